# Optimizing an MI355X kernel written in HIP

```python
import math
import jax, jax.numpy as jnp
from jax import lax
import numpy as np

D_MODEL = 1024
BATCH = 2
SEQ = 8192
DEPTH = 1
DEC_BATCH = 16
DEC_SEQ = 32
PAST_LEN = 2048

CHUNK = 64
EPS = 1e-6
DN_HEADS = 8
DN_DK = 128
DN_DV = 128
DN_QK = DN_HEADS * DN_DK
DN_V = DN_HEADS * DN_DV
DN_CONV_CH = 2 * DN_QK + DN_V
CONV_W = 4
MLA_HEADS = 8
QK_NOPE = 128
QK_ROPE = 64
QK_HEAD = QK_NOPE + QK_ROPE
V_HEAD = 128
KV_RANK = 512
MLA_Q = MLA_HEADS * QK_HEAD
MLA_V = MLA_HEADS * V_HEAD
ROPE_THETA = 10000.0
Q_BLOCK = 128
IN_WIDTHS = (DN_CONV_CH, DN_V, DN_HEADS, DN_HEADS, MLA_Q, KV_RANK, QK_ROPE, MLA_V, D_MODEL, D_MODEL)
IN_WIDTH = DN_CONV_CH + DN_V + 2 * DN_HEADS + MLA_Q + KV_RANK + QK_ROPE + MLA_V + 2 * D_MODEL

kernel_name = 'hybrid_gdn_mla_stream_step'


def _rms(x, gain):
    xf = x.astype(jnp.float32)
    y = xf * lax.rsqrt(jnp.mean(xf * xf, axis=-1, keepdims=True) + EPS)
    return (y * gain.astype(jnp.float32)).astype(x.dtype)


def _l2norm(x):
    return x * lax.rsqrt(jnp.sum(x * x, axis=-1, keepdims=True) + EPS)


def _rope(x, pos):
    half = QK_ROPE // 2
    inv = ROPE_THETA ** (-jnp.arange(half, dtype=jnp.float32) / half)
    ang = pos.astype(jnp.float32)[:, None] * inv
    ang = ang.reshape(ang.shape[0], *([1] * (x.ndim - 3)), half)
    cos, sin = jnp.cos(ang), jnp.sin(ang)
    xf = x.astype(jnp.float32)
    x1, x2 = xf[..., :half], xf[..., half:]
    return jnp.concatenate([x1 * cos - x2 * sin, x2 * cos + x1 * sin], axis=-1).astype(x.dtype)


def _split_in(proj):
    idx, s = [], 0
    for w in IN_WIDTHS[:-1]:
        s += w
        idx.append(s)
    return jnp.split(proj, idx, axis=-1)


def _short_conv(u, buf, w_conv):
    full = jnp.concatenate([buf, u], axis=1)
    T = u.shape[1]
    out = full[:, 0:T] * w_conv[0]
    for i in range(1, CONV_W):
        out = out + full[:, i:i + T] * w_conv[i]
    return jax.nn.silu(out), full[:, -(CONV_W - 1):]


def _gated_delta(q, k, v, g, beta, s0):
    B, T, H, _ = q.shape
    C = min(CHUNK, T)
    N = T // C
    qc, kc, vc = [jnp.moveaxis(a.reshape(B, N, C, H, a.shape[-1]), 3, 2) for a in (q, k, v)]
    gc, bc = [jnp.moveaxis(a.reshape(B, N, C, H), 3, 2) for a in (g, beta)]
    gcum = jnp.cumsum(gc, axis=-1)
    tri_incl = jnp.tril(jnp.ones((C, C), bool))
    tri_strict = jnp.tril(jnp.ones((C, C), bool), -1)
    decay = jnp.exp(jnp.where(tri_incl, gcum[..., :, None] - gcum[..., None, :], -jnp.inf))
    kb = kc * bc[..., None]
    L = jnp.where(tri_strict, jnp.einsum('bnhid,bnhjd->bnhij', kb, kc) * decay, 0.0)
    eye = jnp.eye(C, dtype=q.dtype)
    tinv = lax.linalg.triangular_solve(eye + L, jnp.broadcast_to(eye, L.shape), left_side=True, lower=True)
    eg = jnp.exp(gcum)
    w = tinv @ (kb * eg[..., None])
    u = tinv @ (vc * bc[..., None])
    attn = jnp.einsum('bnhid,bnhjd->bnhij', qc, kc) * decay
    qg = qc * eg[..., None]
    kd = kc * jnp.exp(gcum[..., -1:] - gcum)[..., None]
    glast = jnp.exp(gcum[..., -1])

    def step(S, xs):
        w_, u_, qg_, attn_, kd_, gl_ = xs
        vnew = u_ - w_ @ S
        o = qg_ @ S + attn_ @ vnew
        S = S * gl_[..., None, None] + jnp.swapaxes(kd_, -1, -2) @ vnew
        return S, o

    xs = tuple(jnp.moveaxis(a, 1, 0) for a in (w, u, qg, attn, kd, glast))
    S, o = lax.scan(step, s0, xs)
    o = jnp.moveaxis(jnp.moveaxis(o, 0, 1), 2, 3).reshape(B, T, H, v.shape[-1])
    return o, S


def _deltanet(qkv_raw, beta_raw, alpha_raw, conv_buf, s0, p):
    qkv, conv_new = _short_conv(qkv_raw, conv_buf, p['w_conv'])
    B, T, _ = qkv.shape
    f32 = jnp.float32
    q, k, v = jnp.split(qkv.astype(f32), [DN_QK, 2 * DN_QK], axis=-1)
    q = _l2norm(q.reshape(B, T, DN_HEADS, DN_DK)) * (DN_DK ** -0.5)
    k = _l2norm(k.reshape(B, T, DN_HEADS, DN_DK))
    v = v.reshape(B, T, DN_HEADS, DN_DV)
    beta = jax.nn.sigmoid(beta_raw.astype(f32))
    g = -jnp.exp(p['a_log'].astype(f32)) * jax.nn.softplus(alpha_raw.astype(f32) + p['dt_bias'].astype(f32))
    o, S = _gated_delta(q, k, v, g, beta, s0.astype(f32))
    o = _rms(o, p['dn_out_norm'])
    return o.reshape(B, T, DN_V).astype(qkv_raw.dtype), conv_new, S.astype(qkv_raw.dtype)


def _attend(qn, qr, qpos, kn, kr, v, kpos):
    s = jnp.einsum('bqhd,bkhd->bhqk', qn, kn) + jnp.einsum('bqhd,bkd->bhqk', qr, kr)
    s = s.astype(jnp.float32) * (QK_HEAD ** -0.5)
    mask = (kpos[None, :] // CHUNK) <= (qpos[:, None] // CHUNK)
    s = jnp.where(mask, s, -jnp.inf)
    pr = jax.nn.softmax(s, axis=-1).astype(v.dtype)
    return jnp.einsum('bhqk,bkhd->bqhd', pr, v)


def _mla(q_raw, ckv_raw, kr_raw, pos, past_ckv, past_kr, p):
    B, T, _ = q_raw.shape
    q = q_raw.reshape(B, T, MLA_HEADS, QK_HEAD)
    q_nope = _rms(q[..., :QK_NOPE], p['q_nope_norm'])
    q_rope = _rope(_rms(q[..., QK_NOPE:], p['q_rope_norm']), pos)
    ckv_new = _rms(ckv_raw, p['kv_norm'])
    kr_new = _rope(_rms(kr_raw, p['k_rope_norm']), pos)
    if past_ckv is None:
        ckv_all, kr_all, kpos = ckv_new, kr_new, pos
    else:
        ckv_all = jnp.concatenate([past_ckv, ckv_new], axis=1)
        kr_all = jnp.concatenate([past_kr, kr_new], axis=1)
        kpos = jnp.concatenate([jnp.arange(past_ckv.shape[1]), pos])
    Tk = ckv_all.shape[1]
    k_nope = _rms((ckv_all @ p['w_uk']).reshape(B, Tk, MLA_HEADS, QK_NOPE), p['k_nope_norm'])
    v = (ckv_all @ p['w_uv']).reshape(B, Tk, MLA_HEADS, V_HEAD)
    qb = Q_BLOCK if T % Q_BLOCK == 0 else T
    nb = T // qb
    qn_b = jnp.moveaxis(q_nope.reshape(B, nb, qb, MLA_HEADS, QK_NOPE), 1, 0)
    qr_b = jnp.moveaxis(q_rope.reshape(B, nb, qb, MLA_HEADS, QK_ROPE), 1, 0)
    qp_b = pos.reshape(nb, qb)
    o = lax.map(lambda a: _attend(a[0], a[1], a[2], k_nope, kr_all, v, kpos), (qn_b, qr_b, qp_b))
    o = jnp.moveaxis(o, 0, 1).reshape(B, T, MLA_V)
    return o, ckv_new, kr_new


def _layer(x, c, pos, conv_buf, s0, past_ckv, past_kr, p):
    B = x.shape[0]
    mod = c @ p['w_ada'] + p['b_ada']
    shift, scale, gate = jnp.split(mod, 3, axis=-1)
    h = _rms(x, p['norm_gain']) * (1 + scale[:, None, :]) + shift[:, None, :]
    (qkv_raw, z_a, beta_raw, alpha_raw, q_raw, ckv_raw, kr_raw, z_b, g_a, g_b) = _split_in(h @ p['w_in'])
    if conv_buf is None:
        conv_buf = jnp.zeros((B, CONV_W - 1, DN_CONV_CH), x.dtype)
    if s0 is None:
        s0 = jnp.zeros((B, DN_HEADS, DN_DK, DN_DV), jnp.float32)
    o_a, conv_new, s_new = _deltanet(qkv_raw, beta_raw, alpha_raw, conv_buf, s0, p)
    o_b, ckv_new, kr_new = _mla(q_raw, ckv_raw, kr_raw, pos, past_ckv, past_kr, p)
    u_a = o_a * jax.nn.silu(z_a)
    u_b = o_b * jax.nn.silu(z_b)
    merged = jax.nn.sigmoid(g_a) * (u_a @ p['w_o_dn']) + jax.nn.sigmoid(g_b) * (u_b @ p['w_o_mla'])
    y = x + gate[:, None, :] * (merged @ p['w_out'])
    return y, conv_new, s_new, ckv_new, kr_new


def setup_inputs(seed: int = 0) -> dict:
    key = jax.random.key(seed)
    ks = jax.random.split(key, 32)
    f32 = jnp.float32

    def nrm(k, shape, scale):
        return jax.random.normal(k, shape, f32) * scale

    def gain(k, n):
        return 1.0 + 0.05 * jax.random.normal(k, (DEPTH, n), f32)

    dt = jnp.exp(jax.random.uniform(ks[12], (DEPTH, DN_HEADS), f32, math.log(1e-3), math.log(1e-1)))
    return {
        'x_prompt': nrm(ks[0], (BATCH, SEQ, D_MODEL), 1.0),
        'x_sample': nrm(ks[1], (DEC_BATCH, DEC_SEQ, D_MODEL), 1.0),
        'c_prompt': nrm(ks[2], (BATCH, D_MODEL), 1.0),
        'c_sample': nrm(ks[3], (DEC_BATCH, D_MODEL), 1.0),
        'cache_ckv': nrm(ks[4], (DEPTH, DEC_BATCH, PAST_LEN, KV_RANK), 1.0),
        'cache_krope': nrm(ks[5], (DEPTH, DEC_BATCH, PAST_LEN, QK_ROPE), 1.0),
        'state_delta': nrm(ks[6], (DEPTH, DEC_BATCH, DN_HEADS, DN_DK, DN_DV), 0.1),
        'state_conv': nrm(ks[7], (DEPTH, DEC_BATCH, CONV_W - 1, DN_CONV_CH), 1.0),
        'norm_gain': gain(ks[8], D_MODEL),
        'w_ada': nrm(ks[9], (DEPTH, D_MODEL, 3 * D_MODEL), 0.5 * D_MODEL ** -0.5),
        'b_ada': nrm(ks[10], (DEPTH, 3 * D_MODEL), 0.01),
        'w_in': nrm(ks[11], (DEPTH, D_MODEL, IN_WIDTH), D_MODEL ** -0.5),
        'w_conv': nrm(ks[13], (DEPTH, CONV_W, DN_CONV_CH), CONV_W ** -0.5),
        'a_log': jnp.log(jax.random.uniform(ks[14], (DEPTH, DN_HEADS), f32, 1.0, 16.0)),
        'dt_bias': dt + jnp.log(-jnp.expm1(-dt)),
        'dn_out_norm': gain(ks[15], DN_DV),
        'q_nope_norm': gain(ks[16], QK_NOPE),
        'q_rope_norm': gain(ks[17], QK_ROPE),
        'k_nope_norm': gain(ks[18], QK_NOPE),
        'k_rope_norm': gain(ks[19], QK_ROPE),
        'kv_norm': gain(ks[20], KV_RANK),
        'w_uk': nrm(ks[21], (DEPTH, KV_RANK, MLA_HEADS * QK_NOPE), KV_RANK ** -0.5),
        'w_uv': nrm(ks[22], (DEPTH, KV_RANK, MLA_V), KV_RANK ** -0.5),
        'w_o_dn': nrm(ks[23], (DEPTH, DN_V, D_MODEL), DN_V ** -0.5),
        'w_o_mla': nrm(ks[24], (DEPTH, MLA_V, D_MODEL), MLA_V ** -0.5),
        'w_out': nrm(ks[25], (DEPTH, D_MODEL, D_MODEL), D_MODEL ** -0.5),
    }


def reference(x_prompt, x_sample, c_prompt, c_sample, cache_ckv, cache_krope, state_delta, state_conv,
              norm_gain, w_ada, b_ada, w_in, w_conv, a_log, dt_bias, dn_out_norm,
              q_nope_norm, q_rope_norm, k_nope_norm, k_rope_norm, kv_norm,
              w_uk, w_uv, w_o_dn, w_o_mla, w_out):
    pos_p = jnp.arange(x_prompt.shape[1])
    pos_s = cache_ckv.shape[2] + jnp.arange(x_sample.shape[1])
    yp, ys = x_prompt, x_sample
    ckv_p, kr_p, sd_p, cv_p = [], [], [], []
    ckv_s, kr_s, sd_s, cv_s = [], [], [], []
    for l in range(DEPTH):
        p = dict(norm_gain=norm_gain[l], w_ada=w_ada[l], b_ada=b_ada[l], w_in=w_in[l], w_conv=w_conv[l],
                 a_log=a_log[l], dt_bias=dt_bias[l], dn_out_norm=dn_out_norm[l],
                 q_nope_norm=q_nope_norm[l], q_rope_norm=q_rope_norm[l], k_nope_norm=k_nope_norm[l],
                 k_rope_norm=k_rope_norm[l], kv_norm=kv_norm[l], w_uk=w_uk[l], w_uv=w_uv[l],
                 w_o_dn=w_o_dn[l], w_o_mla=w_o_mla[l], w_out=w_out[l])
        yp, cvp, sdp, kvp, krp = _layer(yp, c_prompt, pos_p, None, None, None, None, p)
        ys, cvs, sds, kvs, krs = _layer(ys, c_sample, pos_s, state_conv[l], state_delta[l],
                                        cache_ckv[l], cache_krope[l], p)
        ckv_p.append(kvp); kr_p.append(krp); sd_p.append(sdp); cv_p.append(cvp)
        ckv_s.append(kvs); kr_s.append(krs); sd_s.append(sds); cv_s.append(cvs)
    new_ckv_p, new_kr_p = jnp.stack(ckv_p), jnp.stack(kr_p)
    new_sd_p, new_cv_p = jnp.stack(sd_p), jnp.stack(cv_p)
    new_ckv_s, new_kr_s = jnp.stack(ckv_s), jnp.stack(kr_s)
    new_sd_s, new_cv_s = jnp.stack(sd_s), jnp.stack(cv_s)
    return (yp, ys, new_ckv_p, new_kr_p, new_sd_p, new_cv_p, new_ckv_s, new_kr_s, new_sd_s, new_cv_s)
```

```cpp
#include <hip/hip_runtime.h>
#include <hip/hip_cooperative_groups.h>
#include <cstdio>
#include <cstdint>
namespace cg = cooperative_groups;
namespace pg8 {
#define PG8_LAS __attribute__((address_space(3)))
typedef unsigned short bf16_t;
typedef short bf16x8 __attribute__((ext_vector_type(8)));
typedef float f32x4 __attribute__((ext_vector_type(4)));
typedef unsigned u32x4 __attribute__((ext_vector_type(4)));
constexpr int BM = 256, BK = 64, HALF = 128, HTB = HALF * BK * 2  , STAGE_BYTES = 8 * HTB, NXCD = 8, WGM = 8;

__host__ __device__ __forceinline__ int lds_byte(int r, int c) { const int st = (r >> 4) * 2 + (c >> 5), rr = r & 15, cc = c & 31, ob = rr * 64 + cc * 2; return st * 1024 + (ob ^ (((ob >> 9) & 1) << 5)); }
__host__ __device__ __forceinline__ void stage_rc(int b, int& R, int& C) { const int st = b / 1024, sb = b % 1024, swz = sb ^ (((sb >> 9) & 1) << 5); R = (st >> 1) * 16 + swz / 64; C = (st & 1) * 32 + (swz % 64) / 2; }
__host__ __device__ __forceinline__ int perm32(int rho) { const int n = rho >> 4, i = rho & 15; return 8 * (i >> 2) + 4 * n + (i & 3); }

struct Unit { int pm, pn; };
struct Gemm { const bf16_t* A; const bf16_t* As; const bf16_t* A2; const bf16_t* A2s; const bf16_t* Bt; int M, N, K, lda, ldb, pm_split, nt1; };

struct StaticOrder {
    int nM, nN, nwg, G, c;
    __host__ __device__ void init(int M, int N, int G_, int c_) { nM = M / BM; nN = N / BM; nwg = nM * nN; G = G_; c = c_; }
    __host__ __device__ bool next(int i, Unit& u) const {
        const long L = (long)i * G + c; if (L >= nwg) return false;
        int wgid = (int)L; { const int q = nwg / NXCD, r = nwg % NXCD, xcd = wgid % NXCD, off = wgid / NXCD; wgid = (xcd < r ? xcd * (q + 1) : r * (q + 1) + (xcd - r) * q) + off; }
        const int nig = WGM * nN, gid = wgid / nig, fm = gid * WGM, gsz = (nM - fm) < WGM ? (nM - fm) : WGM;
        u.pm = fm + ((wgid % nig) % gsz); u.pn = (wgid % nig) / gsz; return true;
    }
    __device__ __forceinline__ void a_ready(const Unit&) const {}
    __device__ __forceinline__ void done(const Unit&) const {}
};

__device__ __forceinline__ unsigned cvt_pk_bf16(float lo, float hi) { unsigned r; asm volatile("v_cvt_pk_bf16_f32 %0, %1, %2" : "=v"(r) : "v"(lo), "v"(hi)); return r; }

template <class Epi, class Sched, bool ALIGN_EPI = false, bool SP2 = false>
__device__ __forceinline__ void gemm_phase(PG8_LAS unsigned char* lds, const Gemm g, const Sched& S, const Epi& E) {
    int tid_l = threadIdx.x; asm volatile("" : "+v"(tid_l));
    const int tid = tid_l, wid = __builtin_amdgcn_readfirstlane(tid >> 6), lane = tid & 63, wr = wid >> 2, wc = wid & 3, fr = lane & 15, fq = lane >> 4;
    const int K = g.K, nt = K / BK;
    unsigned voffA[2], voffB[2];
#pragma unroll
    for (int i = 0; i < 2; ++i) { int R, C; stage_rc(tid * 16 + i * 8192, R, C); const int Rb = Epi::PERM ? ((R & ~31) + perm32(R & 31)) : R;
        voffA[i] = (unsigned)(R * g.lda + C) * 2u; voffB[i] = (unsigned)(Rb * g.ldb + C) * 2u; }
    const size_t kstep = (size_t)(BK * 2);
    const size_t hstepA = (size_t)HALF * g.lda * 2, hstepB = (size_t)HALF * g.ldb * 2;
    const size_t tstepA = 2 * hstepA, tstepB = 2 * hstepB; const int nt1 = g.nt1;
    const unsigned ldsw = (unsigned)wid * 1024u;
    const int aoff = lds_byte(wr * 64 + fr, fq * 8), boff = lds_byte(wc * 32 + fr, fq * 8);
#define PG8_SA(b, h) (((b) * 2 + (h)) * HTB)
#define PG8_SB(b, h) ((4 + (b) * 2 + (h)) * HTB)
#define PG8_STAGE(bufoff, gbase, voff) do { _Pragma("unroll") for (int _i = 0; _i < 2; ++_i) \
        __builtin_amdgcn_global_load_lds((const unsigned*)((const char*)(gbase) + (voff)[_i]), (PG8_LAS unsigned*)(lds + (bufoff) + ldsw + _i * 8192), 16, 0, 0); } while (0)
#define PG8_LDA(dst, b, h) do { _Pragma("unroll") for (int m = 0; m < 4; ++m) _Pragma("unroll") for (int k = 0; k < 2; ++k) dst[m][k] = *(const PG8_LAS bf16x8*)(lds + PG8_SA(b, h) + aoff + m * 2048 + k * 1024); } while (0)
#define PG8_LDB(dst, b, h) do { _Pragma("unroll") for (int n = 0; n < 2; ++n) _Pragma("unroll") for (int k = 0; k < 2; ++k) dst[n][k] = *(const PG8_LAS bf16x8*)(lds + PG8_SB(b, h) + boff + n * 2048 + k * 1024); } while (0)
#define PG8_MMA(ai, bj, At, Bt) do { __builtin_amdgcn_s_setprio(1); _Pragma("unroll") for (int m = 0; m < 4; ++m) _Pragma("unroll") for (int n = 0; n < 2; ++n) _Pragma("unroll") for (int k = 0; k < 2; ++k) \
        acc[ai][bj][m][n] = __builtin_amdgcn_mfma_f32_16x16x32_bf16(Bt[n][k], At[m][k], acc[ai][bj][m][n], 0, 0, 0); __builtin_amdgcn_s_setprio(0); } while (0)
#define PG8_WAIT_V(n) asm volatile("s_waitcnt vmcnt(" #n ")" ::: "memory")
#define PG8_WAIT_L(n) asm volatile("s_waitcnt lgkmcnt(" #n ")" ::: "memory")
#define PG8_BAR __builtin_amdgcn_s_barrier()
#define PG8_SCHED __builtin_amdgcn_sched_barrier(0)
    Unit cur, nxt; int ui = 0;
    if (!S.next(0, cur)) return;
    f32x4 acc[2][2][4][2];
#pragma unroll
    for (int a = 0; a < 2; ++a)
#pragma unroll
        for (int b = 0; b < 2; ++b)
#pragma unroll
            for (int m = 0; m < 4; ++m)
#pragma unroll
                for (int n = 0; n < 2; ++n) acc[a][b][m][n] = (f32x4){0.f, 0.f, 0.f, 0.f};
    bf16x8 At[4][2], B0[2][2], B1[2][2];
    #define PG8_UA(P, Ps, pm_) ((pm_) < g.pm_split ? (const char*)(P) + (size_t)(pm_) * tstepA : (const char*)(Ps) + (size_t)((pm_) - g.pm_split) * tstepA)
#define PG8_KA(t_) ((t_) < nt1 ? cA + (size_t)(t_) * kstep : cA2 + (size_t)((t_) - nt1) * kstep)
    const char* cA = PG8_UA(g.A, g.As, cur.pm); const char* cA2 = PG8_UA(g.A2, g.A2s, cur.pm); const char* cB = (const char*)g.Bt + (size_t)cur.pn * tstepB;
    S.a_ready(cur);
    if constexpr (SP2) {
        PG8_STAGE(PG8_SB(0, 0), cB, voffB); PG8_STAGE(PG8_SB(0, 1), cB + hstepB, voffB); PG8_STAGE(PG8_SA(0, 0), cA, voffA); PG8_STAGE(PG8_SA(0, 1), cA + hstepA, voffA);
        if (wr == 1) PG8_BAR;
        PG8_WAIT_V(2); PG8_BAR;
        PG8_STAGE(PG8_SB(1, 0), cB + kstep, voffB); PG8_STAGE(PG8_SA(1, 0), cA + kstep, voffA); PG8_STAGE(PG8_SB(1, 1), cB + hstepB + kstep, voffB);
        PG8_WAIT_V(6); PG8_BAR;
    } else {
        PG8_STAGE(PG8_SB(0, 0), cB, voffB); PG8_STAGE(PG8_SA(0, 0), cA, voffA); PG8_STAGE(PG8_SB(0, 1), cB + hstepB, voffB); PG8_STAGE(PG8_SA(0, 1), cA + hstepA, voffA);
        if (wr == 1) PG8_BAR;
        PG8_WAIT_V(4); PG8_BAR;
        PG8_STAGE(PG8_SB(1, 0), cB + kstep, voffB); PG8_STAGE(PG8_SA(1, 0), cA + kstep, voffA); PG8_STAGE(PG8_SB(1, 1), cB + hstepB + kstep, voffB);
        PG8_WAIT_V(6); PG8_BAR;
    }
    for (;;) {
        const bool has_next = S.next(ui + 1, nxt);
        const char* nA = has_next ? PG8_UA(g.A, g.As, nxt.pm) : cA; const char* nA2 = has_next ? PG8_UA(g.A2, g.A2s, nxt.pm) : cA2; const char* nB = has_next ? (const char*)g.Bt + (size_t)nxt.pn * tstepB : cB;
        for (int t = 0; t < nt; t += 2) {
            const bool last = (t == nt - 2);
            if constexpr (Epi::HAS_MID) { if (t == nt1) E.mid(acc, cur, wr, wc, fr, fq); }
            const char* a1 = PG8_KA(t + 1);
            const char* a2 = last ? nA : PG8_KA(t + 2); const char* b2 = last ? nB : cB + (size_t)(t + 2) * kstep;
            const char* a3 = a2 + kstep; const char* b3 = b2 + kstep;
            if (last && has_next) S.a_ready(nxt);
            if constexpr (SP2) {
            PG8_LDB(B0, 0, 0); PG8_LDB(B1, 0, 1); PG8_SCHED; PG8_LDA(At, 0, 0); PG8_STAGE(PG8_SA(1, 1), a1 + hstepA, voffA);
            PG8_WAIT_V(8); PG8_WAIT_L(0); PG8_BAR; PG8_MMA(0, 0, At, B0); PG8_MMA(0, 1, At, B1); PG8_BAR; PG8_SCHED;
            PG8_LDA(At, 0, 1); PG8_STAGE(PG8_SB(0, 0), b2, voffB); PG8_STAGE(PG8_SB(0, 1), b2 + hstepB, voffB); PG8_STAGE(PG8_SA(0, 0), a2, voffA);
            PG8_WAIT_V(8); PG8_WAIT_L(0); PG8_BAR; PG8_MMA(1, 0, At, B0); PG8_MMA(1, 1, At, B1); PG8_BAR; PG8_SCHED;
            PG8_LDB(B0, 1, 0); PG8_LDB(B1, 1, 1); PG8_SCHED; PG8_LDA(At, 1, 0); PG8_STAGE(PG8_SA(0, 1), a2 + hstepA, voffA);
            PG8_WAIT_V(8); PG8_WAIT_L(0); PG8_BAR; PG8_MMA(0, 0, At, B0); PG8_MMA(0, 1, At, B1); PG8_BAR; PG8_SCHED;
            PG8_LDA(At, 1, 1); PG8_STAGE(PG8_SB(1, 0), b3, voffB); PG8_STAGE(PG8_SB(1, 1), b3 + hstepB, voffB); PG8_STAGE(PG8_SA(1, 0), a3, voffA);
            PG8_WAIT_V(8); PG8_WAIT_L(0); PG8_BAR; PG8_MMA(1, 0, At, B0); PG8_MMA(1, 1, At, B1); PG8_BAR; PG8_SCHED;
            } else {
            PG8_LDB(B0, 0, 0); PG8_SCHED; PG8_LDA(At, 0, 0); PG8_STAGE(PG8_SA(1, 1), a1 + hstepA, voffA);
            PG8_WAIT_L(8); PG8_BAR; PG8_WAIT_L(0); PG8_MMA(0, 0, At, B0); PG8_BAR; PG8_SCHED;
            PG8_LDB(B1, 0, 1); PG8_STAGE(PG8_SB(0, 0), b2, voffB);
            PG8_BAR; PG8_WAIT_L(0); PG8_MMA(0, 1, At, B1); PG8_BAR;
            PG8_LDA(At, 0, 1); PG8_STAGE(PG8_SA(0, 0), a2, voffA);
            PG8_BAR; PG8_WAIT_L(0); PG8_MMA(1, 0, At, B0); PG8_BAR; PG8_SCHED;
            PG8_STAGE(PG8_SB(0, 1), b2 + hstepB, voffB);
            PG8_WAIT_V(6); PG8_BAR; PG8_MMA(1, 1, At, B1); PG8_BAR;
            PG8_LDB(B0, 1, 0); PG8_SCHED; PG8_LDA(At, 1, 0); PG8_STAGE(PG8_SA(0, 1), a2 + hstepA, voffA);
            PG8_WAIT_L(8); PG8_BAR; PG8_WAIT_L(0); PG8_MMA(0, 0, At, B0); PG8_BAR; PG8_SCHED;
            PG8_LDB(B1, 1, 1); PG8_STAGE(PG8_SB(1, 0), b3, voffB);
            PG8_BAR; PG8_WAIT_L(0); PG8_MMA(0, 1, At, B1); PG8_BAR;
            PG8_LDA(At, 1, 1); PG8_STAGE(PG8_SA(1, 0), a3, voffA);
            PG8_BAR; PG8_WAIT_L(0); PG8_MMA(1, 0, At, B0); PG8_BAR; PG8_SCHED;
            PG8_STAGE(PG8_SB(1, 1), b3 + hstepB, voffB);
            PG8_WAIT_V(6); PG8_BAR; PG8_MMA(1, 1, At, B1); PG8_BAR;
            }
        }
        if constexpr (ALIGN_EPI) { if (wr == 0) PG8_BAR; }
        if constexpr (!Epi::AFTER_DRAIN) { E(acc, cur, wr, wc, fr, fq); S.done(cur); }
        if (!has_next) break;
#pragma unroll
        for (int a = 0; a < 2; ++a)
#pragma unroll
            for (int b = 0; b < 2; ++b)
#pragma unroll
                for (int m = 0; m < 4; ++m)
#pragma unroll
                    for (int n = 0; n < 2; ++n) acc[a][b][m][n] = (f32x4){0.f, 0.f, 0.f, 0.f};
        cur = nxt; cA = nA; cA2 = nA2; cB = nB; ++ui;
        if constexpr (ALIGN_EPI) { if (wr == 1) PG8_BAR; }
    }
    PG8_WAIT_V(0);
    if constexpr (!ALIGN_EPI) { if (wr == 0) PG8_BAR; }
    PG8_BAR;
    if constexpr (Epi::AFTER_DRAIN) { E.fused(acc, cur, wr, wc, fr, fq, lds, wid, lane); S.done(cur); }
#undef PG8_UA
#undef PG8_KA
#undef PG8_SA
#undef PG8_SB
#undef PG8_STAGE
#undef PG8_LDA
#undef PG8_LDB
#undef PG8_MMA
#undef PG8_WAIT_V
#undef PG8_WAIT_L
#undef PG8_BAR
#undef PG8_SCHED
}
}
#define LAS __attribute__((address_space(3)))
typedef unsigned short bf16_t;
typedef short bf16x8 __attribute__((ext_vector_type(8)));
typedef float f32x4 __attribute__((ext_vector_type(4)));
typedef float f32x16 __attribute__((ext_vector_type(16)));
typedef unsigned u32x4 __attribute__((ext_vector_type(4)));
typedef unsigned u32x2 __attribute__((ext_vector_type(2)));
typedef float f32x2_t __attribute__((ext_vector_type(2)));
typedef __bf16 bf16x2_t __attribute__((ext_vector_type(2)));

constexpr int MP = 16384, MS = 512, MT = MP + MS, TKS = 2080, MKS = 16 * TKS  ;
constexpr float EPS = 1e-6f;
constexpr size_t MiB = 1u << 20;
constexpr size_t W_BT_DN = 1 * MiB, W_BT_MLA = W_BT_DN + (size_t)4352 * 1024 * 2, W_BT_UKV = 20 * MiB, W_BT_O = 22 * MiB, W_BT_OUT = 26 * MiB;
constexpr size_t W_MOD = 28 * MiB, W_GL = 28 * MiB + 256 * 1024, W_BA = 28 * MiB + 512 * 1024;
constexpr size_t W_QS = 30 * MiB, W_CKVS = 31 * MiB + 512 * 1024, W_KRS = 32 * MiB, W_UAS = 33 * MiB, W_UBS = 34 * MiB, W_MRGS = 35 * MiB;
constexpr size_t W_QKV = 36 * MiB, W_HALO = 135 * MiB, W_KDT = 140 * MiB, W_SQKV = 174 * MiB, W_UAP = 190 * MiB, W_TB = 222 * MiB, W_UBP = 222 * MiB;
constexpr size_t W_QP = 36 * MiB, W_CKVP = 84 * MiB, W_KRP = 100 * MiB, W_KN = 102 * MiB, W_VT = 134 * MiB;
constexpr size_t W_MRGP = 36 * MiB, W_CKVALL = 68 * MiB, W_KRALL = 101 * MiB, W_KNS = 106 * MiB, W_VTS = 172 * MiB;
static_assert(W_BT_MLA + (size_t)5376 * 1024 * 2 <= W_BT_UKV, "ws map");
static_assert(W_BA + (size_t)MT * 16 * 4 <= W_QS, "ws map");
static_assert(W_QKV + (size_t)MT * 3072 * 2 <= W_HALO && W_HALO + (size_t)264 * 3 * 3072 * 2 <= W_KDT && W_KDT + (size_t)2176 * 8192 * 2 <= W_SQKV && W_SQKV + (size_t)128 * 3 * 8192 * 2 <= W_UAP, "ws map");
static_assert(W_TB + (size_t)2176 * 8192 * 2 <= 256 * MiB && W_UAP + (size_t)MP * 1024 * 2 <= W_UBP && W_UBP + (size_t)MP * 1024 * 2 <= 256 * MiB, "ws map");
static_assert(W_QP + (size_t)MP * 1536 * 2 <= W_CKVP && W_CKVP + (size_t)MP * 512 * 2 <= W_KRP && W_KRP + (size_t)MP * 64 * 2 <= W_KN && W_KN + (size_t)MP * 1024 * 2 <= W_VT && W_VT + (size_t)MP * 1024 * 2 <= W_UAP, "ws map");
static_assert(W_MRGP + (size_t)MP * 1024 * 2 <= W_CKVALL && W_CKVALL + (size_t)(MKS + 64) * 512 * 2 <= W_KRALL && W_KRALL + (size_t)(MKS + 64) * 64 * 2 <= W_KNS && W_KNS + (size_t)(MKS + 64) * 1024 * 2 <= W_VTS && W_VTS + (size_t)1024 * MKS * 2 + 256 <= 256 * MiB, "ws map");
constexpr size_t O_YP = 0, O_YS = O_YP + (size_t)MP * 1024, O_CKVP = O_YS + (size_t)MS * 1024, O_KRP = O_CKVP + (size_t)MP * 512, O_SDP = O_KRP + (size_t)MP * 64,
                 O_CVP = O_SDP + 2 * 8 * 128 * 128, O_CKVS = O_CVP + 2 * 3 * 3072, O_KRS = O_CKVS + (size_t)MS * 512, O_SDS = O_KRS + (size_t)MS * 64, O_CVS = O_SDS + (size_t)16 * 8 * 128 * 128;
constexpr int LDS_BYTES = 147456;

struct Params { const float* in[26]; float* out; unsigned char* ws; };
enum { I_XP = 0, I_XS, I_CP, I_CS, I_CCKV, I_CKR, I_SD, I_SC, I_NG, I_WADA, I_BADA, I_WIN, I_WCONV, I_ALOG, I_DTB, I_DNN, I_QNN, I_QRN, I_KNN, I_KRN, I_KVN, I_WUK, I_WUV, I_WODN, I_WOMLA, I_WOUT };

__device__ __forceinline__ float bf2f(unsigned short u) { return __uint_as_float((unsigned)u << 16); }
__device__ __forceinline__ float bflo(unsigned u) { return __uint_as_float(u << 16); }
__device__ __forceinline__ float bfhi(unsigned u) { return __uint_as_float(u & 0xffff0000u); }
__device__ __forceinline__ unsigned pk2(float lo, float hi) { f32x2_t v = {lo, hi}; bf16x2_t b = __builtin_convertvector(v, bf16x2_t); return __builtin_bit_cast(unsigned, b); }
__device__ __forceinline__ unsigned short f2bf(float f) { return (unsigned short)(pk2(f, 0.f) & 0xffffu); }
__device__ __forceinline__ float wave_sum(float v) {
#pragma unroll
    for (int o = 1; o < 64; o <<= 1) v += __shfl_xor(v, o);
    return v;
}
__device__ __forceinline__ float sigmoidf_(float x) { return 1.f / (1.f + __expf(-x)); }
__device__ __forceinline__ float siluf_(float x) { return x / (1.f + __expf(-x)); }
__device__ __forceinline__ void unpack8(u32x4 v, float* f) { f[0] = bflo(v.x); f[1] = bfhi(v.x); f[2] = bflo(v.y); f[3] = bfhi(v.y); f[4] = bflo(v.z); f[5] = bfhi(v.z); f[6] = bflo(v.w); f[7] = bfhi(v.w); }
__device__ __forceinline__ u32x4 pack8(const float* f) { u32x4 v; v.x = pk2(f[0], f[1]); v.y = pk2(f[2], f[3]); v.z = pk2(f[4], f[5]); v.w = pk2(f[6], f[7]); return v; }

using pg8::Unit;
struct EpiStore {
    static constexpr bool PERM = true, AFTER_DRAIN = false, HAS_MID = false;
    bf16_t* O; int ldc;
    __device__ __forceinline__ void operator()(const f32x4 (&acc)[2][2][4][2], const Unit& u, int wr, int wc, int fr, int fq) const {
#pragma unroll
        for (int ai = 0; ai < 2; ++ai)
#pragma unroll
            for (int m = 0; m < 4; ++m) { const int row = u.pm * 256 + ai * 128 + wr * 64 + m * 16 + fr; bf16_t* rp = O + (size_t)row * ldc + u.pn * 256 + wc * 32 + 8 * fq;
#pragma unroll
                for (int bj = 0; bj < 2; ++bj) { const f32x4 v0 = acc[ai][bj][m][0], v1 = acc[ai][bj][m][1]; u32x4 w; w.x = pk2(v0[0], v0[1]); w.y = pk2(v0[2], v0[3]); w.z = pk2(v1[0], v1[1]); w.w = pk2(v1[2], v1[3]);
                    *(u32x4*)(rp + bj * 128) = w; } }
    }
};
struct EpiProj {
    static constexpr bool PERM = true, AFTER_DRAIN = false, HAS_MID = false;
    int pass; unsigned char* ws; float* out;
    __device__ __forceinline__ void operator()(const f32x4 (&acc)[2][2][4][2], const Unit& u, int wr, int wc, int fr, int fq) const {
        bf16_t* bp; bf16_t* bs; int ldc, ct; int kind = 0;
        const int pn = u.pn;
        if (pass == 0) {
            if (pn < 12) { bp = (bf16_t*)(ws + W_QKV); bs = bp + (size_t)MP * 3072; ldc = 3072; ct = pn * 256; kind = 3; }
            else if (pn < 16) { bp = (bf16_t*)(ws + W_UAP); bs = (bf16_t*)(ws + W_UAS); ldc = 1024; ct = (pn - 12) * 256; }
            else { bp = bs = nullptr; ldc = 0; ct = 0; kind = 1; }
        } else {
            if (pn < 6) { bp = (bf16_t*)(ws + W_QP); bs = (bf16_t*)(ws + W_QS); ldc = 1536; ct = pn * 256; }
            else if (pn < 8) { bp = (bf16_t*)(ws + W_CKVP); bs = (bf16_t*)(ws + W_CKVS); ldc = 512; ct = (pn - 6) * 256; }
            else if (pn < 12) { bp = (bf16_t*)(ws + W_UBP); bs = (bf16_t*)(ws + W_UBS); ldc = 1024; ct = (pn - 8) * 256; }
            else if (pn < 20) { bp = (bf16_t*)(out + O_YP); bs = (bf16_t*)(out + O_YS); ldc = 2048; ct = (pn - 12) * 256; }
            else { bp = (bf16_t*)(ws + W_KRP); bs = (bf16_t*)(ws + W_KRS); ldc = 64; ct = 0; kind = 2; }
        }
        if (kind == 1) {
            if (wc != 0 || fq >= 2) return;
            float* ba = (float*)(ws + W_BA);
#pragma unroll
            for (int ai = 0; ai < 2; ++ai)
#pragma unroll
                for (int m = 0; m < 4; ++m) { const int row = u.pm * 256 + ai * 128 + wr * 64 + m * 16 + fr; float* rp = ba + (size_t)row * 16 + 8 * fq;
                    *(f32x4*)rp = acc[ai][0][m][0]; *(f32x4*)(rp + 4) = acc[ai][0][m][1]; }
            return;
        }
        if (kind == 2 && wc >= 2) return;
#pragma unroll
        for (int ai = 0; ai < 2; ++ai)
#pragma unroll
            for (int m = 0; m < 4; ++m) { const int row = u.pm * 256 + ai * 128 + wr * 64 + m * 16 + fr;
                bf16_t* rp = (row < MP ? bp + (size_t)row * ldc : bs + (size_t)(row - MP) * ldc) + ct + wc * 32 + 8 * fq;
#pragma unroll
                for (int bj = 0; bj < 2; ++bj) { if (kind == 2 && bj == 1) continue;
                    const f32x4 v0 = acc[ai][bj][m][0], v1 = acc[ai][bj][m][1]; u32x4 w; w.x = pk2(v0[0], v0[1]); w.y = pk2(v0[2], v0[3]); w.z = pk2(v1[0], v1[1]); w.w = pk2(v1[2], v1[3]);
                    *(u32x4*)(rp + bj * 128) = w;
                    if (kind == 3 && m == 3 && fr >= 13) *(u32x4*)((bf16_t*)(ws + W_HALO) + ((size_t)(row >> 6) * 3 + (fr - 13)) * 3072 + ct + wc * 32 + 8 * fq + bj * 128) = w; } }
    }
};
struct EpiMerge {
    static constexpr bool PERM = true, AFTER_DRAIN = false, HAS_MID = true;
    const bf16_t* G; bf16_t* O;
    __device__ __forceinline__ void mid(f32x4 (&acc)[2][2][4][2], const Unit& u, int wr, int wc, int fr, int fq) const {
#pragma unroll
        for (int ai = 0; ai < 2; ++ai)
#pragma unroll
            for (int m = 0; m < 4; ++m) { const int row = u.pm * 256 + ai * 128 + wr * 64 + m * 16 + fr; const bf16_t* gp = G + (size_t)row * 2048 + u.pn * 256 + wc * 32 + 8 * fq;
#pragma unroll
                for (int bj = 0; bj < 2; ++bj) { float ga[8], gb[8]; unpack8(*(const u32x4*)(gp + bj * 128), ga); unpack8(*(const u32x4*)(gp + 1024 + bj * 128), gb);
#pragma unroll
                    for (int e = 0; e < 8; ++e) { const float f = (1.f + __expf(-gb[e])) / (1.f + __expf(-ga[e])); if (e < 4) acc[ai][bj][m][0][e] *= f; else acc[ai][bj][m][1][e - 4] *= f; } } }
    }
    __device__ __forceinline__ void operator()(const f32x4 (&acc)[2][2][4][2], const Unit& u, int wr, int wc, int fr, int fq) const {
#pragma unroll
        for (int ai = 0; ai < 2; ++ai)
#pragma unroll
            for (int m = 0; m < 4; ++m) { const int row = u.pm * 256 + ai * 128 + wr * 64 + m * 16 + fr; const bf16_t* gp = G + (size_t)row * 2048 + 1024 + u.pn * 256 + wc * 32 + 8 * fq;
                bf16_t* rp = O + (size_t)row * 1024 + u.pn * 256 + wc * 32 + 8 * fq;
#pragma unroll
                for (int bj = 0; bj < 2; ++bj) { float gb[8], v[8]; unpack8(*(const u32x4*)(gp + bj * 128), gb);
#pragma unroll
                    for (int e = 0; e < 8; ++e) v[e] = (e < 4 ? acc[ai][bj][m][0][e] : acc[ai][bj][m][1][e - 4]) * sigmoidf_(gb[e]);
                    *(u32x4*)(rp + bj * 128) = pack8(v); } }
    }
};
struct EpiOut {
    static constexpr bool PERM = true, AFTER_DRAIN = false, HAS_MID = false;
    const float* X; float* Y; const float* mod; int rows_per_batch, mod_row0;
    __device__ __forceinline__ void operator()(const f32x4 (&acc)[2][2][4][2], const Unit& u, int wr, int wc, int fr, int fq) const {
#pragma unroll
        for (int ai = 0; ai < 2; ++ai)
#pragma unroll
            for (int m = 0; m < 4; ++m) { const int row = u.pm * 256 + ai * 128 + wr * 64 + m * 16 + fr; const int col = u.pn * 256 + wc * 32 + 8 * fq;
                const float* gt = mod + (size_t)(mod_row0 + row / rows_per_batch) * 3072 + 2048 + col;
#pragma unroll
                for (int bj = 0; bj < 2; ++bj) {
                    const f32x4 x0 = *(const f32x4*)(X + (size_t)row * 1024 + col + bj * 128), x1 = *(const f32x4*)(X + (size_t)row * 1024 + col + bj * 128 + 4);
                    const f32x4 g0 = *(const f32x4*)(gt + bj * 128), g1 = *(const f32x4*)(gt + bj * 128 + 4);
                    *(f32x4*)(Y + (size_t)row * 1024 + col + bj * 128) = x0 + g0 * acc[ai][bj][m][0];
                    *(f32x4*)(Y + (size_t)row * 1024 + col + bj * 128 + 4) = x1 + g1 * acc[ai][bj][m][1]; } }
    }
};
__device__ __forceinline__ void tr_item(const float* W, int ldw, int n0, int k0, bf16_t* WT, int ldt, int r0, int kdst, LAS float* scr, int lane) {
#pragma unroll 8
    for (int i = 0; i < 32; ++i) { const int kk = 2 * i + (lane >> 5); scr[kk * 33 + (lane & 31)] = W[(size_t)(k0 + kk) * ldw + n0 + (lane & 31)]; }
    asm volatile("s_waitcnt lgkmcnt(0)" ::: "memory");
    const int c = lane & 7;
#pragma unroll
    for (int j = 0; j < 4; ++j) { const int n = (lane >> 3) + 8 * j; const LAS float* s = scr + (8 * c) * 33 + n;
        u32x4 o; o.x = pk2(s[0 * 33], s[1 * 33]); o.y = pk2(s[2 * 33], s[3 * 33]); o.z = pk2(s[4 * 33], s[5 * 33]); o.w = pk2(s[6 * 33], s[7 * 33]);
        *(u32x4*)(WT + (size_t)(r0 + n) * ldt + kdst + k0 + 8 * c) = o; }
    asm volatile("s_waitcnt lgkmcnt(0)" ::: "memory");
}
__device__ __forceinline__ void p0_phase(const Params& p, LAS unsigned char* lds, int tid, int wid, int lane) {
    const int G = gridDim.x, bx = blockIdx.x;
    for (int cb = bx; cb < 48; cb += G) {
        const int j = cb * 64 + lane; float acc[18];
#pragma unroll
        for (int r = 0; r < 18; ++r) acc[r] = 0.f;
        const float* wa = p.in[I_WADA];
        for (int k = wid * 128; k < wid * 128 + 128; ++k) { const float wv = wa[(size_t)k * 3072 + j];
#pragma unroll
            for (int r = 0; r < 18; ++r) { const float cv = r < 2 ? p.in[I_CP][r * 1024 + k] : p.in[I_CS][(r - 2) * 1024 + k]; acc[r] += cv * wv; } }
        LAS float* red = (LAS float*)lds;
#pragma unroll
        for (int r = 0; r < 18; ++r) red[(wid * 18 + r) * 64 + lane] = acc[r];
        __syncthreads();
        for (int o = tid; o < 18 * 64; o += 512) { const int r = o >> 6, l = o & 63; float s = 0.f;
#pragma unroll
            for (int w = 0; w < 8; ++w) s += red[(w * 18 + r) * 64 + l];
            ((float*)(p.ws + W_MOD))[r * 3072 + cb * 64 + l] = s + p.in[I_BADA][cb * 64 + l]; }
        __syncthreads();
    }
    LAS float* scr = (LAS float*)(lds + 40960 + wid * 8448);
    const int gw = bx * 8 + wid, NGW = G * 8;
    constexpr int I_DN = 129 * 16, I_MLA = 162 * 16, I_UK = 32 * 8, I_UV = 32 * 8, I_ODN = 32 * 16, I_OMLA = 32 * 16, I_WO = 32 * 16;
    constexpr int NITEMS = I_DN + I_MLA + I_UK + I_UV + I_ODN + I_OMLA + I_WO;
    for (int it = gw; it < NITEMS; it += NGW) {
        int r = it;
        if (r < I_DN) { const int dg = r >> 4, kb = r & 15; tr_item(p.in[I_WIN], 9296, 32 * dg, 64 * kb, (bf16_t*)(p.ws + W_BT_DN), 1024, 32 * dg, 0, scr, lane); continue; } r -= I_DN;
        if (r < I_MLA) { const int dg = r >> 4, kb = r & 15; int n0;
            if (dg < 48) n0 = 4112 + 32 * dg; else if (dg < 64) n0 = 5648 + 32 * (dg - 48); else if (dg < 96) n0 = 6224 + 32 * (dg - 64); else if (dg < 160) n0 = 7248 + 32 * (dg - 96); else n0 = 6160 + 32 * (dg - 160);
            tr_item(p.in[I_WIN], 9296, n0, 64 * kb, (bf16_t*)(p.ws + W_BT_MLA), 1024, 32 * dg, 0, scr, lane); continue; } r -= I_MLA;
        if (r < I_UK) { const int dg = r >> 3, kb = r & 7; tr_item(p.in[I_WUK], 1024, 32 * dg, 64 * kb, (bf16_t*)(p.ws + W_BT_UKV), 512, 32 * dg, 0, scr, lane); continue; } r -= I_UK;
        if (r < I_UV) { const int dg = r >> 3, kb = r & 7; tr_item(p.in[I_WUV], 1024, 32 * dg, 64 * kb, (bf16_t*)(p.ws + W_BT_UKV), 512, 1024 + 32 * dg, 0, scr, lane); continue; } r -= I_UV;
        if (r < I_ODN) { const int dg = r >> 4, kb = r & 15; tr_item(p.in[I_WODN], 1024, 32 * dg, 64 * kb, (bf16_t*)(p.ws + W_BT_O), 2048, 32 * dg, 0, scr, lane); continue; } r -= I_ODN;
        if (r < I_OMLA) { const int dg = r >> 4, kb = r & 15; tr_item(p.in[I_WOMLA], 1024, 32 * dg, 64 * kb, (bf16_t*)(p.ws + W_BT_O), 2048, 32 * dg, 1024, scr, lane); continue; } r -= I_OMLA;
        { const int dg = r >> 4, kb = r & 15; tr_item(p.in[I_WOUT], 1024, 32 * dg, 64 * kb, (bf16_t*)(p.ws + W_BT_OUT), 1024, 32 * dg, 0, scr, lane); }
    }
}
__device__ __forceinline__ void p1_phase(const Params& p, int wid, int lane) {
    const int gw = blockIdx.x * 8 + wid, NGW = gridDim.x * 8; const float* mod = (const float*)(p.ws + W_MOD);
    for (int row = gw; row < MT; row += NGW) {
        const float* xr = row < MP ? p.in[I_XP] + (size_t)row * 1024 : p.in[I_XS] + (size_t)(row - MP) * 1024;
        const int mr = row < MP ? (row >> 13) : 2 + ((row - MP) >> 5);
        bf16_t* hr = row < MP ? (bf16_t*)(p.out + O_CKVP) + (size_t)row * 1024 : (bf16_t*)(p.out + O_CKVS) + (size_t)(row - MP) * 1024;
        f32x4 v[4]; float s = 0.f;
#pragma unroll
        for (int j = 0; j < 4; ++j) { v[j] = *(const f32x4*)(xr + 4 * lane + 256 * j); s += (v[j].x * v[j].x + v[j].y * v[j].y) + (v[j].z * v[j].z + v[j].w * v[j].w); }
        const float rs = rsqrtf(wave_sum(s) * (1.f / 1024.f) + EPS);
#pragma unroll
        for (int j = 0; j < 4; ++j) { const int c = 4 * lane + 256 * j;
            const f32x4 g = *(const f32x4*)(p.in[I_NG] + c), sh = *(const f32x4*)(mod + mr * 3072 + c), sc = *(const f32x4*)(mod + mr * 3072 + 1024 + c);
            const f32x4 y = v[j] * rs * g * (1.f + sc) + sh; u32x2 o; o.x = pk2(y.x, y.y); o.y = pk2(y.z, y.w); *(u32x2*)(hr + c) = o; }
    }
}
__device__ __forceinline__ void e1_phase(const Params& p, int wid, int lane) {
    const int gw = blockIdx.x * 8 + wid, NGW = gridDim.x * 8;
    const float QSC = 0.07216878364870322f * 1.4426950408889634f;
    for (int row = gw; row < MT; row += NGW) {
        const bool pr = row < MP; const int lr = pr ? row : row - MP;
        const float pos = pr ? (float)(row & 8191) : (float)(2048 + (lr & 31));
        { bf16_t* q = (pr ? (bf16_t*)(p.ws + W_QP) : (bf16_t*)(p.ws + W_QS)) + (size_t)lr * 1536; const int hd = lane >> 3, sub = lane & 7;
          bf16_t* qn = q + hd * 192 + sub * 16; float f[16]; unpack8(*(const u32x4*)qn, f); unpack8(*(const u32x4*)(qn + 8), f + 8);
          float ss = 0.f;
#pragma unroll
          for (int e = 0; e < 16; ++e) ss += f[e] * f[e];
          ss += __shfl_xor(ss, 1); ss += __shfl_xor(ss, 2); ss += __shfl_xor(ss, 4);
          const float rn = rsqrtf(ss * (1.f / 128.f) + EPS) * QSC;
#pragma unroll
          for (int e = 0; e < 16; ++e) f[e] *= rn * p.in[I_QNN][sub * 16 + e];
          *(u32x4*)qn = pack8(f); *(u32x4*)(qn + 8) = pack8(f + 8);
          bf16_t* qr = q + hd * 192 + 128 + sub * 4; const u32x2 a = *(const u32x2*)qr, b = *(const u32x2*)(qr + 32);
          float x1[4] = {bflo(a.x), bfhi(a.x), bflo(a.y), bfhi(a.y)}, x2[4] = {bflo(b.x), bfhi(b.x), bflo(b.y), bfhi(b.y)};
          float s2 = 0.f;
#pragma unroll
          for (int e = 0; e < 4; ++e) s2 += x1[e] * x1[e] + x2[e] * x2[e];
          s2 += __shfl_xor(s2, 1); s2 += __shfl_xor(s2, 2); s2 += __shfl_xor(s2, 4);
          const float rr = rsqrtf(s2 * (1.f / 64.f) + EPS);
          float o1[4], o2[4];
#pragma unroll
          for (int e = 0; e < 4; ++e) { const int i = sub * 4 + e; const float inv = exp2f(-(float)i * (13.287712379549449f / 32.f)); float sn, cs; sincosf(pos * inv, &sn, &cs);
              const float y1 = x1[e] * rr * p.in[I_QRN][i], y2 = x2[e] * rr * p.in[I_QRN][32 + i]; o1[e] = (y1 * cs - y2 * sn) * QSC; o2[e] = (y2 * cs + y1 * sn) * QSC; }
          u32x2 w1, w2; w1.x = pk2(o1[0], o1[1]); w1.y = pk2(o1[2], o1[3]); w2.x = pk2(o2[0], o2[1]); w2.y = pk2(o2[2], o2[3]);
          *(u32x2*)qr = w1; *(u32x2*)(qr + 32) = w2; }
        { bf16_t* c = (pr ? (bf16_t*)(p.ws + W_CKVP) : (bf16_t*)(p.ws + W_CKVS)) + (size_t)lr * 512 + lane * 8; float f[8]; unpack8(*(const u32x4*)c, f);
          float ss = 0.f;
#pragma unroll
          for (int e = 0; e < 8; ++e) ss += f[e] * f[e];
          const float rn = rsqrtf(wave_sum(ss) * (1.f / 512.f) + EPS);
#pragma unroll
          for (int e = 0; e < 8; ++e) f[e] *= rn * p.in[I_KVN][lane * 8 + e];
          float* o = p.out + (pr ? O_CKVP : O_CKVS) + (size_t)lr * 512 + lane * 8;
          *(f32x4*)o = (f32x4){f[0], f[1], f[2], f[3]}; *(f32x4*)(o + 4) = (f32x4){f[4], f[5], f[6], f[7]};
          *(u32x4*)c = pack8(f); }
        { bf16_t* k = (pr ? (bf16_t*)(p.ws + W_KRP) : (bf16_t*)(p.ws + W_KRS)) + (size_t)lr * 64; const int i = lane & 31;
          const float x1 = bf2f(k[i]), x2 = bf2f(k[32 + i]); float ss = x1 * x1 + x2 * x2;
#pragma unroll
          for (int o = 1; o < 32; o <<= 1) ss += __shfl_xor(ss, o);
          const float rr = rsqrtf(ss * (1.f / 64.f) + EPS); const float inv = exp2f(-(float)i * (13.287712379549449f / 32.f)); float sn, cs; sincosf(pos * inv, &sn, &cs);
          const float y1 = x1 * rr * p.in[I_KRN][i], y2 = x2 * rr * p.in[I_KRN][32 + i]; const float o1 = y1 * cs - y2 * sn, o2 = y2 * cs + y1 * sn;
          float* o = p.out + (pr ? O_KRP : O_KRS) + (size_t)lr * 64;
          if (lane < 32) { o[i] = o1; o[32 + i] = o2; k[i] = f2bf(o1); k[32 + i] = f2bf(o2); } }
    }
}
__device__ __forceinline__ void e2_phase(const Params& p, bf16_t* KN, int nrows, int wid, int lane) {
    const int gw = blockIdx.x * 8 + wid, NGW = gridDim.x * 8;
    for (int row = gw; row < nrows; row += NGW) { bf16_t* k = KN + (size_t)row * 1024 + lane * 16; float f[16]; unpack8(*(const u32x4*)k, f); unpack8(*(const u32x4*)(k + 8), f + 8);
        float ss = 0.f;
#pragma unroll
        for (int e = 0; e < 16; ++e) ss += f[e] * f[e];
        ss += __shfl_xor(ss, 1); ss += __shfl_xor(ss, 2); ss += __shfl_xor(ss, 4);
        const float rn = rsqrtf(ss * (1.f / 128.f) + EPS);
#pragma unroll
        for (int e = 0; e < 16; ++e) f[e] *= rn * p.in[I_KNN][(lane & 7) * 16 + e];
        *(u32x4*)k = pack8(f); *(u32x4*)(k + 8) = pack8(f + 8); }
}
__device__ __forceinline__ void build_sample_kv(const Params& p, int wid, int lane) {
    const int gw = blockIdx.x * 8 + wid, NGW = gridDim.x * 8;
    bf16_t* CA = (bf16_t*)(p.ws + W_CKVALL); bf16_t* KA = (bf16_t*)(p.ws + W_KRALL);
    for (int R = gw; R < MKS; R += NGW) { const int b = R / TKS, t = R - b * TKS;
        if (t < 2048) { const float* s = p.in[I_CCKV] + ((size_t)b * 2048 + t) * 512 + lane * 8; const f32x4 a = *(const f32x4*)s, c = *(const f32x4*)(s + 4);
            u32x4 w; w.x = pk2(a.x, a.y); w.y = pk2(a.z, a.w); w.z = pk2(c.x, c.y); w.w = pk2(c.z, c.w); *(u32x4*)(CA + (size_t)R * 512 + lane * 8) = w;
            KA[(size_t)R * 64 + lane] = f2bf(p.in[I_CKR][((size_t)b * 2048 + t) * 64 + lane]); }
        else { const int lr = b * 32 + t - 2048; *(u32x4*)(CA + (size_t)R * 512 + lane * 8) = *(const u32x4*)((const bf16_t*)(p.ws + W_CKVS) + (size_t)lr * 512 + lane * 8);
            KA[(size_t)R * 64 + lane] = ((const bf16_t*)(p.ws + W_KRS))[(size_t)lr * 64 + lane]; } }
}
#define MFMA32(a, b, c) __builtin_amdgcn_mfma_f32_32x32x16_bf16((a), (b), (c), 0, 0, 0)
#define MFMA16(a, b, c) __builtin_amdgcn_mfma_f32_16x16x32_bf16((a), (b), (c), 0, 0, 0)
constexpr int AT_KR = 17408, AT_KB = 26624, AT_BUF = 45056;
template <bool SAMPLE>
__device__ __forceinline__ void attn_unit(LAS unsigned char* lds, const bf16_t* Q, int ldq, const bf16_t* KN, int ldkn, const bf16_t* KR, const bf16_t* VT, int ldvt,
                                          int ntiles, int limit, bool active, bf16_t* UB, int tid, int lane) {
    const int r = lane & 31, hh = lane >> 5;
    bf16x8 qf[12];
#pragma unroll
    for (int s = 0; s < 12; ++s) qf[s] = active ? *(const bf16x8*)(Q + (size_t)r * ldq + 16 * s + 8 * hh) : (bf16x8){0, 0, 0, 0, 0, 0, 0, 0};
    f32x16 o[4];
#pragma unroll
    for (int d = 0; d < 4; ++d)
#pragma unroll
        for (int e = 0; e < 16; ++e) o[d][e] = 0.f;
    float m_run = -__builtin_inff(), l_run = 0.f;
    const int wv = __builtin_amdgcn_readfirstlane(tid >> 6);
    unsigned aoff[6];
#pragma unroll
    for (int i_ = 0; i_ < 6; ++i_) { const int ch_ = wv + 8 * i_; unsigned o_ = 0;
        if (ch_ < 17) { const int sg_ = ch_ * 64 + lane, row_ = sg_ / 17; int c_ = sg_ - row_ * 17; c_ = c_ > 15 ? 15 : c_; o_ = (unsigned)(row_ * ldkn + c_ * 8) * 2u; }
        else if (ch_ < 26) { const int sg_ = (ch_ - 17) * 64 + lane, row_ = sg_ / 9; int c_ = sg_ - row_ * 9; c_ = c_ > 7 ? 7 : c_; o_ = (unsigned)(row_ * 64 + c_ * 8) * 2u; }
        else if (ch_ < 44) { const int sg_ = (ch_ - 26) * 64 + lane, row_ = sg_ / 9; int c_ = sg_ - row_ * 9; c_ = c_ > 7 ? 7 : c_; o_ = (unsigned)(row_ * ldvt + c_ * 8) * 2u; }
        aoff[i_] = o_; }
#define AT_ISSUE(j, buf) do { LAS unsigned char* b_ = lds + (buf) * AT_BUF; const char* kn_ = (const char*)KN + (size_t)(j) * 128 * ldkn; const char* kr_ = (const char*)KR + (size_t)(j) * 8192; const char* vt_ = (const char*)VT + (size_t)(j) * 128; \
        _Pragma("unroll") for (int i_ = 0; i_ < 6; ++i_) { const int ch_ = wv + 8 * i_; unsigned o_ = aoff[i_]; asm volatile("" : "+v"(o_)); \
        if (ch_ < 17) __builtin_amdgcn_global_load_lds((const unsigned*)(kn_ + o_), (LAS unsigned*)(b_ + ch_ * 1024), 16, 0, 0); \
        else if (ch_ < 26) __builtin_amdgcn_global_load_lds((const unsigned*)(kr_ + o_), (LAS unsigned*)(b_ + AT_KR + (ch_ - 17) * 1024), 16, 0, 0); \
        else if (ch_ < 44) __builtin_amdgcn_global_load_lds((const unsigned*)(vt_ + o_), (LAS unsigned*)(b_ + AT_KB + (ch_ - 26) * 1024), 16, 0, 0); } } while (0)
    AT_ISSUE(0, 0); __syncthreads();
    for (int j = 0; j < ntiles; ++j) {
        const bool more = (j + 1 < ntiles);
        if (more) AT_ISSUE(j + 1, (j + 1) & 1);
        if (active && j <= limit) {
            const LAS unsigned char* kb = lds + (j & 1) * AT_BUF; const LAS unsigned char* vb = kb + AT_KB;
            f32x16 s0, s1;
#pragma unroll
            for (int e = 0; e < 16; ++e) { s0[e] = 0.f; s1[e] = 0.f; }
#pragma unroll
            for (int s = 0; s < 12; ++s) { const LAS unsigned char* ka = s < 8 ? kb + r * 272 + s * 32 + hh * 16 : kb + AT_KR + r * 144 + (s - 8) * 32 + hh * 16; const int rs32 = s < 8 ? 32 * 272 : 32 * 144;
                const bf16x8 a0 = *(const LAS bf16x8*)ka, a1 = *(const LAS bf16x8*)(ka + rs32);
                s0 = MFMA32(a0, qf[s], s0); s1 = MFMA32(a1, qf[s], s1); if ((s & 3) == 3) __builtin_amdgcn_sched_barrier(0); }
            if (SAMPLE && j == ntiles - 1) {
#pragma unroll
                for (int e = 0; e < 16; ++e) s1[e] = -__builtin_inff(); }
            float mx = s0[0];
#pragma unroll
            for (int e = 1; e < 16; ++e) mx = fmaxf(mx, s0[e]);
#pragma unroll
            for (int e = 0; e < 16; ++e) mx = fmaxf(mx, s1[e]);
            mx = fmaxf(mx, __shfl_xor(mx, 32));
            const float mn = fmaxf(m_run, mx), alpha = __builtin_amdgcn_exp2f(m_run - mn); m_run = mn;
            float ps = 0.f;
#pragma unroll
            for (int e = 0; e < 16; ++e) { s0[e] = __builtin_amdgcn_exp2f(s0[e] - mn); s1[e] = __builtin_amdgcn_exp2f(s1[e] - mn); ps += s0[e] + s1[e]; }
            l_run = l_run * alpha + ps;
#pragma unroll
            for (int d = 0; d < 4; ++d)
#pragma unroll
                for (int e = 0; e < 16; ++e) o[d][e] *= alpha;
            bf16x8 pf[4];
#pragma unroll
            for (int sp = 0; sp < 4; ++sp) { const int hf = sp & 1; u32x4 w;
                if (sp < 2) { w.x = pk2(s0[8 * hf + 0], s0[8 * hf + 1]); w.y = pk2(s0[8 * hf + 2], s0[8 * hf + 3]); w.z = pk2(s0[8 * hf + 4], s0[8 * hf + 5]); w.w = pk2(s0[8 * hf + 6], s0[8 * hf + 7]); }
                else        { w.x = pk2(s1[8 * hf + 0], s1[8 * hf + 1]); w.y = pk2(s1[8 * hf + 2], s1[8 * hf + 3]); w.z = pk2(s1[8 * hf + 4], s1[8 * hf + 5]); w.w = pk2(s1[8 * hf + 6], s1[8 * hf + 7]); }
                pf[sp] = __builtin_bit_cast(bf16x8, w); }
#pragma unroll
            for (int d = 0; d < 4; ++d) { __builtin_amdgcn_sched_barrier(0);
#pragma unroll
                for (int sp = 0; sp < 4; ++sp) { const LAS unsigned char* va = vb + (32 * d + r) * 144 + (16 * sp + 4 * hh) * 2;
                    const u32x2 lo = *(const LAS u32x2*)va, hi = *(const LAS u32x2*)(va + 16); const u32x4 w = {lo.x, lo.y, hi.x, hi.y};
                    o[d] = MFMA32(__builtin_bit_cast(bf16x8, w), pf[sp], o[d]); } }
        }
        __syncthreads();
    }
#undef AT_ISSUE
    if (active) {
        const float lt = l_run + __shfl_xor(l_run, 32), inv = 1.f / lt;
        int r2 = r, h2 = hh; asm volatile("" : "+v"(r2), "+v"(h2));
        char* ub = (char*)UB;
#pragma unroll
        for (int d = 0; d < 4; ++d)
#pragma unroll
            for (int g4 = 0; g4 < 4; ++g4) { bf16_t* up = (bf16_t*)(ub + (unsigned)(r2 * 1024 + 32 * d + 8 * g4 + 4 * h2) * 2u); const u32x2 z = *(const u32x2*)up;
                const float z0 = bflo(z.x), z1 = bfhi(z.x), z2 = bflo(z.y), z3 = bfhi(z.y);
                u32x2 w; w.x = pk2(o[d][4 * g4 + 0] * inv * siluf_(z0), o[d][4 * g4 + 1] * inv * siluf_(z1)); w.y = pk2(o[d][4 * g4 + 2] * inv * siluf_(z2), o[d][4 * g4 + 3] * inv * siluf_(z3));
                *(u32x2*)up = w; }
    }
}
__device__ __forceinline__ void attn_prompt_phase(const Params& p, LAS unsigned char* lds, int tid, int wid, int lane) {
    const int G = gridDim.x, bx = blockIdx.x; const int vcu = (G % 8 == 0) ? (bx % 8) * (G / 8) + bx / 8 : bx;
    for (int item = vcu; item < 512; item += G) {
        const int pr = item & 255, bh = pr >> 4, pi = pr & 15, qb = item < 256 ? 31 - pi : pi, b = bh >> 3, h = bh & 7;
        const size_t tok0 = (size_t)b * 8192; const int q0 = qb * 256 + wid * 32;
        attn_unit<false>(lds, (const bf16_t*)(p.ws + W_QP) + (tok0 + q0) * 1536 + h * 192, 1536, (const bf16_t*)(p.ws + W_KN) + tok0 * 1024 + h * 128, 1024,
                         (const bf16_t*)(p.ws + W_KRP) + tok0 * 64, (const bf16_t*)(p.ws + W_VT) + (size_t)(h * 128) * MP + tok0, MP,
                         4 * qb + 4, 4 * qb + (wid >> 1), true, (bf16_t*)(p.ws + W_UBP) + (tok0 + q0) * 1024 + h * 128, tid, lane);
    }
}
__device__ __forceinline__ void attn_sample_phase(const Params& p, LAS unsigned char* lds, int tid, int wid, int lane) {
    const int G = gridDim.x, bx = blockIdx.x; const int vcu = (G % 8 == 0) ? (bx % 8) * (G / 8) + bx / 8 : bx;
    for (int item = vcu; item < 128; item += G) { const int b = item >> 3, h = item & 7; const size_t tok0 = (size_t)b * TKS;
        attn_unit<true>(lds, (const bf16_t*)(p.ws + W_QS) + (size_t)(b * 32) * 1536 + h * 192, 1536, (const bf16_t*)(p.ws + W_KNS) + tok0 * 1024 + h * 128, 1024,
                        (const bf16_t*)(p.ws + W_KRALL) + tok0 * 64, (const bf16_t*)(p.ws + W_VTS) + (size_t)(h * 128) * MKS + tok0, MKS,
                        33, 33, wid == 0, (bf16_t*)(p.ws + W_UBS) + (size_t)(b * 32) * 1024 + h * 128, tid, lane);
    }
}
constexpr int PR_KH = 0, PR_QH = 17408, PR_KT = 34816, PR_LM = 53248, PR_TB = 70656, PR_AT = 78848, PR_VEC = 87040, PR_TL = 88064;
__device__ __forceinline__ void prep_conv(const Params& p, float (&acc)[16], int part, bool smp, bool valid, int b, int h, int n, int row, int cg, size_t grow0) {
    const bf16_t* QKV = (const bf16_t*)(p.ws + W_QKV); const bf16_t* HALO = (const bf16_t*)(p.ws + W_HALO);
    const int col0 = part * 1024 + h * 128 + cg * 16;
#pragma unroll
    for (int e = 0; e < 16; ++e) acc[e] = 0.f;
#pragma unroll 1
    for (int i = 0; i < 4; ++i) { const int tt = row - 3 + i; float x[16];
#pragma unroll
        for (int e = 0; e < 16; ++e) x[e] = 0.f;
        if (valid) {
            if (tt >= 0 || (!smp && n > 0)) { const bf16_t* s = tt >= 0 ? QKV + (grow0 + tt) * 3072 + col0 : HALO + (((size_t)(b * 128 + n - 1)) * 3 + (tt + 3)) * 3072 + col0;
                unpack8(*(const u32x4*)s, x); unpack8(*(const u32x4*)(s + 8), x + 8); }
            else if (smp) { const float* s = p.in[I_SC] + ((size_t)b * 3 + (tt + 3)) * 3072 + col0;
#pragma unroll
                for (int e = 0; e < 4; ++e) { const f32x4 v = *(const f32x4*)(s + 4 * e); x[4 * e] = v.x; x[4 * e + 1] = v.y; x[4 * e + 2] = v.z; x[4 * e + 3] = v.w; } }
        }
        const float* wc = p.in[I_WCONV] + (size_t)i * 3072 + col0;
#pragma unroll
        for (int e = 0; e < 4; ++e) { const f32x4 w = *(const f32x4*)(wc + 4 * e); acc[4 * e] += x[4 * e] * w.x; acc[4 * e + 1] += x[4 * e + 1] * w.y; acc[4 * e + 2] += x[4 * e + 2] * w.z; acc[4 * e + 3] += x[4 * e + 3] * w.w; }
        if (i == 3) {
            float* o = nullptr;
            if (!smp && n == 127 && row >= 61) o = p.out + O_CVP + ((size_t)b * 3 + (row - 61)) * 3072 + col0;
            if (smp && row >= 29 && row < 32) o = p.out + O_CVS + ((size_t)b * 3 + (row - 29)) * 3072 + col0;
            if (o) {
#pragma unroll
                for (int e = 0; e < 4; ++e) *(f32x4*)(o + 4 * e) = (f32x4){x[4 * e], x[4 * e + 1], x[4 * e + 2], x[4 * e + 3]}; }
        }
    }
#pragma unroll
    for (int e = 0; e < 16; ++e) acc[e] = siluf_(acc[e]);
}
__device__ __forceinline__ void prep_unit(const Params& p, LAS unsigned char* lds, int u, int tid, int wid, int lane) {
    const bool smp = u >= 2048; int b, h, n;
    if (!smp) { b = u >> 10; h = (u >> 7) & 7; n = u & 127; } else { b = (u - 2048) >> 3; h = (u - 2048) & 7; n = 0; }
    const int row = tid >> 3, cg = tid & 7; const bool valid = !smp || row < 32;
    const size_t grow0 = smp ? (size_t)MP + b * 32 : (size_t)b * 8192 + n * 64;
    bf16_t* QKV = (bf16_t*)(p.ws + W_QKV);
    LAS float* gv = (LAS float*)(lds + PR_VEC); LAS float* betav = gv + 64; LAS float* gcv = gv + 128;
    if (wid == 0) { float g = 0.f, bt = 0.f;
        if (!smp || lane < 32) { const float* ba = (const float*)(p.ws + W_BA) + (grow0 + lane) * 16; bt = sigmoidf_(ba[h]); const float xx = ba[8 + h] + p.in[I_DTB][h];
            const float sp = xx > 20.f ? xx : log1pf(__expf(xx)); g = -__expf(p.in[I_ALOG][h]) * sp; }
        betav[lane] = bt; float c = g;
#pragma unroll
        for (int o = 1; o < 64; o <<= 1) { const float t = __shfl_up(c, o); if (lane >= o) c += t; }
        gcv[lane] = c; }
    __syncthreads();
    const float gc = gcv[row], eg = __expf(gc), ed = __expf(gcv[63] - gc);
    bf16_t* dq; if (!smp) dq = QKV + (grow0 + row) * 3072 + h * 128 + cg * 16; else dq = (bf16_t*)(p.ws + W_SQKV) + (size_t)(u - 2048) * 3 * 8192 + row * 128 + cg * 16;
    const size_t pstep = smp ? 8192 : 1024;
    LAS bf16_t* KH = (LAS bf16_t*)(lds + PR_KH); LAS bf16_t* QH = (LAS bf16_t*)(lds + PR_QH); LAS bf16_t* KT = (LAS bf16_t*)(lds + PR_KT);
    {   float a[16]; prep_conv(p, a, 0, smp, valid, b, h, n, row, cg, grow0);
        float sq = 0.f;
#pragma unroll
        for (int e = 0; e < 16; ++e) sq += a[e] * a[e];
        sq += __shfl_xor(sq, 1); sq += __shfl_xor(sq, 2); sq += __shfl_xor(sq, 4);
        const float rq = rsqrtf(sq + EPS) * 0.08838834764831845f;
#pragma unroll
        for (int e = 0; e < 16; ++e) a[e] *= rq;
        __syncthreads();
        *(LAS u32x4*)(QH + row * 136 + cg * 16) = pack8(a); *(LAS u32x4*)(QH + row * 136 + cg * 16 + 8) = pack8(a + 8);
#pragma unroll
        for (int e = 0; e < 16; ++e) a[e] *= eg;
        *(u32x4*)dq = pack8(a); *(u32x4*)(dq + 8) = pack8(a + 8); }
    {   float a[16]; prep_conv(p, a, 1, smp, valid, b, h, n, row, cg, grow0);
        float sk = 0.f;
#pragma unroll
        for (int e = 0; e < 16; ++e) sk += a[e] * a[e];
        sk += __shfl_xor(sk, 1); sk += __shfl_xor(sk, 2); sk += __shfl_xor(sk, 4);
        const float rk = rsqrtf(sk + EPS);
#pragma unroll
        for (int e = 0; e < 16; ++e) a[e] *= rk;
        __syncthreads();
        *(LAS u32x4*)(KH + row * 136 + cg * 16) = pack8(a); *(LAS u32x4*)(KH + row * 136 + cg * 16 + 8) = pack8(a + 8);
#pragma unroll
        for (int e = 0; e < 16; ++e) KT[(cg * 16 + e) * 72 + row] = f2bf(a[e] * ed);
#pragma unroll
        for (int e = 0; e < 16; ++e) a[e] *= eg;
        *(u32x4*)(dq + pstep) = pack8(a); *(u32x4*)(dq + pstep + 8) = pack8(a + 8); }
    {   float a[16]; prep_conv(p, a, 2, smp, valid, b, h, n, row, cg, grow0);
        __syncthreads();
        *(u32x4*)(dq + 2 * pstep) = pack8(a); *(u32x4*)(dq + 2 * pstep + 8) = pack8(a + 8); }
    __syncthreads();
    {
        const LAS unsigned char* KHb = lds + PR_KH; const LAS unsigned char* QHb = lds + PR_QH; const int c = lane & 15, g = lane >> 4, mi = wid >> 1;
        f32x4 kk[2], qk[2];
#pragma unroll
        for (int j = 0; j < 2; ++j) { kk[j] = (f32x4){0.f, 0.f, 0.f, 0.f}; qk[j] = kk[j]; }
#pragma unroll
        for (int s = 0; s < 4; ++s) { const bf16x8 aK = *(const LAS bf16x8*)(KHb + (16 * mi + c) * 272 + (32 * s + 8 * g) * 2), aQ = *(const LAS bf16x8*)(QHb + (16 * mi + c) * 272 + (32 * s + 8 * g) * 2);
#pragma unroll
            for (int j = 0; j < 2; ++j) { const int nj = 2 * (wid & 1) + j; const bf16x8 bK = *(const LAS bf16x8*)(KHb + (16 * nj + c) * 272 + (32 * s + 8 * g) * 2);
                kk[j] = MFMA16(aK, bK, kk[j]); qk[j] = MFMA16(aQ, bK, qk[j]); } }
        LAS float* LM = (LAS float*)(lds + PR_LM); LAS bf16_t* ATs = (LAS bf16_t*)(lds + PR_AT);
#pragma unroll
        for (int j = 0; j < 2; ++j) { const int cj = 16 * (2 * (wid & 1) + j) + c; const float gj = gcv[cj];
#pragma unroll
            for (int e = 0; e < 4; ++e) { const int ri = 16 * mi + 4 * g + e; const float dec = (cj <= ri) ? __expf(gcv[ri] - gj) : 0.f;
                LM[ri * 68 + cj] = (cj < ri) ? betav[ri] * kk[j][e] * dec : 0.f; ATs[ri * 64 + cj] = f2bf(qk[j][e] * dec); } }
    }
    __syncthreads();
    if (wid == 0) {
        const LAS float* LM = (const LAS float*)(lds + PR_LM); LAS float* TL = (LAS float*)(lds + PR_TL); LAS bf16_t* TBs = (LAS bf16_t*)(lds + PR_TB); const float bc = betav[lane];
        for (int i = 0; i < 64; ++i) { float a0 = (i == lane) ? 1.f : 0.f, a1 = 0.f, a2 = 0.f, a3 = 0.f; int j = 0;
            for (; j + 4 <= i; j += 4) { const f32x4 l4 = *(const LAS f32x4*)(LM + i * 68 + j);
                a0 -= l4.x * TL[j * 64 + lane]; a1 -= l4.y * TL[(j + 1) * 64 + lane]; a2 -= l4.z * TL[(j + 2) * 64 + lane]; a3 -= l4.w * TL[(j + 3) * 64 + lane]; }
            for (; j < i; ++j) a0 -= LM[i * 68 + j] * TL[j * 64 + lane];
            const float a = (a0 + a1) + (a2 + a3); TL[i * 64 + lane] = a; TBs[i * 64 + lane] = f2bf(a * bc); }
    }
    __syncthreads();
    {   bf16_t* KDT = (bf16_t*)(p.ws + W_KDT) + (size_t)u * 8192; bf16_t* TBG = (bf16_t*)(p.ws + W_TB) + (size_t)u * 8192;
#pragma unroll
        for (int i = 0; i < 2; ++i) { const int pc = tid + 512 * i, r = pc >> 3, c = pc & 7; *(u32x4*)(KDT + r * 64 + c * 8) = *(const LAS u32x4*)(lds + PR_KT + r * 144 + c * 16); }
        { const int r = tid >> 3, c = tid & 7; *(u32x4*)(TBG + r * 64 + c * 8) = *(const LAS u32x4*)(lds + PR_TB + r * 128 + c * 16);
          *(u32x4*)(TBG + 4096 + r * 64 + c * 8) = *(const LAS u32x4*)(lds + PR_AT + r * 128 + c * 16); }
        if (tid == 0) ((float*)(p.ws + W_GL))[u] = __expf(gcv[63]);
    }
    __syncthreads();
}
constexpr int SC_KG = 0, SC_QG = 17408, SC_KD = 34816, SC_TB = 53248, SC_AT = 62464, SC_V = 71680, SC_WV = 88064, SC_WVB = 6656, SC_EX = 141312;
__device__ __forceinline__ void scan_chain(const Params& p, LAS unsigned char* lds, int ci, int tid, int wid, int lane) {
    const bool smp = ci >= 16; const int b = smp ? (ci - 16) >> 3 : ci >> 3, h = smp ? (ci - 16) & 7 : ci & 7; const int nsteps = smp ? 1 : 128;
    const int c = lane & 15, g = lane >> 4;
    f32x4 S[8];
#pragma unroll
    for (int mb = 0; mb < 8; ++mb) { if (smp) { const float* sd = p.in[I_SD] + ((size_t)(b * 8 + h) * 128) * 128;
#pragma unroll
            for (int e = 0; e < 4; ++e) S[mb][e] = *(const float*)((const char*)(sd + 16 * wid) + (unsigned)((16 * mb + 4 * g + e) * 128 + c) * 4u); } else S[mb] = (f32x4){0.f, 0.f, 0.f, 0.f}; }
    const int u0 = smp ? 2048 + (ci - 16) : (b * 8 + h) * 128;
    const bf16_t* qb0; size_t rstride, ustride;
    if (!smp) { qb0 = (const bf16_t*)(p.ws + W_QKV) + ((size_t)b * 8192) * 3072 + h * 128; rstride = 3072; ustride = (size_t)64 * 3072; }
    else { qb0 = (const bf16_t*)(p.ws + W_SQKV) + (size_t)(ci - 16) * 3 * 8192; rstride = 128; ustride = 0; }
    const size_t koff = smp ? 8192 : 1024, voff = smp ? 16384 : 2048;
    const bf16_t* KDT = (const bf16_t*)(p.ws + W_KDT) + (size_t)u0 * 8192; const bf16_t* TBG = (const bf16_t*)(p.ws + W_TB) + (size_t)u0 * 8192; const float* GLp = (const float*)(p.ws + W_GL) + u0;
    u32x4 rq[2], rk[2], rv[2], rd[2], rt, ra; float gl_next;
    const unsigned oq0 = (unsigned)((tid >> 4) * rstride + (tid & 15) * 8) * 2u, oq1 = (unsigned)(((tid + 512) >> 4) * rstride + (tid & 15) * 8) * 2u, od0 = (unsigned)tid * 16u, od1 = (unsigned)(tid + 512) * 16u;
#define SC_ISSUE(st) do { const char* qb_ = (const char*)(qb0 + (size_t)(st) * ustride); const char* kb_ = qb_ + koff * 2; const char* vb_ = qb_ + voff * 2; const char* db_ = (const char*)(KDT + (size_t)(st) * 8192); const char* tb_ = (const char*)(TBG + (size_t)(st) * 8192); \
        rq[0] = *(const u32x4*)(qb_ + oq0); rq[1] = *(const u32x4*)(qb_ + oq1); rk[0] = *(const u32x4*)(kb_ + oq0); rk[1] = *(const u32x4*)(kb_ + oq1); rv[0] = *(const u32x4*)(vb_ + oq0); rv[1] = *(const u32x4*)(vb_ + oq1); \
        rd[0] = *(const u32x4*)(db_ + od0); rd[1] = *(const u32x4*)(db_ + od1); rt = *(const u32x4*)(tb_ + od0); ra = *(const u32x4*)(tb_ + 8192 + od0); gl_next = GLp[st]; } while (0)
#define SC_WRITE() do { _Pragma("unroll") for (int i_ = 0; i_ < 2; ++i_) { const int pc_ = tid + 512 * i_, r_ = pc_ >> 4, c_ = pc_ & 15; *(LAS u32x4*)(lds + SC_QG + r_ * 272 + c_ * 16) = rq[i_]; *(LAS u32x4*)(lds + SC_KG + r_ * 272 + c_ * 16) = rk[i_]; \
            *(LAS u32x4*)(lds + SC_V + r_ * 256 + c_ * 16) = rv[i_]; const int r2_ = pc_ >> 3, c2_ = pc_ & 7; *(LAS u32x4*)(lds + SC_KD + r2_ * 144 + c2_ * 16) = rd[i_]; } \
        { const int r_ = tid >> 3, c_ = tid & 7; *(LAS u32x4*)(lds + SC_TB + r_ * 144 + c_ * 16) = rt; *(LAS u32x4*)(lds + SC_AT + r_ * 144 + c_ * 16) = ra; } } while (0)
    LAS unsigned char* ST = lds + SC_WV + wid * SC_WVB; LAS unsigned char* RT = ST + 4352; LAS float* EX = (LAS float*)(lds + SC_EX);
    const float gain = p.in[I_DNN][16 * wid + c];
    SC_ISSUE(0);
    for (int st = 0; st < nsteps; ++st) {
        __syncthreads();
        SC_WRITE(); const float gl = gl_next;
        __syncthreads();
        if (st + 1 < nsteps) SC_ISSUE(st + 1);
#pragma unroll
        for (int mb = 0; mb < 8; ++mb) { u32x2 w; w.x = pk2(S[mb][0], S[mb][1]); w.y = pk2(S[mb][2], S[mb][3]); *(LAS u32x2*)(ST + c * 272 + (16 * mb + 4 * g) * 2) = w; }
        f32x4 aK[4];
#pragma unroll
        for (int mb = 0; mb < 4; ++mb) aK[mb] = (f32x4){0.f, 0.f, 0.f, 0.f};
#pragma unroll
        for (int s = 0; s < 4; ++s) { const bf16x8 bS = *(const LAS bf16x8*)(ST + c * 272 + (32 * s + 8 * g) * 2);
#pragma unroll
            for (int mb = 0; mb < 4; ++mb) aK[mb] = MFMA16(*(const LAS bf16x8*)(lds + SC_KG + (16 * mb + c) * 272 + (32 * s + 8 * g) * 2), bS, aK[mb]); }
        __builtin_amdgcn_sched_barrier(0);
#pragma unroll
        for (int mb = 0; mb < 4; ++mb) { float rr[4];
#pragma unroll
            for (int e = 0; e < 4; ++e) rr[e] = bf2f(*(const LAS bf16_t*)(lds + SC_V + (16 * mb + 4 * g + e) * 256 + (16 * wid + c) * 2)) - aK[mb][e];
            u32x2 w; w.x = pk2(rr[0], rr[1]); w.y = pk2(rr[2], rr[3]); *(LAS u32x2*)(RT + c * 144 + (16 * mb + 4 * g) * 2) = w; }
        __builtin_amdgcn_sched_barrier(0);
        { const bf16x8 b0 = *(const LAS bf16x8*)(RT + c * 144 + (8 * g) * 2), b1 = *(const LAS bf16x8*)(RT + c * 144 + (32 + 8 * g) * 2);
#pragma unroll
          for (int mb = 0; mb < 4; ++mb) { aK[mb] = (f32x4){0.f, 0.f, 0.f, 0.f};
              aK[mb] = MFMA16(*(const LAS bf16x8*)(lds + SC_TB + (16 * mb + c) * 144 + (8 * g) * 2), b0, aK[mb]);
              aK[mb] = MFMA16(*(const LAS bf16x8*)(lds + SC_TB + (16 * mb + c) * 144 + (32 + 8 * g) * 2), b1, aK[mb]); } }
        asm volatile("s_waitcnt lgkmcnt(0)" ::: "memory");
#pragma unroll
        for (int mb = 0; mb < 4; ++mb) { u32x2 w; w.x = pk2(aK[mb][0], aK[mb][1]); w.y = pk2(aK[mb][2], aK[mb][3]); *(LAS u32x2*)(RT + c * 144 + (16 * mb + 4 * g) * 2) = w; }
        __builtin_amdgcn_sched_barrier(0);
        f32x4 aQ[4];
#pragma unroll
        for (int mb = 0; mb < 4; ++mb) aQ[mb] = (f32x4){0.f, 0.f, 0.f, 0.f};
#pragma unroll
        for (int s = 0; s < 4; ++s) { const bf16x8 bS = *(const LAS bf16x8*)(ST + c * 272 + (32 * s + 8 * g) * 2);
#pragma unroll
            for (int mb = 0; mb < 4; ++mb) aQ[mb] = MFMA16(*(const LAS bf16x8*)(lds + SC_QG + (16 * mb + c) * 272 + (32 * s + 8 * g) * 2), bS, aQ[mb]); }
        __builtin_amdgcn_sched_barrier(0);
        { const bf16x8 b0 = *(const LAS bf16x8*)(RT + c * 144 + (8 * g) * 2), b1 = *(const LAS bf16x8*)(RT + c * 144 + (32 + 8 * g) * 2);
#pragma unroll
          for (int mb = 0; mb < 4; ++mb) { aQ[mb] = MFMA16(*(const LAS bf16x8*)(lds + SC_AT + (16 * mb + c) * 144 + (8 * g) * 2), b0, aQ[mb]);
              aQ[mb] = MFMA16(*(const LAS bf16x8*)(lds + SC_AT + (16 * mb + c) * 144 + (32 + 8 * g) * 2), b1, aQ[mb]); }
          __builtin_amdgcn_sched_barrier(0);
#pragma unroll
          for (int mb = 0; mb < 8; ++mb) { S[mb] = S[mb] * gl;
              S[mb] = MFMA16(*(const LAS bf16x8*)(lds + SC_KD + (16 * mb + c) * 144 + (8 * g) * 2), b0, S[mb]);
              S[mb] = MFMA16(*(const LAS bf16x8*)(lds + SC_KD + (16 * mb + c) * 144 + (32 + 8 * g) * 2), b1, S[mb]); } }
        __builtin_amdgcn_sched_barrier(0);
#pragma unroll
        for (int mb = 0; mb < 4; ++mb)
#pragma unroll
            for (int e = 0; e < 4; ++e) { float q = aQ[mb][e] * aQ[mb][e]; q += __shfl_xor(q, 1); q += __shfl_xor(q, 2); q += __shfl_xor(q, 4); q += __shfl_xor(q, 8);
                if (c == 0) EX[(16 * mb + 4 * g + e) * 8 + wid] = q; }
        __syncthreads();
        { int c2 = c, g2 = g; asm volatile("" : "+v"(c2), "+v"(g2));
          char* ubase = smp ? (char*)((bf16_t*)(p.ws + W_UAS) + (size_t)(b * 32) * 1024 + h * 128 + 16 * wid) : (char*)((bf16_t*)(p.ws + W_UAP) + ((size_t)b * 8192 + st * 64) * 1024 + h * 128 + 16 * wid);
#pragma unroll
          for (int mb = 0; mb < 4; ++mb)
#pragma unroll
            for (int e = 0; e < 4; ++e) { const int rw = 16 * mb + 4 * g2 + e; const f32x4 x0 = *(const LAS f32x4*)(EX + rw * 8), x1 = *(const LAS f32x4*)(EX + rw * 8 + 4);
                const float rn = rsqrtf(((x0.x + x0.y) + (x0.z + x0.w) + (x1.x + x1.y) + (x1.z + x1.w)) * (1.f / 128.f) + EPS);
                if (!smp || rw < 32) { bf16_t* up = (bf16_t*)(ubase + (unsigned)(rw * 1024 + c2) * 2u);
                    *up = f2bf(aQ[mb][e] * rn * gain * siluf_(bf2f(*up))); } } }
    }
#undef SC_ISSUE
#undef SC_WRITE
    { int c2 = c, g2 = g; asm volatile("" : "+v"(c2), "+v"(g2));
      char* so = (char*)(p.out + (smp ? O_SDS : O_SDP) + ((size_t)(b * 8 + h) * 128) * 128 + 16 * wid);
#pragma unroll
      for (int mb = 0; mb < 8; ++mb)
#pragma unroll
        for (int e = 0; e < 4; ++e) *(float*)(so + (unsigned)((16 * mb + 4 * g2 + e) * 128 + c2) * 4u) = S[mb][e]; }
    __syncthreads();
}
template <class Epi>
__device__ __forceinline__ void run_gemm(LAS unsigned char* lds, const pg8::Gemm& g, const Epi& E) {
    pg8::StaticOrder S; S.init(g.M, g.N, (int)gridDim.x, (int)blockIdx.x);
    pg8::gemm_phase<Epi, pg8::StaticOrder, true, true>((PG8_LAS unsigned char*)lds, g, S, E);
}
__device__ __forceinline__ pg8::Gemm mk_gemm(const bf16_t* A, const bf16_t* As, int pm_split, const bf16_t* Bt, int M, int N, int K, int lda, int ldb) {
    pg8::Gemm g; g.A = A; g.As = As ? As : A; g.A2 = A; g.A2s = g.As; g.Bt = Bt; g.M = M; g.N = N; g.K = K; g.lda = lda; g.ldb = ldb; g.pm_split = pm_split; g.nt1 = K / 64; return g;
}
#ifndef PH_LO
#define PH_LO 0
#endif
#ifndef PH_HI
#define PH_HI 16
#endif
__global__ void __launch_bounds__(512, 2) hybrid_fwd(Params p_arg) {
    extern __shared__ __attribute__((aligned(16))) unsigned char lds_raw[];
    LAS unsigned char* lds = (LAS unsigned char*)lds_raw;
    cg::grid_group grid = cg::this_grid();
#define PH(k) if (PH_LO <= (k) && (k) < PH_HI)
#if defined(__HIP_DEVICE_COMPILE__)
#define LOADP() Params p; { const __attribute__((address_space(4))) Params* kp_ = (const __attribute__((address_space(4))) Params*)__builtin_amdgcn_kernarg_segment_ptr(); asm volatile("" : "+s"(kp_)); p = *(const Params*)kp_; } unsigned char* ws = p.ws; (void)ws; int tid = threadIdx.x; asm volatile("" : "+v"(tid)); const int lane = tid & 63, wid = __builtin_amdgcn_readfirstlane(tid >> 6); (void)lane; (void)wid
#else
#define LOADP() Params p = p_arg; unsigned char* ws = p.ws; (void)ws; int tid = threadIdx.x; const int lane = tid & 63, wid = tid >> 6; (void)lane; (void)wid
#endif
#define SYNC(k) if (PH_LO <= (k) && (k) + 1 < PH_HI) grid.sync()
    PH(0) { LOADP(); p0_phase(p, lds, tid, wid, lane); } SYNC(0);
    PH(1) { LOADP(); p1_phase(p, wid, lane); } SYNC(1);
    PH(2) { LOADP();
        pg8::Gemm g = mk_gemm((const bf16_t*)(p.out + O_CKVP), (const bf16_t*)(p.out + O_CKVS), 64, (const bf16_t*)(ws + W_BT_DN), MT, 4352, 1024, 1024, 1024);
        EpiProj E{0, ws, p.out}; run_gemm(lds, g, E); } SYNC(2);
    PH(3) { LOADP(); for (int u = blockIdx.x; u < 2176; u += gridDim.x) prep_unit(p, lds, u, tid, wid, lane); } SYNC(3);
    PH(4) { LOADP(); for (int ci = blockIdx.x; ci < 144; ci += gridDim.x) scan_chain(p, lds, ci, tid, wid, lane); } SYNC(4);
    PH(5) { LOADP();
        pg8::Gemm g = mk_gemm((const bf16_t*)(p.out + O_CKVP), (const bf16_t*)(p.out + O_CKVS), 64, (const bf16_t*)(ws + W_BT_MLA), MT, 5376, 1024, 1024, 1024);
        EpiProj E{1, ws, p.out}; run_gemm(lds, g, E); } SYNC(5);
    PH(6) { LOADP(); e1_phase(p, wid, lane); } SYNC(6);
    PH(7) { LOADP();
        { pg8::Gemm g = mk_gemm((const bf16_t*)(ws + W_CKVP), nullptr, 1 << 20, (const bf16_t*)(ws + W_BT_UKV), MP, 1024, 512, 512, 512); EpiStore E{(bf16_t*)(ws + W_KN), 1024}; run_gemm(lds, g, E); }
        { pg8::Gemm g = mk_gemm((const bf16_t*)(ws + W_BT_UKV) + (size_t)1024 * 512, nullptr, 1 << 20, (const bf16_t*)(ws + W_CKVP), 1024, MP, 512, 512, 512); EpiStore E{(bf16_t*)(ws + W_VT), MP}; run_gemm(lds, g, E); } } SYNC(7);
    PH(8) { LOADP(); e2_phase(p, (bf16_t*)(ws + W_KN), MP, wid, lane); } SYNC(8);
    PH(9) { LOADP(); attn_prompt_phase(p, lds, tid, wid, lane); } SYNC(9);
    PH(10) { LOADP();
        pg8::Gemm g = mk_gemm((const bf16_t*)(ws + W_UAP), nullptr, 1 << 20, (const bf16_t*)(ws + W_BT_O), MP, 1024, 2048, 1024, 2048); g.A2 = (const bf16_t*)(ws + W_UBP); g.A2s = g.A2; g.nt1 = 16;
        EpiMerge E{(const bf16_t*)(p.out + O_YP), (bf16_t*)(ws + W_MRGP)}; run_gemm(lds, g, E);
        build_sample_kv(p, wid, lane); } SYNC(10);
    PH(11) { LOADP();
        { pg8::Gemm g = mk_gemm((const bf16_t*)(ws + W_MRGP), nullptr, 1 << 20, (const bf16_t*)(ws + W_BT_OUT), MP, 1024, 1024, 1024, 1024);
          EpiOut E{p.in[I_XP], p.out + O_YP, (const float*)(ws + W_MOD), 8192, 0}; run_gemm(lds, g, E); }
        { pg8::Gemm g = mk_gemm((const bf16_t*)(ws + W_CKVALL), nullptr, 1 << 20, (const bf16_t*)(ws + W_BT_UKV), MKS, 1024, 512, 512, 512); EpiStore E{(bf16_t*)(ws + W_KNS), 1024}; run_gemm(lds, g, E); }
        { pg8::Gemm g = mk_gemm((const bf16_t*)(ws + W_BT_UKV) + (size_t)1024 * 512, nullptr, 1 << 20, (const bf16_t*)(ws + W_CKVALL), 1024, MKS, 512, 512, 512); EpiStore E{(bf16_t*)(ws + W_VTS), MKS}; run_gemm(lds, g, E); } } SYNC(11);
    PH(12) { LOADP(); e2_phase(p, (bf16_t*)(ws + W_KNS), MKS, wid, lane); } SYNC(12);
    PH(13) { LOADP(); attn_sample_phase(p, lds, tid, wid, lane); } SYNC(13);
    PH(14) { LOADP(); pg8::Gemm g = mk_gemm((const bf16_t*)(ws + W_UAS), nullptr, 1 << 20, (const bf16_t*)(ws + W_BT_O), MS, 1024, 2048, 1024, 2048); g.A2 = (const bf16_t*)(ws + W_UBS); g.A2s = g.A2; g.nt1 = 16;
        EpiMerge E{(const bf16_t*)(p.out + O_YS), (bf16_t*)(ws + W_MRGS)}; run_gemm(lds, g, E); } SYNC(14);
    PH(15) { LOADP(); pg8::Gemm g = mk_gemm((const bf16_t*)(ws + W_MRGS), nullptr, 1 << 20, (const bf16_t*)(ws + W_BT_OUT), MS, 1024, 1024, 1024, 1024);
        EpiOut E{p.in[I_XS], p.out + O_YS, (const float*)(ws + W_MOD), 32, 2}; run_gemm(lds, g, E); }
}

extern "C" void kernel_launch(void* const* d_in, const int* in_sizes, int n_in, void* d_out, int out_size, void* d_ws, size_t ws_size, hipStream_t stream) {
    static int grid = 0;
    if (grid == 0) {
        int dev = 0, cus = 0, per_cu = 0;
        if (n_in != 26 || ws_size < 256 * MiB) { fprintf(stderr, "kernel_launch: unexpected n_in %d / ws %zu\n", n_in, ws_size); grid = -1; return; }
        hipGetDevice(&dev); hipDeviceGetAttribute(&cus, hipDeviceAttributeMultiprocessorCount, dev);
        if (hipFuncSetAttribute((const void*)hybrid_fwd, hipFuncAttributeMaxDynamicSharedMemorySize, LDS_BYTES) != hipSuccess) { fprintf(stderr, "kernel_launch: hipFuncSetAttribute failed\n"); }
        if (hipOccupancyMaxActiveBlocksPerMultiprocessor(&per_cu, (const void*)hybrid_fwd, 512, LDS_BYTES) != hipSuccess || per_cu < 1) { fprintf(stderr, "kernel_launch: occupancy query says %d\n", per_cu); per_cu = 1; }
        (void)hipGetLastError();
        grid = cus;
    }
    if (grid < 0) return;
    Params p{};
    for (int i = 0; i < 26; ++i) p.in[i] = (const float*)d_in[i];
    p.out = (float*)d_out; p.ws = (unsigned char*)d_ws;
    void* args[] = {&p};
    hipError_t e = hipLaunchCooperativeKernel((const void*)hybrid_fwd, dim3(grid), dim3(512), args, LDS_BYTES, stream);
    if (e != hipSuccess) fprintf(stderr, "cooperative launch failed: %s (grid %d)\n", hipGetErrorString(e), grid);
}
```

```cpp
#include <hip/hip_runtime.h>
#include <hip/hip_cooperative_groups.h>
#include <cstdio>
#include <cstdint>
namespace cg = cooperative_groups;
namespace pg8 {
#define PG8_LAS __attribute__((address_space(3)))
typedef unsigned short bf16_t;
typedef short bf16x8 __attribute__((ext_vector_type(8)));
typedef float f32x4 __attribute__((ext_vector_type(4)));
typedef unsigned u32x4 __attribute__((ext_vector_type(4)));
constexpr int BM = 256, BK = 64, HALF = 128, HTB = HALF * BK * 2  , STAGE_BYTES = 8 * HTB, NXCD = 8, WGM = 8;

__host__ __device__ __forceinline__ int lds_byte(int r, int c) { const int st = (r >> 4) * 2 + (c >> 5), rr = r & 15, cc = c & 31, ob = rr * 64 + cc * 2; return st * 1024 + (ob ^ (((ob >> 9) & 1) << 5)); }
__host__ __device__ __forceinline__ void stage_rc(int b, int& R, int& C) { const int st = b / 1024, sb = b % 1024, swz = sb ^ (((sb >> 9) & 1) << 5); R = (st >> 1) * 16 + swz / 64; C = (st & 1) * 32 + (swz % 64) / 2; }
__host__ __device__ __forceinline__ int perm32(int rho) { const int n = rho >> 4, i = rho & 15; return 8 * (i >> 2) + 4 * n + (i & 3); }

struct Unit { int pm, pn; };
struct Gemm { const bf16_t* A; const bf16_t* As; const bf16_t* A2; const bf16_t* A2s; const bf16_t* Bt; int M, N, K, lda, ldb, pm_split, nt1; };

struct StaticOrder {
    int nM, nN, nwg, G, c;
    __host__ __device__ void init(int M, int N, int G_, int c_) { nM = M / BM; nN = N / BM; nwg = nM * nN; G = G_; c = c_; }
    __host__ __device__ bool next(int i, Unit& u) const {
        const long L = (long)i * G + c; if (L >= nwg) return false;
        int wgid = (int)L; { const int q = nwg / NXCD, r = nwg % NXCD, xcd = wgid % NXCD, off = wgid / NXCD; wgid = (xcd < r ? xcd * (q + 1) : r * (q + 1) + (xcd - r) * q) + off; }
        const int nig = WGM * nN, gid = wgid / nig, fm = gid * WGM, gsz = (nM - fm) < WGM ? (nM - fm) : WGM;
        u.pm = fm + ((wgid % nig) % gsz); u.pn = (wgid % nig) / gsz; return true;
    }
    __device__ __forceinline__ void a_ready(const Unit&) const {}
    __device__ __forceinline__ void done(const Unit&) const {}
};

__device__ __forceinline__ unsigned cvt_pk_bf16(float lo, float hi) { unsigned r; asm volatile("v_cvt_pk_bf16_f32 %0, %1, %2" : "=v"(r) : "v"(lo), "v"(hi)); return r; }

template <class Epi, class Sched, bool ALIGN_EPI = false, bool SP2 = false>
__device__ __forceinline__ void gemm_phase(PG8_LAS unsigned char* lds, const Gemm g, const Sched& S, const Epi& E) {
    int tid_l = threadIdx.x; asm volatile("" : "+v"(tid_l));
    const int tid = tid_l, wid = __builtin_amdgcn_readfirstlane(tid >> 6), lane = tid & 63, wr = wid >> 2, wc = wid & 3, fr = lane & 15, fq = lane >> 4;
    const int K = g.K, nt = K / BK;
    unsigned voffA[2], voffB[2];
#pragma unroll
    for (int i = 0; i < 2; ++i) { int R, C; stage_rc(tid * 16 + i * 8192, R, C); const int Rb = Epi::PERM ? ((R & ~31) + perm32(R & 31)) : R;
        voffA[i] = (unsigned)(R * g.lda + C) * 2u; voffB[i] = (unsigned)(Rb * g.ldb + C) * 2u; }
    const size_t kstep = (size_t)(BK * 2);
    const size_t hstepA = (size_t)HALF * g.lda * 2, hstepB = (size_t)HALF * g.ldb * 2;
    const size_t tstepA = 2 * hstepA, tstepB = 2 * hstepB; const int nt1 = g.nt1;
    const unsigned ldsw = (unsigned)wid * 1024u;
    const int aoff = lds_byte(wr * 64 + fr, fq * 8), boff = lds_byte(wc * 32 + fr, fq * 8);
#define PG8_SA(b, h) (((b) * 2 + (h)) * HTB)
#define PG8_SB(b, h) ((4 + (b) * 2 + (h)) * HTB)
#define PG8_STAGE(bufoff, gbase, voff) do { _Pragma("unroll") for (int _i = 0; _i < 2; ++_i) \
        __builtin_amdgcn_global_load_lds((const unsigned*)((const char*)(gbase) + (voff)[_i]), (PG8_LAS unsigned*)(lds + (bufoff) + ldsw + _i * 8192), 16, 0, 0); } while (0)
#define PG8_LDA(dst, b, h) do { _Pragma("unroll") for (int m = 0; m < 4; ++m) _Pragma("unroll") for (int k = 0; k < 2; ++k) dst[m][k] = *(const PG8_LAS bf16x8*)(lds + PG8_SA(b, h) + aoff + m * 2048 + k * 1024); } while (0)
#define PG8_LDB(dst, b, h) do { _Pragma("unroll") for (int n = 0; n < 2; ++n) _Pragma("unroll") for (int k = 0; k < 2; ++k) dst[n][k] = *(const PG8_LAS bf16x8*)(lds + PG8_SB(b, h) + boff + n * 2048 + k * 1024); } while (0)
#define PG8_MMA(ai, bj, At, Bt) do { __builtin_amdgcn_s_setprio(1); _Pragma("unroll") for (int m = 0; m < 4; ++m) _Pragma("unroll") for (int n = 0; n < 2; ++n) _Pragma("unroll") for (int k = 0; k < 2; ++k) \
        acc[ai][bj][m][n] = __builtin_amdgcn_mfma_f32_16x16x32_bf16(Bt[n][k], At[m][k], acc[ai][bj][m][n], 0, 0, 0); __builtin_amdgcn_s_setprio(0); } while (0)
#define PG8_WAIT_V(n) asm volatile("s_waitcnt vmcnt(" #n ")" ::: "memory")
#define PG8_WAIT_L(n) asm volatile("s_waitcnt lgkmcnt(" #n ")" ::: "memory")
#define PG8_BAR __builtin_amdgcn_s_barrier()
#define PG8_SCHED __builtin_amdgcn_sched_barrier(0)
    Unit cur, nxt; int ui = 0;
    if (!S.next(0, cur)) return;
    f32x4 acc[2][2][4][2];
#pragma unroll
    for (int a = 0; a < 2; ++a)
#pragma unroll
        for (int b = 0; b < 2; ++b)
#pragma unroll
            for (int m = 0; m < 4; ++m)
#pragma unroll
                for (int n = 0; n < 2; ++n) acc[a][b][m][n] = (f32x4){0.f, 0.f, 0.f, 0.f};
    bf16x8 At[4][2], B0[2][2], B1[2][2];
    #define PG8_UA(P, Ps, pm_) ((pm_) < g.pm_split ? (const char*)(P) + (size_t)(pm_) * tstepA : (const char*)(Ps) + (size_t)((pm_) - g.pm_split) * tstepA)
#define PG8_KA(t_) ((t_) < nt1 ? cA + (size_t)(t_) * kstep : cA2 + (size_t)((t_) - nt1) * kstep)
    const char* cA = PG8_UA(g.A, g.As, cur.pm); const char* cA2 = PG8_UA(g.A2, g.A2s, cur.pm); const char* cB = (const char*)g.Bt + (size_t)cur.pn * tstepB;
    S.a_ready(cur);
    if constexpr (SP2) {
        PG8_STAGE(PG8_SB(0, 0), cB, voffB); PG8_STAGE(PG8_SB(0, 1), cB + hstepB, voffB); PG8_STAGE(PG8_SA(0, 0), cA, voffA); PG8_STAGE(PG8_SA(0, 1), cA + hstepA, voffA);
        if (wr == 1) PG8_BAR;
        PG8_WAIT_V(2); PG8_BAR;
        PG8_STAGE(PG8_SB(1, 0), cB + kstep, voffB); PG8_STAGE(PG8_SA(1, 0), cA + kstep, voffA); PG8_STAGE(PG8_SB(1, 1), cB + hstepB + kstep, voffB);
        PG8_WAIT_V(6); PG8_BAR;
    } else {
        PG8_STAGE(PG8_SB(0, 0), cB, voffB); PG8_STAGE(PG8_SA(0, 0), cA, voffA); PG8_STAGE(PG8_SB(0, 1), cB + hstepB, voffB); PG8_STAGE(PG8_SA(0, 1), cA + hstepA, voffA);
        if (wr == 1) PG8_BAR;
        PG8_WAIT_V(4); PG8_BAR;
        PG8_STAGE(PG8_SB(1, 0), cB + kstep, voffB); PG8_STAGE(PG8_SA(1, 0), cA + kstep, voffA); PG8_STAGE(PG8_SB(1, 1), cB + hstepB + kstep, voffB);
        PG8_WAIT_V(6); PG8_BAR;
    }
    for (;;) {
        const bool has_next = S.next(ui + 1, nxt);
        const char* nA = has_next ? PG8_UA(g.A, g.As, nxt.pm) : cA; const char* nA2 = has_next ? PG8_UA(g.A2, g.A2s, nxt.pm) : cA2; const char* nB = has_next ? (const char*)g.Bt + (size_t)nxt.pn * tstepB : cB;
        for (int t = 0; t < nt; t += 2) {
            const bool last = (t == nt - 2);
            if constexpr (Epi::HAS_MID) { if (t == nt1) E.mid(acc, cur, wr, wc, fr, fq); }
            const char* a1 = PG8_KA(t + 1);
            const char* a2 = last ? nA : PG8_KA(t + 2); const char* b2 = last ? nB : cB + (size_t)(t + 2) * kstep;
            const char* a3 = a2 + kstep; const char* b3 = b2 + kstep;
            if (last && has_next) S.a_ready(nxt);
            if constexpr (SP2) {
            PG8_LDB(B0, 0, 0); PG8_LDB(B1, 0, 1); PG8_SCHED; PG8_LDA(At, 0, 0); PG8_STAGE(PG8_SA(1, 1), a1 + hstepA, voffA);
            PG8_WAIT_V(8); PG8_WAIT_L(0); PG8_BAR; PG8_MMA(0, 0, At, B0); PG8_MMA(0, 1, At, B1); PG8_BAR; PG8_SCHED;
            PG8_LDA(At, 0, 1); PG8_STAGE(PG8_SB(0, 0), b2, voffB); PG8_STAGE(PG8_SB(0, 1), b2 + hstepB, voffB); PG8_STAGE(PG8_SA(0, 0), a2, voffA);
            PG8_WAIT_V(8); PG8_WAIT_L(0); PG8_BAR; PG8_MMA(1, 0, At, B0); PG8_MMA(1, 1, At, B1); PG8_BAR; PG8_SCHED;
            PG8_LDB(B0, 1, 0); PG8_LDB(B1, 1, 1); PG8_SCHED; PG8_LDA(At, 1, 0); PG8_STAGE(PG8_SA(0, 1), a2 + hstepA, voffA);
            PG8_WAIT_V(8); PG8_WAIT_L(0); PG8_BAR; PG8_MMA(0, 0, At, B0); PG8_MMA(0, 1, At, B1); PG8_BAR; PG8_SCHED;
            PG8_LDA(At, 1, 1); PG8_STAGE(PG8_SB(1, 0), b3, voffB); PG8_STAGE(PG8_SB(1, 1), b3 + hstepB, voffB); PG8_STAGE(PG8_SA(1, 0), a3, voffA);
            PG8_WAIT_V(8); PG8_WAIT_L(0); PG8_BAR; PG8_MMA(1, 0, At, B0); PG8_MMA(1, 1, At, B1); PG8_BAR; PG8_SCHED;
            } else {
            PG8_LDB(B0, 0, 0); PG8_SCHED; PG8_LDA(At, 0, 0); PG8_STAGE(PG8_SA(1, 1), a1 + hstepA, voffA);
            PG8_WAIT_L(8); PG8_BAR; PG8_WAIT_L(0); PG8_MMA(0, 0, At, B0); PG8_BAR; PG8_SCHED;
            PG8_LDB(B1, 0, 1); PG8_STAGE(PG8_SB(0, 0), b2, voffB);
            PG8_BAR; PG8_WAIT_L(0); PG8_MMA(0, 1, At, B1); PG8_BAR;
            PG8_LDA(At, 0, 1); PG8_STAGE(PG8_SA(0, 0), a2, voffA);
            PG8_BAR; PG8_WAIT_L(0); PG8_MMA(1, 0, At, B0); PG8_BAR; PG8_SCHED;
            PG8_STAGE(PG8_SB(0, 1), b2 + hstepB, voffB);
            PG8_WAIT_V(6); PG8_BAR; PG8_MMA(1, 1, At, B1); PG8_BAR;
            PG8_LDB(B0, 1, 0); PG8_SCHED; PG8_LDA(At, 1, 0); PG8_STAGE(PG8_SA(0, 1), a2 + hstepA, voffA);
            PG8_WAIT_L(8); PG8_BAR; PG8_WAIT_L(0); PG8_MMA(0, 0, At, B0); PG8_BAR; PG8_SCHED;
            PG8_LDB(B1, 1, 1); PG8_STAGE(PG8_SB(1, 0), b3, voffB);
            PG8_BAR; PG8_WAIT_L(0); PG8_MMA(0, 1, At, B1); PG8_BAR;
            PG8_LDA(At, 1, 1); PG8_STAGE(PG8_SA(1, 0), a3, voffA);
            PG8_BAR; PG8_WAIT_L(0); PG8_MMA(1, 0, At, B0); PG8_BAR; PG8_SCHED;
            PG8_STAGE(PG8_SB(1, 1), b3 + hstepB, voffB);
            PG8_WAIT_V(6); PG8_BAR; PG8_MMA(1, 1, At, B1); PG8_BAR;
            }
        }
        if constexpr (ALIGN_EPI) { if (wr == 0) PG8_BAR; }
        if constexpr (!Epi::AFTER_DRAIN) { E(acc, cur, wr, wc, fr, fq); S.done(cur); }
        if (!has_next) break;
#pragma unroll
        for (int a = 0; a < 2; ++a)
#pragma unroll
            for (int b = 0; b < 2; ++b)
#pragma unroll
                for (int m = 0; m < 4; ++m)
#pragma unroll
                    for (int n = 0; n < 2; ++n) acc[a][b][m][n] = (f32x4){0.f, 0.f, 0.f, 0.f};
        cur = nxt; cA = nA; cA2 = nA2; cB = nB; ++ui;
        if constexpr (ALIGN_EPI) { if (wr == 1) PG8_BAR; }
    }
    PG8_WAIT_V(0);
    if constexpr (!ALIGN_EPI) { if (wr == 0) PG8_BAR; }
    PG8_BAR;
    if constexpr (Epi::AFTER_DRAIN) { E.fused(acc, cur, wr, wc, fr, fq, lds, wid, lane); S.done(cur); }
#undef PG8_UA
#undef PG8_KA
#undef PG8_SA
#undef PG8_SB
#undef PG8_STAGE
#undef PG8_LDA
#undef PG8_LDB
#undef PG8_MMA
#undef PG8_WAIT_V
#undef PG8_WAIT_L
#undef PG8_BAR
#undef PG8_SCHED
}
}
#define LAS __attribute__((address_space(3)))
typedef unsigned short bf16_t;
typedef short bf16x8 __attribute__((ext_vector_type(8)));
typedef float f32x4 __attribute__((ext_vector_type(4)));
typedef float f32x16 __attribute__((ext_vector_type(16)));
typedef unsigned u32x4 __attribute__((ext_vector_type(4)));
typedef unsigned u32x2 __attribute__((ext_vector_type(2)));
typedef float f32x2_t __attribute__((ext_vector_type(2)));
typedef __bf16 bf16x2_t __attribute__((ext_vector_type(2)));

constexpr int MP = 16384, MS = 512, MT = MP + MS, TKS = 2080, MKS = 16 * TKS  ;
constexpr float EPS = 1e-6f;
constexpr size_t MiB = 1u << 20;
constexpr size_t W_BT_DN = 1 * MiB, W_BT_MLA = W_BT_DN + (size_t)4352 * 1024 * 2, W_BT_UKV = 20 * MiB, W_BT_O = 22 * MiB, W_BT_OUT = 26 * MiB;
constexpr size_t W_MOD = 28 * MiB, W_GL = 28 * MiB + 256 * 1024, W_BA = 28 * MiB + 512 * 1024;
constexpr size_t W_QS = 30 * MiB, W_CKVS = 31 * MiB + 512 * 1024, W_KRS = 32 * MiB, W_UAS = 33 * MiB, W_UBS = 34 * MiB, W_MRGS = 35 * MiB;
constexpr size_t W_QKV = 36 * MiB, W_HALO = 135 * MiB, W_KDT = 140 * MiB, W_SQKV = 174 * MiB, W_UAP = 190 * MiB, W_TB = 222 * MiB, W_MB = 239 * MiB, W_UBP = 222 * MiB;
constexpr size_t W_QP = 36 * MiB, W_CKVP = 84 * MiB, W_KRP = 100 * MiB, W_KN = 102 * MiB, W_VT = 134 * MiB;
constexpr size_t W_MRGP = 36 * MiB, W_CKVALL = 68 * MiB, W_KRALL = 101 * MiB, W_KNS = 106 * MiB, W_VTS = 172 * MiB;
static_assert(W_BT_MLA + (size_t)5376 * 1024 * 2 <= W_BT_UKV, "ws map");
static_assert(W_BA + (size_t)MT * 16 * 4 <= W_QS, "ws map");
static_assert(W_QKV + (size_t)MT * 3072 * 2 <= W_HALO && W_HALO + (size_t)264 * 3 * 3072 * 2 <= W_KDT && W_KDT + (size_t)2176 * 8192 * 2 <= W_SQKV && W_SQKV + (size_t)128 * 3 * 8192 * 2 <= W_UAP, "ws map");
static_assert(W_TB + (size_t)2176 * 4096 * 2 <= W_MB && W_MB + (size_t)128 * 2 * 16384 * 4 <= 256 * MiB && W_UAP + (size_t)MP * 1024 * 2 <= W_UBP && W_UBP + (size_t)MP * 1024 * 2 <= 256 * MiB, "ws map");
static_assert(W_QP + (size_t)MP * 1536 * 2 <= W_CKVP && W_CKVP + (size_t)MP * 512 * 2 <= W_KRP && W_KRP + (size_t)MP * 64 * 2 <= W_KN && W_KN + (size_t)MP * 1024 * 2 <= W_VT && W_VT + (size_t)MP * 1024 * 2 <= W_UAP, "ws map");
static_assert(W_MRGP + (size_t)MP * 1024 * 2 <= W_CKVALL && W_CKVALL + (size_t)(MKS + 64) * 512 * 2 <= W_KRALL && W_KRALL + (size_t)(MKS + 64) * 64 * 2 <= W_KNS && W_KNS + (size_t)(MKS + 64) * 1024 * 2 <= W_VTS && W_VTS + (size_t)1024 * MKS * 2 + 256 <= 256 * MiB, "ws map");
constexpr size_t O_YP = 0, O_YS = O_YP + (size_t)MP * 1024, O_CKVP = O_YS + (size_t)MS * 1024, O_KRP = O_CKVP + (size_t)MP * 512, O_SDP = O_KRP + (size_t)MP * 64,
                 O_CVP = O_SDP + 2 * 8 * 128 * 128, O_CKVS = O_CVP + 2 * 3 * 3072, O_KRS = O_CKVS + (size_t)MS * 512, O_SDS = O_KRS + (size_t)MS * 64, O_CVS = O_SDS + (size_t)16 * 8 * 128 * 128;
constexpr int LDS_BYTES = 163840;

struct Params { const float* in[26]; float* out; unsigned char* ws; };
enum { I_XP = 0, I_XS, I_CP, I_CS, I_CCKV, I_CKR, I_SD, I_SC, I_NG, I_WADA, I_BADA, I_WIN, I_WCONV, I_ALOG, I_DTB, I_DNN, I_QNN, I_QRN, I_KNN, I_KRN, I_KVN, I_WUK, I_WUV, I_WODN, I_WOMLA, I_WOUT };

__device__ __forceinline__ float bf2f(unsigned short u) { return __uint_as_float((unsigned)u << 16); }
__device__ __forceinline__ float bflo(unsigned u) { return __uint_as_float(u << 16); }
__device__ __forceinline__ float bfhi(unsigned u) { return __uint_as_float(u & 0xffff0000u); }
__device__ __forceinline__ unsigned pk2(float lo, float hi) { f32x2_t v = {lo, hi}; bf16x2_t b = __builtin_convertvector(v, bf16x2_t); return __builtin_bit_cast(unsigned, b); }
__device__ __forceinline__ unsigned short f2bf(float f) { return (unsigned short)(pk2(f, 0.f) & 0xffffu); }
__device__ __forceinline__ float wave_sum(float v) {
#pragma unroll
    for (int o = 1; o < 64; o <<= 1) v += __shfl_xor(v, o);
    return v;
}
__device__ __forceinline__ float sigmoidf_(float x) { return 1.f / (1.f + __expf(-x)); }
__device__ __forceinline__ float siluf_(float x) { return x / (1.f + __expf(-x)); }
__device__ __forceinline__ void unpack8(u32x4 v, float* f) { f[0] = bflo(v.x); f[1] = bfhi(v.x); f[2] = bflo(v.y); f[3] = bfhi(v.y); f[4] = bflo(v.z); f[5] = bfhi(v.z); f[6] = bflo(v.w); f[7] = bfhi(v.w); }
__device__ __forceinline__ u32x4 pack8(const float* f) { u32x4 v; v.x = pk2(f[0], f[1]); v.y = pk2(f[2], f[3]); v.z = pk2(f[4], f[5]); v.w = pk2(f[6], f[7]); return v; }

using pg8::Unit;
struct EpiStore {
    static constexpr bool PERM = true, AFTER_DRAIN = false, HAS_MID = false;
    bf16_t* O; int ldc;
    __device__ __forceinline__ void operator()(const f32x4 (&acc)[2][2][4][2], const Unit& u, int wr, int wc, int fr, int fq) const {
#pragma unroll
        for (int ai = 0; ai < 2; ++ai)
#pragma unroll
            for (int m = 0; m < 4; ++m) { const int row = u.pm * 256 + ai * 128 + wr * 64 + m * 16 + fr; bf16_t* rp = O + (size_t)row * ldc + u.pn * 256 + wc * 32 + 8 * fq;
#pragma unroll
                for (int bj = 0; bj < 2; ++bj) { const f32x4 v0 = acc[ai][bj][m][0], v1 = acc[ai][bj][m][1]; u32x4 w; w.x = pk2(v0[0], v0[1]); w.y = pk2(v0[2], v0[3]); w.z = pk2(v1[0], v1[1]); w.w = pk2(v1[2], v1[3]);
                    *(u32x4*)(rp + bj * 128) = w; } }
    }
};
struct EpiProj {
    static constexpr bool PERM = true, AFTER_DRAIN = false, HAS_MID = false;
    int pass; unsigned char* ws; float* out;
    __device__ __forceinline__ void operator()(const f32x4 (&acc)[2][2][4][2], const Unit& u, int wr, int wc, int fr, int fq) const {
        bf16_t* bp; bf16_t* bs; int ldc, ct; int kind = 0;
        const int pn = u.pn;
        if (pass == 0) {
            if (pn < 12) { bp = (bf16_t*)(ws + W_QKV); bs = bp + (size_t)MP * 3072; ldc = 3072; ct = pn * 256; kind = 3; }
            else if (pn < 16) { bp = (bf16_t*)(ws + W_UAP); bs = (bf16_t*)(ws + W_UAS); ldc = 1024; ct = (pn - 12) * 256; }
            else { bp = bs = nullptr; ldc = 0; ct = 0; kind = 1; }
        } else {
            if (pn < 6) { bp = (bf16_t*)(ws + W_QP); bs = (bf16_t*)(ws + W_QS); ldc = 1536; ct = pn * 256; }
            else if (pn < 8) { bp = (bf16_t*)(ws + W_CKVP); bs = (bf16_t*)(ws + W_CKVS); ldc = 512; ct = (pn - 6) * 256; }
            else if (pn < 12) { bp = (bf16_t*)(ws + W_UBP); bs = (bf16_t*)(ws + W_UBS); ldc = 1024; ct = (pn - 8) * 256; }
            else if (pn < 20) { bp = (bf16_t*)(out + O_YP); bs = (bf16_t*)(out + O_YS); ldc = 2048; ct = (pn - 12) * 256; }
            else { bp = (bf16_t*)(ws + W_KRP); bs = (bf16_t*)(ws + W_KRS); ldc = 64; ct = 0; kind = 2; }
        }
        if (kind == 1) {
            if (wc != 0 || fq >= 2) return;
            float* ba = (float*)(ws + W_BA);
#pragma unroll
            for (int ai = 0; ai < 2; ++ai)
#pragma unroll
                for (int m = 0; m < 4; ++m) { const int row = u.pm * 256 + ai * 128 + wr * 64 + m * 16 + fr; float* rp = ba + (size_t)row * 16 + 8 * fq;
                    *(f32x4*)rp = acc[ai][0][m][0]; *(f32x4*)(rp + 4) = acc[ai][0][m][1]; }
            return;
        }
        if (kind == 2 && wc >= 2) return;
#pragma unroll
        for (int ai = 0; ai < 2; ++ai)
#pragma unroll
            for (int m = 0; m < 4; ++m) { const int row = u.pm * 256 + ai * 128 + wr * 64 + m * 16 + fr;
                bf16_t* rp = (row < MP ? bp + (size_t)row * ldc : bs + (size_t)(row - MP) * ldc) + ct + wc * 32 + 8 * fq;
#pragma unroll
                for (int bj = 0; bj < 2; ++bj) { if (kind == 2 && bj == 1) continue;
                    const f32x4 v0 = acc[ai][bj][m][0], v1 = acc[ai][bj][m][1]; u32x4 w; w.x = pk2(v0[0], v0[1]); w.y = pk2(v0[2], v0[3]); w.z = pk2(v1[0], v1[1]); w.w = pk2(v1[2], v1[3]);
                    *(u32x4*)(rp + bj * 128) = w;
                    if (kind == 3 && m == 3 && fr >= 13) *(u32x4*)((bf16_t*)(ws + W_HALO) + ((size_t)(row >> 6) * 3 + (fr - 13)) * 3072 + ct + wc * 32 + 8 * fq + bj * 128) = w; } }
    }
};
struct EpiMerge {
    static constexpr bool PERM = true, AFTER_DRAIN = false, HAS_MID = true;
    const bf16_t* G; bf16_t* O;
    __device__ __forceinline__ void mid(f32x4 (&acc)[2][2][4][2], const Unit& u, int wr, int wc, int fr, int fq) const {
#pragma unroll
        for (int ai = 0; ai < 2; ++ai)
#pragma unroll
            for (int m = 0; m < 4; ++m) { const int row = u.pm * 256 + ai * 128 + wr * 64 + m * 16 + fr; const bf16_t* gp = G + (size_t)row * 2048 + u.pn * 256 + wc * 32 + 8 * fq;
#pragma unroll
                for (int bj = 0; bj < 2; ++bj) { float ga[8], gb[8]; unpack8(*(const u32x4*)(gp + bj * 128), ga); unpack8(*(const u32x4*)(gp + 1024 + bj * 128), gb);
#pragma unroll
                    for (int e = 0; e < 8; ++e) { const float f = (1.f + __expf(-gb[e])) / (1.f + __expf(-ga[e])); if (e < 4) acc[ai][bj][m][0][e] *= f; else acc[ai][bj][m][1][e - 4] *= f; } } }
    }
    __device__ __forceinline__ void operator()(const f32x4 (&acc)[2][2][4][2], const Unit& u, int wr, int wc, int fr, int fq) const {
#pragma unroll
        for (int ai = 0; ai < 2; ++ai)
#pragma unroll
            for (int m = 0; m < 4; ++m) { const int row = u.pm * 256 + ai * 128 + wr * 64 + m * 16 + fr; const bf16_t* gp = G + (size_t)row * 2048 + 1024 + u.pn * 256 + wc * 32 + 8 * fq;
                bf16_t* rp = O + (size_t)row * 1024 + u.pn * 256 + wc * 32 + 8 * fq;
#pragma unroll
                for (int bj = 0; bj < 2; ++bj) { float gb[8], v[8]; unpack8(*(const u32x4*)(gp + bj * 128), gb);
#pragma unroll
                    for (int e = 0; e < 8; ++e) v[e] = (e < 4 ? acc[ai][bj][m][0][e] : acc[ai][bj][m][1][e - 4]) * sigmoidf_(gb[e]);
                    *(u32x4*)(rp + bj * 128) = pack8(v); } }
    }
};
struct EpiOut {
    static constexpr bool PERM = true, AFTER_DRAIN = false, HAS_MID = false;
    const float* X; float* Y; const float* mod; int rows_per_batch, mod_row0;
    __device__ __forceinline__ void operator()(const f32x4 (&acc)[2][2][4][2], const Unit& u, int wr, int wc, int fr, int fq) const {
#pragma unroll
        for (int ai = 0; ai < 2; ++ai)
#pragma unroll
            for (int m = 0; m < 4; ++m) { const int row = u.pm * 256 + ai * 128 + wr * 64 + m * 16 + fr; const int col = u.pn * 256 + wc * 32 + 8 * fq;
                const float* gt = mod + (size_t)(mod_row0 + row / rows_per_batch) * 3072 + 2048 + col;
#pragma unroll
                for (int bj = 0; bj < 2; ++bj) {
                    const f32x4 x0 = *(const f32x4*)(X + (size_t)row * 1024 + col + bj * 128), x1 = *(const f32x4*)(X + (size_t)row * 1024 + col + bj * 128 + 4);
                    const f32x4 g0 = *(const f32x4*)(gt + bj * 128), g1 = *(const f32x4*)(gt + bj * 128 + 4);
                    *(f32x4*)(Y + (size_t)row * 1024 + col + bj * 128) = x0 + g0 * acc[ai][bj][m][0];
                    *(f32x4*)(Y + (size_t)row * 1024 + col + bj * 128 + 4) = x1 + g1 * acc[ai][bj][m][1]; } }
    }
};
__device__ __forceinline__ void tr_item(const float* W, int ldw, int n0, int k0, bf16_t* WT, int ldt, int r0, int kdst, LAS float* scr, int lane) {
#pragma unroll 8
    for (int i = 0; i < 32; ++i) { const int kk = 2 * i + (lane >> 5); scr[kk * 33 + (lane & 31)] = W[(size_t)(k0 + kk) * ldw + n0 + (lane & 31)]; }
    asm volatile("s_waitcnt lgkmcnt(0)" ::: "memory");
    const int c = lane & 7;
#pragma unroll
    for (int j = 0; j < 4; ++j) { const int n = (lane >> 3) + 8 * j; const LAS float* s = scr + (8 * c) * 33 + n;
        u32x4 o; o.x = pk2(s[0 * 33], s[1 * 33]); o.y = pk2(s[2 * 33], s[3 * 33]); o.z = pk2(s[4 * 33], s[5 * 33]); o.w = pk2(s[6 * 33], s[7 * 33]);
        *(u32x4*)(WT + (size_t)(r0 + n) * ldt + kdst + k0 + 8 * c) = o; }
    asm volatile("s_waitcnt lgkmcnt(0)" ::: "memory");
}
__device__ __forceinline__ void p0_phase(const Params& p, LAS unsigned char* lds, int tid, int wid, int lane) {
    const int G = gridDim.x, bx = blockIdx.x;
    for (int cb = bx; cb < 48; cb += G) {
        const int j = cb * 64 + lane; float acc[18];
#pragma unroll
        for (int r = 0; r < 18; ++r) acc[r] = 0.f;
        const float* wa = p.in[I_WADA];
        for (int k = wid * 128; k < wid * 128 + 128; ++k) { const float wv = wa[(size_t)k * 3072 + j];
#pragma unroll
            for (int r = 0; r < 18; ++r) { const float cv = r < 2 ? p.in[I_CP][r * 1024 + k] : p.in[I_CS][(r - 2) * 1024 + k]; acc[r] += cv * wv; } }
        LAS float* red = (LAS float*)lds;
#pragma unroll
        for (int r = 0; r < 18; ++r) red[(wid * 18 + r) * 64 + lane] = acc[r];
        __syncthreads();
        for (int o = tid; o < 18 * 64; o += 512) { const int r = o >> 6, l = o & 63; float s = 0.f;
#pragma unroll
            for (int w = 0; w < 8; ++w) s += red[(w * 18 + r) * 64 + l];
            ((float*)(p.ws + W_MOD))[r * 3072 + cb * 64 + l] = s + p.in[I_BADA][cb * 64 + l]; }
        __syncthreads();
    }
    LAS float* scr = (LAS float*)(lds + 40960 + wid * 8448);
    const int gw = bx * 8 + wid, NGW = G * 8;
    constexpr int I_DN = 129 * 16, I_MLA = 162 * 16, I_UK = 32 * 8, I_UV = 32 * 8, I_ODN = 32 * 16, I_OMLA = 32 * 16, I_WO = 32 * 16;
    constexpr int NITEMS = I_DN + I_MLA + I_UK + I_UV + I_ODN + I_OMLA + I_WO;
    for (int it = gw; it < NITEMS; it += NGW) {
        int r = it;
        if (r < I_DN) { const int dg = r >> 4, kb = r & 15; tr_item(p.in[I_WIN], 9296, 32 * dg, 64 * kb, (bf16_t*)(p.ws + W_BT_DN), 1024, 32 * dg, 0, scr, lane); continue; } r -= I_DN;
        if (r < I_MLA) { const int dg = r >> 4, kb = r & 15; int n0;
            if (dg < 48) n0 = 4112 + 32 * dg; else if (dg < 64) n0 = 5648 + 32 * (dg - 48); else if (dg < 96) n0 = 6224 + 32 * (dg - 64); else if (dg < 160) n0 = 7248 + 32 * (dg - 96); else n0 = 6160 + 32 * (dg - 160);
            tr_item(p.in[I_WIN], 9296, n0, 64 * kb, (bf16_t*)(p.ws + W_BT_MLA), 1024, 32 * dg, 0, scr, lane); continue; } r -= I_MLA;
        if (r < I_UK) { const int dg = r >> 3, kb = r & 7; tr_item(p.in[I_WUK], 1024, 32 * dg, 64 * kb, (bf16_t*)(p.ws + W_BT_UKV), 512, 32 * dg, 0, scr, lane); continue; } r -= I_UK;
        if (r < I_UV) { const int dg = r >> 3, kb = r & 7; tr_item(p.in[I_WUV], 1024, 32 * dg, 64 * kb, (bf16_t*)(p.ws + W_BT_UKV), 512, 1024 + 32 * dg, 0, scr, lane); continue; } r -= I_UV;
        if (r < I_ODN) { const int dg = r >> 4, kb = r & 15; tr_item(p.in[I_WODN], 1024, 32 * dg, 64 * kb, (bf16_t*)(p.ws + W_BT_O), 2048, 32 * dg, 0, scr, lane); continue; } r -= I_ODN;
        if (r < I_OMLA) { const int dg = r >> 4, kb = r & 15; tr_item(p.in[I_WOMLA], 1024, 32 * dg, 64 * kb, (bf16_t*)(p.ws + W_BT_O), 2048, 32 * dg, 1024, scr, lane); continue; } r -= I_OMLA;
        { const int dg = r >> 4, kb = r & 15; tr_item(p.in[I_WOUT], 1024, 32 * dg, 64 * kb, (bf16_t*)(p.ws + W_BT_OUT), 1024, 32 * dg, 0, scr, lane); }
    }
}
__device__ __forceinline__ void p1_phase(const Params& p, int wid, int lane) {
    const int gw = blockIdx.x * 8 + wid, NGW = gridDim.x * 8; const float* mod = (const float*)(p.ws + W_MOD);
    for (int row = gw; row < MT; row += NGW) {
        const float* xr = row < MP ? p.in[I_XP] + (size_t)row * 1024 : p.in[I_XS] + (size_t)(row - MP) * 1024;
        const int mr = row < MP ? (row >> 13) : 2 + ((row - MP) >> 5);
        bf16_t* hr = row < MP ? (bf16_t*)(p.out + O_CKVP) + (size_t)row * 1024 : (bf16_t*)(p.out + O_CKVS) + (size_t)(row - MP) * 1024;
        f32x4 v[4]; float s = 0.f;
#pragma unroll
        for (int j = 0; j < 4; ++j) { v[j] = *(const f32x4*)(xr + 4 * lane + 256 * j); s += (v[j].x * v[j].x + v[j].y * v[j].y) + (v[j].z * v[j].z + v[j].w * v[j].w); }
        const float rs = rsqrtf(wave_sum(s) * (1.f / 1024.f) + EPS);
#pragma unroll
        for (int j = 0; j < 4; ++j) { const int c = 4 * lane + 256 * j;
            const f32x4 g = *(const f32x4*)(p.in[I_NG] + c), sh = *(const f32x4*)(mod + mr * 3072 + c), sc = *(const f32x4*)(mod + mr * 3072 + 1024 + c);
            const f32x4 y = v[j] * rs * g * (1.f + sc) + sh; u32x2 o; o.x = pk2(y.x, y.y); o.y = pk2(y.z, y.w); *(u32x2*)(hr + c) = o; }
    }
}
__device__ __forceinline__ void e1_phase(const Params& p, int wid, int lane) {
    const int gw = blockIdx.x * 8 + wid, NGW = gridDim.x * 8;
    const float QSC = 0.07216878364870322f * 1.4426950408889634f;
    for (int row = gw; row < MT; row += NGW) {
        const bool pr = row < MP; const int lr = pr ? row : row - MP;
        const float pos = pr ? (float)(row & 8191) : (float)(2048 + (lr & 31));
        { bf16_t* q = (pr ? (bf16_t*)(p.ws + W_QP) : (bf16_t*)(p.ws + W_QS)) + (size_t)lr * 1536; const int hd = lane >> 3, sub = lane & 7;
          bf16_t* qn = q + hd * 192 + sub * 16; float f[16]; unpack8(*(const u32x4*)qn, f); unpack8(*(const u32x4*)(qn + 8), f + 8);
          float ss = 0.f;
#pragma unroll
          for (int e = 0; e < 16; ++e) ss += f[e] * f[e];
          ss += __shfl_xor(ss, 1); ss += __shfl_xor(ss, 2); ss += __shfl_xor(ss, 4);
          const float rn = rsqrtf(ss * (1.f / 128.f) + EPS) * QSC;
#pragma unroll
          for (int e = 0; e < 16; ++e) f[e] *= rn * p.in[I_QNN][sub * 16 + e];
          *(u32x4*)qn = pack8(f); *(u32x4*)(qn + 8) = pack8(f + 8);
          bf16_t* qr = q + hd * 192 + 128 + sub * 4; const u32x2 a = *(const u32x2*)qr, b = *(const u32x2*)(qr + 32);
          float x1[4] = {bflo(a.x), bfhi(a.x), bflo(a.y), bfhi(a.y)}, x2[4] = {bflo(b.x), bfhi(b.x), bflo(b.y), bfhi(b.y)};
          float s2 = 0.f;
#pragma unroll
          for (int e = 0; e < 4; ++e) s2 += x1[e] * x1[e] + x2[e] * x2[e];
          s2 += __shfl_xor(s2, 1); s2 += __shfl_xor(s2, 2); s2 += __shfl_xor(s2, 4);
          const float rr = rsqrtf(s2 * (1.f / 64.f) + EPS);
          float o1[4], o2[4];
#pragma unroll
          for (int e = 0; e < 4; ++e) { const int i = sub * 4 + e; const float inv = exp2f(-(float)i * (13.287712379549449f / 32.f)); float sn, cs; sincosf(pos * inv, &sn, &cs);
              const float y1 = x1[e] * rr * p.in[I_QRN][i], y2 = x2[e] * rr * p.in[I_QRN][32 + i]; o1[e] = (y1 * cs - y2 * sn) * QSC; o2[e] = (y2 * cs + y1 * sn) * QSC; }
          u32x2 w1, w2; w1.x = pk2(o1[0], o1[1]); w1.y = pk2(o1[2], o1[3]); w2.x = pk2(o2[0], o2[1]); w2.y = pk2(o2[2], o2[3]);
          *(u32x2*)qr = w1; *(u32x2*)(qr + 32) = w2; }
        { bf16_t* c = (pr ? (bf16_t*)(p.ws + W_CKVP) : (bf16_t*)(p.ws + W_CKVS)) + (size_t)lr * 512 + lane * 8; float f[8]; unpack8(*(const u32x4*)c, f);
          float ss = 0.f;
#pragma unroll
          for (int e = 0; e < 8; ++e) ss += f[e] * f[e];
          const float rn = rsqrtf(wave_sum(ss) * (1.f / 512.f) + EPS);
#pragma unroll
          for (int e = 0; e < 8; ++e) f[e] *= rn * p.in[I_KVN][lane * 8 + e];
          float* o = p.out + (pr ? O_CKVP : O_CKVS) + (size_t)lr * 512 + lane * 8;
          *(f32x4*)o = (f32x4){f[0], f[1], f[2], f[3]}; *(f32x4*)(o + 4) = (f32x4){f[4], f[5], f[6], f[7]};
          *(u32x4*)c = pack8(f); }
        { bf16_t* k = (pr ? (bf16_t*)(p.ws + W_KRP) : (bf16_t*)(p.ws + W_KRS)) + (size_t)lr * 64; const int i = lane & 31;
          const float x1 = bf2f(k[i]), x2 = bf2f(k[32 + i]); float ss = x1 * x1 + x2 * x2;
#pragma unroll
          for (int o = 1; o < 32; o <<= 1) ss += __shfl_xor(ss, o);
          const float rr = rsqrtf(ss * (1.f / 64.f) + EPS); const float inv = exp2f(-(float)i * (13.287712379549449f / 32.f)); float sn, cs; sincosf(pos * inv, &sn, &cs);
          const float y1 = x1 * rr * p.in[I_KRN][i], y2 = x2 * rr * p.in[I_KRN][32 + i]; const float o1 = y1 * cs - y2 * sn, o2 = y2 * cs + y1 * sn;
          float* o = p.out + (pr ? O_KRP : O_KRS) + (size_t)lr * 64;
          if (lane < 32) { o[i] = o1; o[32 + i] = o2; k[i] = f2bf(o1); k[32 + i] = f2bf(o2); } }
    }
}
__device__ __forceinline__ void e2_phase(const Params& p, bf16_t* KN, int nrows, int wid, int lane) {
    const int gw = blockIdx.x * 8 + wid, NGW = gridDim.x * 8;
    for (int row = gw; row < nrows; row += NGW) { bf16_t* k = KN + (size_t)row * 1024 + lane * 16; float f[16]; unpack8(*(const u32x4*)k, f); unpack8(*(const u32x4*)(k + 8), f + 8);
        float ss = 0.f;
#pragma unroll
        for (int e = 0; e < 16; ++e) ss += f[e] * f[e];
        ss += __shfl_xor(ss, 1); ss += __shfl_xor(ss, 2); ss += __shfl_xor(ss, 4);
        const float rn = rsqrtf(ss * (1.f / 128.f) + EPS);
#pragma unroll
        for (int e = 0; e < 16; ++e) f[e] *= rn * p.in[I_KNN][(lane & 7) * 16 + e];
        *(u32x4*)k = pack8(f); *(u32x4*)(k + 8) = pack8(f + 8); }
}
__device__ __forceinline__ void build_sample_kv(const Params& p, int wid, int lane) {
    const int gw = blockIdx.x * 8 + wid, NGW = gridDim.x * 8;
    bf16_t* CA = (bf16_t*)(p.ws + W_CKVALL); bf16_t* KA = (bf16_t*)(p.ws + W_KRALL);
    for (int R = gw; R < MKS; R += NGW) { const int b = R / TKS, t = R - b * TKS;
        if (t < 2048) { const float* s = p.in[I_CCKV] + ((size_t)b * 2048 + t) * 512 + lane * 8; const f32x4 a = *(const f32x4*)s, c = *(const f32x4*)(s + 4);
            u32x4 w; w.x = pk2(a.x, a.y); w.y = pk2(a.z, a.w); w.z = pk2(c.x, c.y); w.w = pk2(c.z, c.w); *(u32x4*)(CA + (size_t)R * 512 + lane * 8) = w;
            KA[(size_t)R * 64 + lane] = f2bf(p.in[I_CKR][((size_t)b * 2048 + t) * 64 + lane]); }
        else { const int lr = b * 32 + t - 2048; *(u32x4*)(CA + (size_t)R * 512 + lane * 8) = *(const u32x4*)((const bf16_t*)(p.ws + W_CKVS) + (size_t)lr * 512 + lane * 8);
            KA[(size_t)R * 64 + lane] = ((const bf16_t*)(p.ws + W_KRS))[(size_t)lr * 64 + lane]; } }
}
#define MFMA32(a, b, c) __builtin_amdgcn_mfma_f32_32x32x16_bf16((a), (b), (c), 0, 0, 0)
#define MFMA16(a, b, c) __builtin_amdgcn_mfma_f32_16x16x32_bf16((a), (b), (c), 0, 0, 0)
constexpr int AT_KR = 17408, AT_KB = 26624, AT_BUF = 45056;
template <bool SAMPLE>
__device__ __forceinline__ void attn_unit(LAS unsigned char* lds, const bf16_t* Q, int ldq, const bf16_t* KN, int ldkn, const bf16_t* KR, const bf16_t* VT, int ldvt,
                                          int ntiles, int limit, bool active, bf16_t* UB, int tid, int lane) {
    const int r = lane & 31, hh = lane >> 5;
    bf16x8 qf[12];
#pragma unroll
    for (int s = 0; s < 12; ++s) qf[s] = active ? *(const bf16x8*)(Q + (size_t)r * ldq + 16 * s + 8 * hh) : (bf16x8){0, 0, 0, 0, 0, 0, 0, 0};
    f32x16 o[4];
#pragma unroll
    for (int d = 0; d < 4; ++d)
#pragma unroll
        for (int e = 0; e < 16; ++e) o[d][e] = 0.f;
    float m_run = -__builtin_inff(), l_run = 0.f;
    const int wv = __builtin_amdgcn_readfirstlane(tid >> 6);
    unsigned aoff[6];
#pragma unroll
    for (int i_ = 0; i_ < 6; ++i_) { const int ch_ = wv + 8 * i_; unsigned o_ = 0;
        if (ch_ < 17) { const int sg_ = ch_ * 64 + lane, row_ = sg_ / 17; int c_ = sg_ - row_ * 17; c_ = c_ > 15 ? 15 : c_; o_ = (unsigned)(row_ * ldkn + c_ * 8) * 2u; }
        else if (ch_ < 26) { const int sg_ = (ch_ - 17) * 64 + lane, row_ = sg_ / 9; int c_ = sg_ - row_ * 9; c_ = c_ > 7 ? 7 : c_; o_ = (unsigned)(row_ * 64 + c_ * 8) * 2u; }
        else if (ch_ < 44) { const int sg_ = (ch_ - 26) * 64 + lane, row_ = sg_ / 9; int c_ = sg_ - row_ * 9; c_ = c_ > 7 ? 7 : c_; o_ = (unsigned)(row_ * ldvt + c_ * 8) * 2u; }
        aoff[i_] = o_; }
#define AT_ISSUE(j, buf) do { LAS unsigned char* b_ = lds + (buf) * AT_BUF; const char* kn_ = (const char*)KN + (size_t)(j) * 128 * ldkn; const char* kr_ = (const char*)KR + (size_t)(j) * 8192; const char* vt_ = (const char*)VT + (size_t)(j) * 128; \
        _Pragma("unroll") for (int i_ = 0; i_ < 6; ++i_) { const int ch_ = wv + 8 * i_; unsigned o_ = aoff[i_]; asm volatile("" : "+v"(o_)); \
        if (ch_ < 17) __builtin_amdgcn_global_load_lds((const unsigned*)(kn_ + o_), (LAS unsigned*)(b_ + ch_ * 1024), 16, 0, 0); \
        else if (ch_ < 26) __builtin_amdgcn_global_load_lds((const unsigned*)(kr_ + o_), (LAS unsigned*)(b_ + AT_KR + (ch_ - 17) * 1024), 16, 0, 0); \
        else if (ch_ < 44) __builtin_amdgcn_global_load_lds((const unsigned*)(vt_ + o_), (LAS unsigned*)(b_ + AT_KB + (ch_ - 26) * 1024), 16, 0, 0); } } while (0)
    AT_ISSUE(0, 0); __syncthreads();
    for (int j = 0; j < ntiles; ++j) {
        const bool more = (j + 1 < ntiles);
        if (more) AT_ISSUE(j + 1, (j + 1) & 1);
        if (active && j <= limit) {
            const LAS unsigned char* kb = lds + (j & 1) * AT_BUF; const LAS unsigned char* vb = kb + AT_KB;
            f32x16 s0, s1;
#pragma unroll
            for (int e = 0; e < 16; ++e) { s0[e] = 0.f; s1[e] = 0.f; }
#pragma unroll
            for (int s = 0; s < 12; ++s) { const LAS unsigned char* ka = s < 8 ? kb + r * 272 + s * 32 + hh * 16 : kb + AT_KR + r * 144 + (s - 8) * 32 + hh * 16; const int rs32 = s < 8 ? 32 * 272 : 32 * 144;
                const bf16x8 a0 = *(const LAS bf16x8*)ka, a1 = *(const LAS bf16x8*)(ka + rs32);
                s0 = MFMA32(a0, qf[s], s0); s1 = MFMA32(a1, qf[s], s1); if ((s & 3) == 3) __builtin_amdgcn_sched_barrier(0); }
            if (SAMPLE && j == ntiles - 1) {
#pragma unroll
                for (int e = 0; e < 16; ++e) s1[e] = -__builtin_inff(); }
            float mx = s0[0];
#pragma unroll
            for (int e = 1; e < 16; ++e) mx = fmaxf(mx, s0[e]);
#pragma unroll
            for (int e = 0; e < 16; ++e) mx = fmaxf(mx, s1[e]);
            mx = fmaxf(mx, __shfl_xor(mx, 32));
            const float mn = fmaxf(m_run, mx), alpha = __builtin_amdgcn_exp2f(m_run - mn); m_run = mn;
            float ps = 0.f;
#pragma unroll
            for (int e = 0; e < 16; ++e) { s0[e] = __builtin_amdgcn_exp2f(s0[e] - mn); s1[e] = __builtin_amdgcn_exp2f(s1[e] - mn); ps += s0[e] + s1[e]; }
            l_run = l_run * alpha + ps;
#pragma unroll
            for (int d = 0; d < 4; ++d)
#pragma unroll
                for (int e = 0; e < 16; ++e) o[d][e] *= alpha;
            bf16x8 pf[4];
#pragma unroll
            for (int sp = 0; sp < 4; ++sp) { const int hf = sp & 1; u32x4 w;
                if (sp < 2) { w.x = pk2(s0[8 * hf + 0], s0[8 * hf + 1]); w.y = pk2(s0[8 * hf + 2], s0[8 * hf + 3]); w.z = pk2(s0[8 * hf + 4], s0[8 * hf + 5]); w.w = pk2(s0[8 * hf + 6], s0[8 * hf + 7]); }
                else        { w.x = pk2(s1[8 * hf + 0], s1[8 * hf + 1]); w.y = pk2(s1[8 * hf + 2], s1[8 * hf + 3]); w.z = pk2(s1[8 * hf + 4], s1[8 * hf + 5]); w.w = pk2(s1[8 * hf + 6], s1[8 * hf + 7]); }
                pf[sp] = __builtin_bit_cast(bf16x8, w); }
#pragma unroll
            for (int d = 0; d < 4; ++d) { __builtin_amdgcn_sched_barrier(0);
#pragma unroll
                for (int sp = 0; sp < 4; ++sp) { const LAS unsigned char* va = vb + (32 * d + r) * 144 + (16 * sp + 4 * hh) * 2;
                    const u32x2 lo = *(const LAS u32x2*)va, hi = *(const LAS u32x2*)(va + 16); const u32x4 w = {lo.x, lo.y, hi.x, hi.y};
                    o[d] = MFMA32(__builtin_bit_cast(bf16x8, w), pf[sp], o[d]); } }
        }
        __syncthreads();
    }
#undef AT_ISSUE
    if (active) {
        const float lt = l_run + __shfl_xor(l_run, 32), inv = 1.f / lt;
        int r2 = r, h2 = hh; asm volatile("" : "+v"(r2), "+v"(h2));
        char* ub = (char*)UB;
#pragma unroll
        for (int d = 0; d < 4; ++d)
#pragma unroll
            for (int g4 = 0; g4 < 4; ++g4) { bf16_t* up = (bf16_t*)(ub + (unsigned)(r2 * 1024 + 32 * d + 8 * g4 + 4 * h2) * 2u); const u32x2 z = *(const u32x2*)up;
                const float z0 = bflo(z.x), z1 = bfhi(z.x), z2 = bflo(z.y), z3 = bfhi(z.y);
                u32x2 w; w.x = pk2(o[d][4 * g4 + 0] * inv * siluf_(z0), o[d][4 * g4 + 1] * inv * siluf_(z1)); w.y = pk2(o[d][4 * g4 + 2] * inv * siluf_(z2), o[d][4 * g4 + 3] * inv * siluf_(z3));
                *(u32x2*)up = w; }
    }
}
__device__ __forceinline__ void attn_prompt_phase(const Params& p, LAS unsigned char* lds, int tid, int wid, int lane) {
    const int G = gridDim.x, bx = blockIdx.x; const int vcu = (G % 8 == 0) ? (bx % 8) * (G / 8) + bx / 8 : bx;
    for (int item = vcu; item < 512; item += G) {
        const int pr = item & 255, bh = pr >> 4, pi = pr & 15, qb = item < 256 ? 31 - pi : pi, b = bh >> 3, h = bh & 7;
        const size_t tok0 = (size_t)b * 8192; const int q0 = qb * 256 + wid * 32;
        attn_unit<false>(lds, (const bf16_t*)(p.ws + W_QP) + (tok0 + q0) * 1536 + h * 192, 1536, (const bf16_t*)(p.ws + W_KN) + tok0 * 1024 + h * 128, 1024,
                         (const bf16_t*)(p.ws + W_KRP) + tok0 * 64, (const bf16_t*)(p.ws + W_VT) + (size_t)(h * 128) * MP + tok0, MP,
                         4 * qb + 4, 4 * qb + (wid >> 1), true, (bf16_t*)(p.ws + W_UBP) + (tok0 + q0) * 1024 + h * 128, tid, lane);
    }
}
__device__ __forceinline__ void attn_sample_phase(const Params& p, LAS unsigned char* lds, int tid, int wid, int lane) {
    const int G = gridDim.x, bx = blockIdx.x; const int vcu = (G % 8 == 0) ? (bx % 8) * (G / 8) + bx / 8 : bx;
    for (int item = vcu; item < 128; item += G) { const int b = item >> 3, h = item & 7; const size_t tok0 = (size_t)b * TKS;
        attn_unit<true>(lds, (const bf16_t*)(p.ws + W_QS) + (size_t)(b * 32) * 1536 + h * 192, 1536, (const bf16_t*)(p.ws + W_KNS) + tok0 * 1024 + h * 128, 1024,
                        (const bf16_t*)(p.ws + W_KRALL) + tok0 * 64, (const bf16_t*)(p.ws + W_VTS) + (size_t)(h * 128) * MKS + tok0, MKS,
                        33, 33, wid == 0, (bf16_t*)(p.ws + W_UBS) + (size_t)(b * 32) * 1024 + h * 128, tid, lane);
    }
}
constexpr int PR_KH = 0, PR_QH = 17408, PR_KT = 34816, PR_KT0 = 53248, PR_VT0 = 71680, PR_LM = 90112, PR_TB = 107520, PR_TBE = 116736, PR_AT = 125952, PR_VEC = 134144, PR_TL = 135168;
__device__ __forceinline__ void prep_conv(const Params& p, float (&acc)[16], int part, bool smp, bool valid, int b, int h, int n, int row, int cg, size_t grow0) {
    const bf16_t* QKV = (const bf16_t*)(p.ws + W_QKV); const bf16_t* HALO = (const bf16_t*)(p.ws + W_HALO);
    const int col0 = part * 1024 + h * 128 + cg * 16;
#pragma unroll
    for (int e = 0; e < 16; ++e) acc[e] = 0.f;
#pragma unroll 1
    for (int i = 0; i < 4; ++i) { const int tt = row - 3 + i; float x[16];
#pragma unroll
        for (int e = 0; e < 16; ++e) x[e] = 0.f;
        if (valid) {
            if (tt >= 0 || (!smp && n > 0)) { const bf16_t* s = tt >= 0 ? QKV + (grow0 + tt) * 3072 + col0 : HALO + (((size_t)(b * 128 + n - 1)) * 3 + (tt + 3)) * 3072 + col0;
                unpack8(*(const u32x4*)s, x); unpack8(*(const u32x4*)(s + 8), x + 8); }
            else if (smp) { const float* s = p.in[I_SC] + ((size_t)b * 3 + (tt + 3)) * 3072 + col0;
#pragma unroll
                for (int e = 0; e < 4; ++e) { const f32x4 v = *(const f32x4*)(s + 4 * e); x[4 * e] = v.x; x[4 * e + 1] = v.y; x[4 * e + 2] = v.z; x[4 * e + 3] = v.w; } }
        }
        const float* wc = p.in[I_WCONV] + (size_t)i * 3072 + col0;
#pragma unroll
        for (int e = 0; e < 4; ++e) { const f32x4 w = *(const f32x4*)(wc + 4 * e); acc[4 * e] += x[4 * e] * w.x; acc[4 * e + 1] += x[4 * e + 1] * w.y; acc[4 * e + 2] += x[4 * e + 2] * w.z; acc[4 * e + 3] += x[4 * e + 3] * w.w; }
        if (i == 3) {
            float* o = nullptr;
            if (!smp && n == 127 && row >= 61) o = p.out + O_CVP + ((size_t)b * 3 + (row - 61)) * 3072 + col0;
            if (smp && row >= 29 && row < 32) o = p.out + O_CVS + ((size_t)b * 3 + (row - 29)) * 3072 + col0;
            if (o) {
#pragma unroll
                for (int e = 0; e < 4; ++e) *(f32x4*)(o + 4 * e) = (f32x4){x[4 * e], x[4 * e + 1], x[4 * e + 2], x[4 * e + 3]}; }
        }
    }
#pragma unroll
    for (int e = 0; e < 16; ++e) acc[e] = siluf_(acc[e]);
}
__device__ __forceinline__ void prep_unit(const Params& p, LAS unsigned char* lds, int u, int tid, int wid, int lane) {
    const bool smp = u >= 2048; int b, h, n;
    if (!smp) { b = u >> 10; h = (u >> 7) & 7; n = u & 127; } else { b = (u - 2048) >> 3; h = (u - 2048) & 7; n = 0; }
    const int row = tid >> 3, cg = tid & 7; const bool valid = !smp || row < 32;
    const size_t grow0 = smp ? (size_t)MP + b * 32 : (size_t)b * 8192 + n * 64;
    bf16_t* QKV = (bf16_t*)(p.ws + W_QKV);
    LAS float* gv = (LAS float*)(lds + PR_VEC); LAS float* betav = gv + 64; LAS float* gcv = gv + 128;
    if (wid == 0) { float g = 0.f, bt = 0.f;
        if (!smp || lane < 32) { const float* ba = (const float*)(p.ws + W_BA) + (grow0 + lane) * 16; bt = sigmoidf_(ba[h]); const float xx = ba[8 + h] + p.in[I_DTB][h];
            const float sp = xx > 20.f ? xx : log1pf(__expf(xx)); g = -__expf(p.in[I_ALOG][h]) * sp; }
        betav[lane] = bt; float c = g;
#pragma unroll
        for (int o = 1; o < 64; o <<= 1) { const float t = __shfl_up(c, o); if (lane >= o) c += t; }
        gcv[lane] = c; }
    __syncthreads();
    const float gc = gcv[row], eg = __expf(gc), ed = __expf(gcv[63] - gc);
    bf16_t* dq; if (!smp) dq = QKV + (grow0 + row) * 3072 + h * 128 + cg * 16; else dq = (bf16_t*)(p.ws + W_SQKV) + (size_t)(u - 2048) * 3 * 8192 + row * 128 + cg * 16;
    const size_t pstep = smp ? 8192 : 1024;
    LAS bf16_t* KH = (LAS bf16_t*)(lds + PR_KH); LAS bf16_t* QH = (LAS bf16_t*)(lds + PR_QH); LAS bf16_t* KT = (LAS bf16_t*)(lds + PR_KT); LAS bf16_t* KT0 = (LAS bf16_t*)(lds + PR_KT0); LAS bf16_t* VT0 = (LAS bf16_t*)(lds + PR_VT0);
    {   float a[16]; prep_conv(p, a, 0, smp, valid, b, h, n, row, cg, grow0);
        float sq = 0.f;
#pragma unroll
        for (int e = 0; e < 16; ++e) sq += a[e] * a[e];
        sq += __shfl_xor(sq, 1); sq += __shfl_xor(sq, 2); sq += __shfl_xor(sq, 4);
        const float rq = rsqrtf(sq + EPS) * 0.08838834764831845f;
#pragma unroll
        for (int e = 0; e < 16; ++e) a[e] *= rq;
        __syncthreads();
        *(LAS u32x4*)(QH + row * 136 + cg * 16) = pack8(a); *(LAS u32x4*)(QH + row * 136 + cg * 16 + 8) = pack8(a + 8);
#pragma unroll
        for (int e = 0; e < 16; ++e) a[e] *= eg;
        *(u32x4*)dq = pack8(a); *(u32x4*)(dq + 8) = pack8(a + 8); }
    {   float a[16]; prep_conv(p, a, 1, smp, valid, b, h, n, row, cg, grow0);
        float sk = 0.f;
#pragma unroll
        for (int e = 0; e < 16; ++e) sk += a[e] * a[e];
        sk += __shfl_xor(sk, 1); sk += __shfl_xor(sk, 2); sk += __shfl_xor(sk, 4);
        const float rk = rsqrtf(sk + EPS);
#pragma unroll
        for (int e = 0; e < 16; ++e) a[e] *= rk;
        __syncthreads();
        *(LAS u32x4*)(KH + row * 136 + cg * 16) = pack8(a); *(LAS u32x4*)(KH + row * 136 + cg * 16 + 8) = pack8(a + 8);
#pragma unroll
        for (int e = 0; e < 16; ++e) { KT[(cg * 16 + e) * 72 + row] = f2bf(a[e] * ed); KT0[(cg * 16 + e) * 72 + row] = f2bf(a[e]); } }
    {   float a[16]; prep_conv(p, a, 2, smp, valid, b, h, n, row, cg, grow0);
        __syncthreads();
#pragma unroll
        for (int e = 0; e < 16; ++e) VT0[(cg * 16 + e) * 72 + row] = f2bf(a[e]); }
    __syncthreads();
    {
        const LAS unsigned char* KHb = lds + PR_KH; const LAS unsigned char* QHb = lds + PR_QH; const int c = lane & 15, g = lane >> 4, mi = wid >> 1;
        f32x4 kk[2], qk[2];
#pragma unroll
        for (int j = 0; j < 2; ++j) { kk[j] = (f32x4){0.f, 0.f, 0.f, 0.f}; qk[j] = kk[j]; }
#pragma unroll
        for (int s = 0; s < 4; ++s) { const bf16x8 aK = *(const LAS bf16x8*)(KHb + (16 * mi + c) * 272 + (32 * s + 8 * g) * 2), aQ = *(const LAS bf16x8*)(QHb + (16 * mi + c) * 272 + (32 * s + 8 * g) * 2);
#pragma unroll
            for (int j = 0; j < 2; ++j) { const int nj = 2 * (wid & 1) + j; const bf16x8 bK = *(const LAS bf16x8*)(KHb + (16 * nj + c) * 272 + (32 * s + 8 * g) * 2);
                kk[j] = MFMA16(aK, bK, kk[j]); qk[j] = MFMA16(aQ, bK, qk[j]); } }
        LAS float* LM = (LAS float*)(lds + PR_LM); LAS bf16_t* ATs = (LAS bf16_t*)(lds + PR_AT);
#pragma unroll
        for (int j = 0; j < 2; ++j) { const int cj = 16 * (2 * (wid & 1) + j) + c; const float gj = gcv[cj];
#pragma unroll
            for (int e = 0; e < 4; ++e) { const int ri = 16 * mi + 4 * g + e; const float dec = (cj <= ri) ? __expf(gcv[ri] - gj) : 0.f;
                LM[ri * 68 + cj] = (cj < ri) ? betav[ri] * kk[j][e] * dec : 0.f; ATs[ri * 64 + cj] = f2bf(qk[j][e] * dec); } }
    }
    __syncthreads();
    if (wid == 0) {
        const LAS float* LM = (const LAS float*)(lds + PR_LM); LAS float* TL = (LAS float*)(lds + PR_TL); LAS bf16_t* TBs = (LAS bf16_t*)(lds + PR_TB); LAS bf16_t* TBe = (LAS bf16_t*)(lds + PR_TBE); const float bc = betav[lane], bce = bc * __expf(gcv[lane]);
        for (int i = 0; i < 64; ++i) { float a0 = (i == lane) ? 1.f : 0.f, a1 = 0.f, a2 = 0.f, a3 = 0.f; int j = 0;
            for (; j + 4 <= i; j += 4) { const f32x4 l4 = *(const LAS f32x4*)(LM + i * 68 + j);
                a0 -= l4.x * TL[j * 64 + lane]; a1 -= l4.y * TL[(j + 1) * 64 + lane]; a2 -= l4.z * TL[(j + 2) * 64 + lane]; a3 -= l4.w * TL[(j + 3) * 64 + lane]; }
            for (; j < i; ++j) a0 -= LM[i * 68 + j] * TL[j * 64 + lane];
            const float a = (a0 + a1) + (a2 + a3); TL[i * 64 + lane] = a; TBs[i * 72 + lane] = f2bf(a * bc); TBe[i * 72 + lane] = f2bf(a * bce); }
    }
    __syncthreads();
    {
        const int c = lane & 15, g = lane >> 4;
        f32x4 aw[4], au[4];
#pragma unroll
        for (int mb = 0; mb < 4; ++mb) { aw[mb] = (f32x4){0.f, 0.f, 0.f, 0.f}; au[mb] = aw[mb]; }
#pragma unroll
        for (int s = 0; s < 2; ++s) { const bf16x8 bk = *(const LAS bf16x8*)(lds + PR_KT0 + (16 * wid + c) * 144 + (32 * s + 8 * g) * 2), bv = *(const LAS bf16x8*)(lds + PR_VT0 + (16 * wid + c) * 144 + (32 * s + 8 * g) * 2);
#pragma unroll
            for (int mb = 0; mb < 4; ++mb) { aw[mb] = MFMA16(*(const LAS bf16x8*)(lds + PR_TBE + (16 * mb + c) * 144 + (32 * s + 8 * g) * 2), bk, aw[mb]);
                au[mb] = MFMA16(*(const LAS bf16x8*)(lds + PR_TB + (16 * mb + c) * 144 + (32 * s + 8 * g) * 2), bv, au[mb]); } }
        char* wb = smp ? (char*)((bf16_t*)(p.ws + W_SQKV) + (size_t)(u - 2048) * 3 * 8192 + 8192 + 16 * wid) : (char*)(QKV + grow0 * 3072 + 1024 + h * 128 + 16 * wid);
        const unsigned rs = smp ? 128u : 3072u, us = smp ? 8192u * 2u : 1024u * 2u;
#pragma unroll
        for (int mb = 0; mb < 4; ++mb)
#pragma unroll
            for (int e = 0; e < 4; ++e) { const unsigned off = ((unsigned)(16 * mb + 4 * g + e) * rs + (unsigned)c) * 2u; *(bf16_t*)(wb + off) = f2bf(aw[mb][e]); *(bf16_t*)(wb + us + off) = f2bf(au[mb][e]); }
    }
    {   bf16_t* KDT = (bf16_t*)(p.ws + W_KDT) + (size_t)u * 8192; bf16_t* ATG = (bf16_t*)(p.ws + W_TB) + (size_t)u * 4096;
#pragma unroll
        for (int i = 0; i < 2; ++i) { const int pc = tid + 512 * i, r = pc >> 3, c = pc & 7; *(u32x4*)(KDT + r * 64 + c * 8) = *(const LAS u32x4*)(lds + PR_KT + r * 144 + c * 16); }
        { const int r = tid >> 3, c = tid & 7; *(u32x4*)(ATG + r * 64 + c * 8) = *(const LAS u32x4*)(lds + PR_AT + r * 128 + c * 16); }
        if (tid == 0) ((float*)(p.ws + W_GL))[u] = __expf(gcv[63]);
    }
    __syncthreads();
}
constexpr int SC_QG = 0, SC_W = 17408, SC_KD = 34816, SC_AT = 53248, SC_U = 62464, SC_Z = 78848, SC_WV = 95232, SC_WVB = 6656, SC_EX = 148480;
constexpr int NSEG = 8, SEGLEN = 16;
template <int mode>
__device__ __forceinline__ void scan_chain(const Params& p, LAS unsigned char* lds, int bh, int seg, int tid, int wid, int lane) {
    constexpr bool smp = mode == 3, emit = mode >= 2; const int b = bh >> 3, h = bh & 7; const int nsteps = smp ? 1 : SEGLEN;
    asm volatile("" : "+v"(tid), "+v"(lane));
    const int c = lane & 15, g = lane >> 4;
    LAS unsigned char* ST = lds + SC_WV + wid * SC_WVB; LAS unsigned char* RT = ST + 4352; LAS float* EX = (LAS float*)(lds + SC_EX);
    float* MB = (float*)(p.ws + W_MB);
    f32x4 S[8];
#pragma unroll
    for (int mb = 0; mb < 8; ++mb) S[mb] = (f32x4){0.f, 0.f, 0.f, 0.f};
    if (smp) { const char* sd = (const char*)(p.in[I_SD] + ((size_t)bh * 128) * 128 + 16 * wid);
#pragma unroll
        for (int mb = 0; mb < 8; ++mb)
#pragma unroll
            for (int e = 0; e < 4; ++e) S[mb][e] = *(const float*)(sd + (unsigned)((16 * mb + 4 * g + e) * 128 + c) * 4u); }
    if (mode == 1) {
#pragma unroll
        for (int mb = 0; mb < 8; ++mb)
#pragma unroll
            for (int e = 0; e < 4; ++e) S[mb][e] = (16 * mb + 4 * g + e == 16 * wid + c) ? 1.f : 0.f; }
    if (mode == 2) {
        for (int j = 0; j < seg; ++j) { const float* Mj = MB + (size_t)(bh * NSEG + j) * 2 * 16384; const float* Bj = Mj + 16384;
            __syncthreads();
#pragma unroll 2
            for (int i = 0; i < 8; ++i) { const int pc = tid + 512 * i, r = pc >> 5, cc = pc & 31; const f32x4 v = *(const f32x4*)(Mj + r * 128 + cc * 4); u32x2 w; w.x = pk2(v.x, v.y); w.y = pk2(v.z, v.w); *(LAS u32x2*)(lds + r * 272 + cc * 8) = w; }
#pragma unroll
            for (int mb = 0; mb < 8; ++mb) { u32x2 w; w.x = pk2(S[mb][0], S[mb][1]); w.y = pk2(S[mb][2], S[mb][3]); *(LAS u32x2*)(ST + c * 272 + (16 * mb + 4 * g) * 2) = w; }
            __syncthreads();
            { const char* bj = (const char*)(Bj + 16 * wid);
#pragma unroll
              for (int mb = 0; mb < 8; ++mb)
#pragma unroll
                for (int e = 0; e < 4; ++e) S[mb][e] = *(const float*)(bj + (unsigned)((16 * mb + 4 * g + e) * 128 + c) * 4u); }
#pragma unroll
            for (int s = 0; s < 4; ++s) { const bf16x8 bS = *(const LAS bf16x8*)(ST + c * 272 + (32 * s + 8 * g) * 2);
#pragma unroll
                for (int mb = 0; mb < 8; ++mb) S[mb] = MFMA16(*(const LAS bf16x8*)(lds + (16 * mb + c) * 272 + (32 * s + 8 * g) * 2), bS, S[mb]); }
        }
    }
    const int u0 = smp ? 2048 + bh : bh * 128 + seg * SEGLEN;
    const bf16_t* qb0; unsigned rstride; size_t ustride;
    if (!smp) { qb0 = (const bf16_t*)(p.ws + W_QKV) + ((size_t)b * 8192 + (size_t)seg * SEGLEN * 64) * 3072 + h * 128; rstride = 3072; ustride = (size_t)64 * 3072; }
    else { qb0 = (const bf16_t*)(p.ws + W_SQKV) + (size_t)bh * 3 * 8192; rstride = 128; ustride = 0; }
    const size_t koff = smp ? 8192 : 1024, voff = smp ? 16384 : 2048;
    const bf16_t* KDT = (const bf16_t*)(p.ws + W_KDT) + (size_t)u0 * 8192; const bf16_t* ATG = (const bf16_t*)(p.ws + W_TB) + (size_t)u0 * 4096; const float* GLp = (const float*)(p.ws + W_GL) + u0;
    bf16_t* zb0 = smp ? (bf16_t*)(p.ws + W_UAS) + (size_t)(b * 32) * 1024 + h * 128 : (bf16_t*)(p.ws + W_UAP) + ((size_t)b * 8192 + (size_t)seg * SEGLEN * 64) * 1024 + h * 128;
    const int zrows = smp ? 32 : 64;
    u32x4 rq[2], rk[2], rv[2], rd[2], ra, rz[2]; float gl_next;
    const unsigned oq0 = (unsigned)((tid >> 4) * rstride + (tid & 15) * 8) * 2u, oq1 = (unsigned)(((tid + 512) >> 4) * rstride + (tid & 15) * 8) * 2u, od0 = (unsigned)tid * 16u, od1 = (unsigned)(tid + 512) * 16u;
    const unsigned oz0 = (unsigned)((tid >> 4) * 1024 + (tid & 15) * 8) * 2u, oz1 = (unsigned)(((tid + 512) >> 4) * 1024 + (tid & 15) * 8) * 2u;
#define SC_ISSUE(st) do { const char* qb_ = (const char*)(qb0 + (size_t)(st) * ustride); const char* kb_ = qb_ + koff * 2; const char* vb_ = qb_ + voff * 2; const char* db_ = (const char*)(KDT + (size_t)(st) * 8192); const char* tb_ = (const char*)(ATG + (size_t)(st) * 4096); \
        rq[0] = *(const u32x4*)(qb_ + oq0); rq[1] = *(const u32x4*)(qb_ + oq1); rk[0] = *(const u32x4*)(kb_ + oq0); rk[1] = *(const u32x4*)(kb_ + oq1); rv[0] = *(const u32x4*)(vb_ + oq0); rv[1] = *(const u32x4*)(vb_ + oq1); \
        rd[0] = *(const u32x4*)(db_ + od0); rd[1] = *(const u32x4*)(db_ + od1); ra = *(const u32x4*)(tb_ + od0); gl_next = GLp[st]; \
        if (emit) { const char* z_ = (const char*)(zb0 + (size_t)(st) * 64 * 1024); rz[0] = *(const u32x4*)(z_ + oz0); if ((tid >> 4) + 32 < zrows) rz[1] = *(const u32x4*)(z_ + oz1); } } while (0)
#define SC_WRITE() do { _Pragma("unroll") for (int i_ = 0; i_ < 2; ++i_) { const int pc_ = tid + 512 * i_, r_ = pc_ >> 4, c_ = pc_ & 15; *(LAS u32x4*)(lds + SC_QG + r_ * 272 + c_ * 16) = rq[i_]; *(LAS u32x4*)(lds + SC_W + r_ * 272 + c_ * 16) = rk[i_]; \
            *(LAS u32x4*)(lds + SC_U + r_ * 256 + c_ * 16) = rv[i_]; if (emit) *(LAS u32x4*)(lds + SC_Z + r_ * 256 + c_ * 16) = rz[i_]; const int r2_ = pc_ >> 3, c2_ = pc_ & 7; *(LAS u32x4*)(lds + SC_KD + r2_ * 144 + c2_ * 16) = rd[i_]; } \
        { const int r_ = tid >> 3, c_ = tid & 7; *(LAS u32x4*)(lds + SC_AT + r_ * 144 + c_ * 16) = ra; } } while (0)
#define SC_FLUSH(st_) do { char* z_ = (char*)(zb0 + (size_t)(st_) * 64 * 1024); *(u32x4*)(z_ + oz0) = *(const LAS u32x4*)(lds + SC_Z + (tid >> 4) * 256 + (tid & 15) * 16); \
        if ((tid >> 4) + 32 < zrows) *(u32x4*)(z_ + oz1) = *(const LAS u32x4*)(lds + SC_Z + ((tid >> 4) + 32) * 256 + (tid & 15) * 16); } while (0)
    const float gain = p.in[I_DNN][16 * wid + c];
    rz[0] = (u32x4){0u, 0u, 0u, 0u}; rz[1] = rz[0];
    SC_ISSUE(0);
    for (int st = 0; st < nsteps; ++st) {
        __syncthreads();
        if (emit && st > 0) SC_FLUSH(st - 1);
        SC_WRITE(); const float gl = gl_next;
        __syncthreads();
        if (st + 1 < nsteps) SC_ISSUE(st + 1);
#pragma unroll
        for (int mb = 0; mb < 8; ++mb) { u32x2 w; w.x = pk2(S[mb][0], S[mb][1]); w.y = pk2(S[mb][2], S[mb][3]); *(LAS u32x2*)(ST + c * 272 + (16 * mb + 4 * g) * 2) = w; }
        f32x4 aK[4];
#pragma unroll
        for (int mb = 0; mb < 4; ++mb) aK[mb] = (f32x4){0.f, 0.f, 0.f, 0.f};
#pragma unroll
        for (int s = 0; s < 4; ++s) { const bf16x8 bS = *(const LAS bf16x8*)(ST + c * 272 + (32 * s + 8 * g) * 2);
#pragma unroll
            for (int mb = 0; mb < 4; ++mb) aK[mb] = MFMA16(*(const LAS bf16x8*)(lds + SC_W + (16 * mb + c) * 272 + (32 * s + 8 * g) * 2), bS, aK[mb]); }
        __builtin_amdgcn_sched_barrier(0);
#pragma unroll
        for (int mb = 0; mb < 4; ++mb) { float rr[4];
#pragma unroll
            for (int e = 0; e < 4; ++e) rr[e] = (mode == 1 ? 0.f : bf2f(*(const LAS bf16_t*)(lds + SC_U + (16 * mb + 4 * g + e) * 256 + (16 * wid + c) * 2))) - aK[mb][e];
            u32x2 w; w.x = pk2(rr[0], rr[1]); w.y = pk2(rr[2], rr[3]); *(LAS u32x2*)(RT + c * 144 + (16 * mb + 4 * g) * 2) = w; }
        __builtin_amdgcn_sched_barrier(0);
        f32x4 aQ[4];
        { const bf16x8 b0 = *(const LAS bf16x8*)(RT + c * 144 + (8 * g) * 2), b1 = *(const LAS bf16x8*)(RT + c * 144 + (32 + 8 * g) * 2);
#pragma unroll
          for (int mb = 0; mb < 8; ++mb) { S[mb] = S[mb] * gl;
              S[mb] = MFMA16(*(const LAS bf16x8*)(lds + SC_KD + (16 * mb + c) * 144 + (8 * g) * 2), b0, S[mb]);
              S[mb] = MFMA16(*(const LAS bf16x8*)(lds + SC_KD + (16 * mb + c) * 144 + (32 + 8 * g) * 2), b1, S[mb]); }
          __builtin_amdgcn_sched_barrier(0);
          if (emit) {
#pragma unroll
            for (int mb = 0; mb < 4; ++mb) { aQ[mb] = (f32x4){0.f, 0.f, 0.f, 0.f};
                aQ[mb] = MFMA16(*(const LAS bf16x8*)(lds + SC_AT + (16 * mb + c) * 144 + (8 * g) * 2), b0, aQ[mb]);
                aQ[mb] = MFMA16(*(const LAS bf16x8*)(lds + SC_AT + (16 * mb + c) * 144 + (32 + 8 * g) * 2), b1, aQ[mb]); } } }
        __builtin_amdgcn_sched_barrier(0);
        if (emit) {
#pragma unroll
            for (int s = 0; s < 4; ++s) { const bf16x8 bS = *(const LAS bf16x8*)(ST + c * 272 + (32 * s + 8 * g) * 2);
#pragma unroll
                for (int mb = 0; mb < 4; ++mb) aQ[mb] = MFMA16(*(const LAS bf16x8*)(lds + SC_QG + (16 * mb + c) * 272 + (32 * s + 8 * g) * 2), bS, aQ[mb]); } }
        __builtin_amdgcn_sched_barrier(0);
        if (emit) {
#pragma unroll
            for (int mb = 0; mb < 4; ++mb)
#pragma unroll
                for (int e = 0; e < 4; ++e) { float q = aQ[mb][e] * aQ[mb][e]; q += __shfl_xor(q, 1); q += __shfl_xor(q, 2); q += __shfl_xor(q, 4); q += __shfl_xor(q, 8);
                    if (c == 0) EX[(16 * mb + 4 * g + e) * 8 + wid] = q; }
            __syncthreads();
#pragma unroll
            for (int mb = 0; mb < 4; ++mb)
#pragma unroll
                for (int e = 0; e < 4; ++e) { const int rw = 16 * mb + 4 * g + e; const f32x4 x0 = *(const LAS f32x4*)(EX + rw * 8), x1 = *(const LAS f32x4*)(EX + rw * 8 + 4);
                    const float rn = rsqrtf(((x0.x + x0.y) + (x0.z + x0.w) + (x1.x + x1.y) + (x1.z + x1.w)) * (1.f / 128.f) + EPS);
                    LAS bf16_t* zp = (LAS bf16_t*)(lds + SC_Z + rw * 256 + (16 * wid + c) * 2); *zp = f2bf(aQ[mb][e] * rn * gain * siluf_(bf2f(*zp))); }
        }
    }
    __syncthreads();
    if (emit) SC_FLUSH(nsteps - 1);
#undef SC_ISSUE
#undef SC_WRITE
#undef SC_FLUSH
    if (mode != 2 || seg == NSEG - 1) {
        int c2 = c, g2 = g; asm volatile("" : "+v"(c2), "+v"(g2));
        char* so = mode == 3 ? (char*)(p.out + O_SDS + ((size_t)bh * 128) * 128 + 16 * wid) : mode == 2 ? (char*)(p.out + O_SDP + ((size_t)bh * 128) * 128 + 16 * wid)
                             : (char*)(MB + ((size_t)(bh * NSEG + seg) * 2 + (mode == 0 ? 1 : 0)) * 16384 + 16 * wid);
#pragma unroll
        for (int mb = 0; mb < 8; ++mb)
#pragma unroll
            for (int e = 0; e < 4; ++e) *(float*)(so + (unsigned)((16 * mb + 4 * g2 + e) * 128 + c2) * 4u) = S[mb][e]; }
    __syncthreads();
}
template <class Epi>
__device__ __forceinline__ void run_gemm(LAS unsigned char* lds, const pg8::Gemm& g, const Epi& E) {
    pg8::StaticOrder S; S.init(g.M, g.N, (int)gridDim.x, (int)blockIdx.x);
    pg8::gemm_phase<Epi, pg8::StaticOrder, true, true>((PG8_LAS unsigned char*)lds, g, S, E);
}
__device__ __forceinline__ pg8::Gemm mk_gemm(const bf16_t* A, const bf16_t* As, int pm_split, const bf16_t* Bt, int M, int N, int K, int lda, int ldb) {
    pg8::Gemm g; g.A = A; g.As = As ? As : A; g.A2 = A; g.A2s = g.As; g.Bt = Bt; g.M = M; g.N = N; g.K = K; g.lda = lda; g.ldb = ldb; g.pm_split = pm_split; g.nt1 = K / 64; return g;
}
#ifndef PH_LO
#define PH_LO 0
#endif
#ifndef PH_HI
#define PH_HI 16
#endif
__global__ void __launch_bounds__(512, 2) hybrid_fwd(Params p_arg) {
    extern __shared__ __attribute__((aligned(16))) unsigned char lds_raw[];
    LAS unsigned char* lds = (LAS unsigned char*)lds_raw;
    cg::grid_group grid = cg::this_grid();
#define PH(k) if (PH_LO <= (k) && (k) < PH_HI)
#if defined(__HIP_DEVICE_COMPILE__)
#define LOADP() Params p; { const __attribute__((address_space(4))) Params* kp_ = (const __attribute__((address_space(4))) Params*)__builtin_amdgcn_kernarg_segment_ptr(); asm volatile("" : "+s"(kp_)); p = *(const Params*)kp_; } unsigned char* ws = p.ws; (void)ws; int tid = threadIdx.x; asm volatile("" : "+v"(tid)); const int lane = tid & 63, wid = __builtin_amdgcn_readfirstlane(tid >> 6); (void)lane; (void)wid
#else
#define LOADP() Params p = p_arg; unsigned char* ws = p.ws; (void)ws; int tid = threadIdx.x; const int lane = tid & 63, wid = tid >> 6; (void)lane; (void)wid
#endif
#define SYNC(k) if (PH_LO <= (k) && (k) + 1 < PH_HI) grid.sync()
    PH(0) { LOADP(); p0_phase(p, lds, tid, wid, lane); } SYNC(0);
    PH(1) { LOADP(); p1_phase(p, wid, lane); } SYNC(1);
    PH(2) { LOADP();
        pg8::Gemm g = mk_gemm((const bf16_t*)(p.out + O_CKVP), (const bf16_t*)(p.out + O_CKVS), 64, (const bf16_t*)(ws + W_BT_DN), MT, 4352, 1024, 1024, 1024);
        EpiProj E{0, ws, p.out}; run_gemm(lds, g, E); } SYNC(2);
    PH(3) { LOADP(); for (int u = blockIdx.x; u < 2176; u += gridDim.x) prep_unit(p, lds, u, tid, wid, lane); } SYNC(3);
    PH(4) { LOADP();
        for (int ci = blockIdx.x; ci < 256; ci += gridDim.x) { if (ci & 1) scan_chain<1>(p, lds, ci >> 4, (ci >> 1) & 7, tid, wid, lane); else scan_chain<0>(p, lds, ci >> 4, (ci >> 1) & 7, tid, wid, lane); }
        grid.sync(); }
    PH(4) { LOADP();
        for (int ci = blockIdx.x; ci < 256; ci += gridDim.x) { if (ci < 128) scan_chain<2>(p, lds, ci >> 3, ci & 7, tid, wid, lane); else scan_chain<3>(p, lds, ci - 128, 0, tid, wid, lane); } } SYNC(4);
    PH(5) { LOADP();
        pg8::Gemm g = mk_gemm((const bf16_t*)(p.out + O_CKVP), (const bf16_t*)(p.out + O_CKVS), 64, (const bf16_t*)(ws + W_BT_MLA), MT, 5376, 1024, 1024, 1024);
        EpiProj E{1, ws, p.out}; run_gemm(lds, g, E); } SYNC(5);
    PH(6) { LOADP(); e1_phase(p, wid, lane); } SYNC(6);
    PH(7) { LOADP();
        { pg8::Gemm g = mk_gemm((const bf16_t*)(ws + W_CKVP), nullptr, 1 << 20, (const bf16_t*)(ws + W_BT_UKV), MP, 1024, 512, 512, 512); EpiStore E{(bf16_t*)(ws + W_KN), 1024}; run_gemm(lds, g, E); }
        { pg8::Gemm g = mk_gemm((const bf16_t*)(ws + W_BT_UKV) + (size_t)1024 * 512, nullptr, 1 << 20, (const bf16_t*)(ws + W_CKVP), 1024, MP, 512, 512, 512); EpiStore E{(bf16_t*)(ws + W_VT), MP}; run_gemm(lds, g, E); } } SYNC(7);
    PH(8) { LOADP(); e2_phase(p, (bf16_t*)(ws + W_KN), MP, wid, lane); } SYNC(8);
    PH(9) { LOADP(); attn_prompt_phase(p, lds, tid, wid, lane); } SYNC(9);
    PH(10) { LOADP();
        pg8::Gemm g = mk_gemm((const bf16_t*)(ws + W_UAP), nullptr, 1 << 20, (const bf16_t*)(ws + W_BT_O), MP, 1024, 2048, 1024, 2048); g.A2 = (const bf16_t*)(ws + W_UBP); g.A2s = g.A2; g.nt1 = 16;
        EpiMerge E{(const bf16_t*)(p.out + O_YP), (bf16_t*)(ws + W_MRGP)}; run_gemm(lds, g, E);
        build_sample_kv(p, wid, lane); } SYNC(10);
    PH(11) { LOADP();
        { pg8::Gemm g = mk_gemm((const bf16_t*)(ws + W_MRGP), nullptr, 1 << 20, (const bf16_t*)(ws + W_BT_OUT), MP, 1024, 1024, 1024, 1024);
          EpiOut E{p.in[I_XP], p.out + O_YP, (const float*)(ws + W_MOD), 8192, 0}; run_gemm(lds, g, E); }
        { pg8::Gemm g = mk_gemm((const bf16_t*)(ws + W_CKVALL), nullptr, 1 << 20, (const bf16_t*)(ws + W_BT_UKV), MKS, 1024, 512, 512, 512); EpiStore E{(bf16_t*)(ws + W_KNS), 1024}; run_gemm(lds, g, E); }
        { pg8::Gemm g = mk_gemm((const bf16_t*)(ws + W_BT_UKV) + (size_t)1024 * 512, nullptr, 1 << 20, (const bf16_t*)(ws + W_CKVALL), 1024, MKS, 512, 512, 512); EpiStore E{(bf16_t*)(ws + W_VTS), MKS}; run_gemm(lds, g, E); } } SYNC(11);
    PH(12) { LOADP(); e2_phase(p, (bf16_t*)(ws + W_KNS), MKS, wid, lane); } SYNC(12);
    PH(13) { LOADP(); attn_sample_phase(p, lds, tid, wid, lane); } SYNC(13);
    PH(14) { LOADP(); pg8::Gemm g = mk_gemm((const bf16_t*)(ws + W_UAS), nullptr, 1 << 20, (const bf16_t*)(ws + W_BT_O), MS, 1024, 2048, 1024, 2048); g.A2 = (const bf16_t*)(ws + W_UBS); g.A2s = g.A2; g.nt1 = 16;
        EpiMerge E{(const bf16_t*)(p.out + O_YS), (bf16_t*)(ws + W_MRGS)}; run_gemm(lds, g, E); } SYNC(14);
    PH(15) { LOADP(); pg8::Gemm g = mk_gemm((const bf16_t*)(ws + W_MRGS), nullptr, 1 << 20, (const bf16_t*)(ws + W_BT_OUT), MS, 1024, 1024, 1024, 1024);
        EpiOut E{p.in[I_XS], p.out + O_YS, (const float*)(ws + W_MOD), 32, 2}; run_gemm(lds, g, E); }
}

extern "C" void kernel_launch(void* const* d_in, const int* in_sizes, int n_in, void* d_out, int out_size, void* d_ws, size_t ws_size, hipStream_t stream) {
    static int grid = 0;
    if (grid == 0) {
        int dev = 0, cus = 0, per_cu = 0;
        if (n_in != 26 || ws_size < 256 * MiB) { fprintf(stderr, "kernel_launch: unexpected n_in %d / ws %zu\n", n_in, ws_size); grid = -1; return; }
        hipGetDevice(&dev); hipDeviceGetAttribute(&cus, hipDeviceAttributeMultiprocessorCount, dev);
        if (hipFuncSetAttribute((const void*)hybrid_fwd, hipFuncAttributeMaxDynamicSharedMemorySize, LDS_BYTES) != hipSuccess) { fprintf(stderr, "kernel_launch: hipFuncSetAttribute failed\n"); }
        if (hipOccupancyMaxActiveBlocksPerMultiprocessor(&per_cu, (const void*)hybrid_fwd, 512, LDS_BYTES) != hipSuccess || per_cu < 1) { fprintf(stderr, "kernel_launch: occupancy query says %d\n", per_cu); per_cu = 1; }
        (void)hipGetLastError();
        grid = cus;
    }
    if (grid < 0) return;
    Params p{};
    for (int i = 0; i < 26; ++i) p.in[i] = (const float*)d_in[i];
    p.out = (float*)d_out; p.ws = (unsigned char*)d_ws;
    void* args[] = {&p};
    hipError_t e = hipLaunchCooperativeKernel((const void*)hybrid_fwd, dim3(grid), dim3(512), args, LDS_BYTES, stream);
    if (e != hipSuccess) fprintf(stderr, "cooperative launch failed: %s (grid %d)\n", hipGetErrorString(e), grid);
}
```

```cpp
#include <hip/hip_runtime.h>
#include <hip/hip_cooperative_groups.h>
#include <cstdio>
#include <cstdint>
namespace cg = cooperative_groups;
namespace pg8 {
#define PG8_LAS __attribute__((address_space(3)))
typedef unsigned short bf16_t;
typedef short bf16x8 __attribute__((ext_vector_type(8)));
typedef float f32x4 __attribute__((ext_vector_type(4)));
typedef unsigned u32x4 __attribute__((ext_vector_type(4)));
constexpr int BM = 256, BK = 64, HALF = 128, HTB = HALF * BK * 2  , STAGE_BYTES = 8 * HTB, NXCD = 8, WGM = 8;

__host__ __device__ __forceinline__ int lds_byte(int r, int c) { const int st = (r >> 4) * 2 + (c >> 5), rr = r & 15, cc = c & 31, ob = rr * 64 + cc * 2; return st * 1024 + (ob ^ (((ob >> 9) & 1) << 5)); }
__host__ __device__ __forceinline__ void stage_rc(int b, int& R, int& C) { const int st = b / 1024, sb = b % 1024, swz = sb ^ (((sb >> 9) & 1) << 5); R = (st >> 1) * 16 + swz / 64; C = (st & 1) * 32 + (swz % 64) / 2; }
__host__ __device__ __forceinline__ int perm32(int rho) { const int n = rho >> 4, i = rho & 15; return 8 * (i >> 2) + 4 * n + (i & 3); }

struct Unit { int pm, pn; };
struct Gemm { const bf16_t* A; const bf16_t* As; const bf16_t* A2; const bf16_t* A2s; const bf16_t* Bt; int M, N, K, lda, ldb, pm_split, nt1; };

struct StaticOrder {
    int nM, nN, nwg, G, c;
    __host__ __device__ void init(int M, int N, int G_, int c_) { nM = M / BM; nN = N / BM; nwg = nM * nN; G = G_; c = c_; }
    __host__ __device__ bool next(int i, Unit& u) const {
        const long L = (long)i * G + c; if (L >= nwg) return false;
        int wgid = (int)L; { const int q = nwg / NXCD, r = nwg % NXCD, xcd = wgid % NXCD, off = wgid / NXCD; wgid = (xcd < r ? xcd * (q + 1) : r * (q + 1) + (xcd - r) * q) + off; }
        const int nig = WGM * nN, gid = wgid / nig, fm = gid * WGM, gsz = (nM - fm) < WGM ? (nM - fm) : WGM;
        u.pm = fm + ((wgid % nig) % gsz); u.pn = (wgid % nig) / gsz; return true;
    }
    __device__ __forceinline__ void a_ready(const Unit&) const {}
    __device__ __forceinline__ void done(const Unit&) const {}
};

__device__ __forceinline__ unsigned cvt_pk_bf16(float lo, float hi) { unsigned r; asm volatile("v_cvt_pk_bf16_f32 %0, %1, %2" : "=v"(r) : "v"(lo), "v"(hi)); return r; }

template <class Epi, class Sched, bool ALIGN_EPI = false, bool SP2 = false>
__device__ __forceinline__ void gemm_phase(PG8_LAS unsigned char* lds, const Gemm g, const Sched& S, const Epi& E) {
    int tid_l = threadIdx.x; asm volatile("" : "+v"(tid_l));
    const int tid = tid_l, wid = __builtin_amdgcn_readfirstlane(tid >> 6), lane = tid & 63, wr = wid >> 2, wc = wid & 3, fr = lane & 15, fq = lane >> 4;
    const int K = g.K, nt = K / BK;
    unsigned voffA[2], voffB[2];
#pragma unroll
    for (int i = 0; i < 2; ++i) { int R, C; stage_rc(tid * 16 + i * 8192, R, C); const int Rb = Epi::PERM ? ((R & ~31) + perm32(R & 31)) : R;
        voffA[i] = (unsigned)(R * g.lda + C) * 2u; voffB[i] = (unsigned)(Rb * g.ldb + C) * 2u; }
    const size_t kstep = (size_t)(BK * 2);
    const size_t hstepA = (size_t)HALF * g.lda * 2, hstepB = (size_t)HALF * g.ldb * 2;
    const size_t tstepA = 2 * hstepA, tstepB = 2 * hstepB; const int nt1 = g.nt1;
    const unsigned ldsw = (unsigned)wid * 1024u;
    const int aoff = lds_byte(wr * 64 + fr, fq * 8), boff = lds_byte(wc * 32 + fr, fq * 8);
#define PG8_SA(b, h) (((b) * 2 + (h)) * HTB)
#define PG8_SB(b, h) ((4 + (b) * 2 + (h)) * HTB)
#define PG8_STAGE(bufoff, gbase, voff) do { _Pragma("unroll") for (int _i = 0; _i < 2; ++_i) \
        __builtin_amdgcn_global_load_lds((const unsigned*)((const char*)(gbase) + (voff)[_i]), (PG8_LAS unsigned*)(lds + (bufoff) + ldsw + _i * 8192), 16, 0, 0); } while (0)
#define PG8_LDA(dst, b, h) do { _Pragma("unroll") for (int m = 0; m < 4; ++m) _Pragma("unroll") for (int k = 0; k < 2; ++k) dst[m][k] = *(const PG8_LAS bf16x8*)(lds + PG8_SA(b, h) + aoff + m * 2048 + k * 1024); } while (0)
#define PG8_LDB(dst, b, h) do { _Pragma("unroll") for (int n = 0; n < 2; ++n) _Pragma("unroll") for (int k = 0; k < 2; ++k) dst[n][k] = *(const PG8_LAS bf16x8*)(lds + PG8_SB(b, h) + boff + n * 2048 + k * 1024); } while (0)
#define PG8_MMA(ai, bj, At, Bt) do { __builtin_amdgcn_s_setprio(1); _Pragma("unroll") for (int m = 0; m < 4; ++m) _Pragma("unroll") for (int n = 0; n < 2; ++n) _Pragma("unroll") for (int k = 0; k < 2; ++k) \
        acc[ai][bj][m][n] = __builtin_amdgcn_mfma_f32_16x16x32_bf16(Bt[n][k], At[m][k], acc[ai][bj][m][n], 0, 0, 0); __builtin_amdgcn_s_setprio(0); } while (0)
#define PG8_WAIT_V(n) asm volatile("s_waitcnt vmcnt(" #n ")" ::: "memory")
#define PG8_WAIT_L(n) asm volatile("s_waitcnt lgkmcnt(" #n ")" ::: "memory")
#define PG8_BAR __builtin_amdgcn_s_barrier()
#define PG8_SCHED __builtin_amdgcn_sched_barrier(0)
    Unit cur, nxt; int ui = 0;
    if (!S.next(0, cur)) return;
    f32x4 acc[2][2][4][2];
#pragma unroll
    for (int a = 0; a < 2; ++a)
#pragma unroll
        for (int b = 0; b < 2; ++b)
#pragma unroll
            for (int m = 0; m < 4; ++m)
#pragma unroll
                for (int n = 0; n < 2; ++n) acc[a][b][m][n] = (f32x4){0.f, 0.f, 0.f, 0.f};
    bf16x8 At[4][2], B0[2][2], B1[2][2];
    #define PG8_UA(P, Ps, pm_) ((pm_) < g.pm_split ? (const char*)(P) + (size_t)(pm_) * tstepA : (const char*)(Ps) + (size_t)((pm_) - g.pm_split) * tstepA)
#define PG8_KA(t_) ((t_) < nt1 ? cA + (size_t)(t_) * kstep : cA2 + (size_t)((t_) - nt1) * kstep)
    const char* cA = PG8_UA(g.A, g.As, cur.pm); const char* cA2 = PG8_UA(g.A2, g.A2s, cur.pm); const char* cB = (const char*)g.Bt + (size_t)cur.pn * tstepB;
    S.a_ready(cur);
    if constexpr (SP2) {
        PG8_STAGE(PG8_SB(0, 0), cB, voffB); PG8_STAGE(PG8_SB(0, 1), cB + hstepB, voffB); PG8_STAGE(PG8_SA(0, 0), cA, voffA); PG8_STAGE(PG8_SA(0, 1), cA + hstepA, voffA);
        if (wr == 1) PG8_BAR;
        PG8_WAIT_V(2); PG8_BAR;
        PG8_STAGE(PG8_SB(1, 0), cB + kstep, voffB); PG8_STAGE(PG8_SA(1, 0), cA + kstep, voffA); PG8_STAGE(PG8_SB(1, 1), cB + hstepB + kstep, voffB);
        PG8_WAIT_V(6); PG8_BAR;
    } else {
        PG8_STAGE(PG8_SB(0, 0), cB, voffB); PG8_STAGE(PG8_SA(0, 0), cA, voffA); PG8_STAGE(PG8_SB(0, 1), cB + hstepB, voffB); PG8_STAGE(PG8_SA(0, 1), cA + hstepA, voffA);
        if (wr == 1) PG8_BAR;
        PG8_WAIT_V(4); PG8_BAR;
        PG8_STAGE(PG8_SB(1, 0), cB + kstep, voffB); PG8_STAGE(PG8_SA(1, 0), cA + kstep, voffA); PG8_STAGE(PG8_SB(1, 1), cB + hstepB + kstep, voffB);
        PG8_WAIT_V(6); PG8_BAR;
    }
    for (;;) {
        const bool has_next = S.next(ui + 1, nxt);
        const char* nA = has_next ? PG8_UA(g.A, g.As, nxt.pm) : cA; const char* nA2 = has_next ? PG8_UA(g.A2, g.A2s, nxt.pm) : cA2; const char* nB = has_next ? (const char*)g.Bt + (size_t)nxt.pn * tstepB : cB;
        for (int t = 0; t < nt; t += 2) {
            const bool last = (t == nt - 2);
            if constexpr (Epi::HAS_MID) { if (t == nt1) E.mid(acc, cur, wr, wc, fr, fq); }
            const char* a1 = PG8_KA(t + 1);
            const char* a2 = last ? nA : PG8_KA(t + 2); const char* b2 = last ? nB : cB + (size_t)(t + 2) * kstep;
            const char* a3 = a2 + kstep; const char* b3 = b2 + kstep;
            if (last && has_next) S.a_ready(nxt);
            if constexpr (SP2) {
            PG8_LDB(B0, 0, 0); PG8_LDB(B1, 0, 1); PG8_SCHED; PG8_LDA(At, 0, 0); PG8_STAGE(PG8_SA(1, 1), a1 + hstepA, voffA);
            PG8_WAIT_V(8); PG8_WAIT_L(0); PG8_BAR; PG8_MMA(0, 0, At, B0); PG8_MMA(0, 1, At, B1); PG8_BAR; PG8_SCHED;
            PG8_LDA(At, 0, 1); PG8_STAGE(PG8_SB(0, 0), b2, voffB); PG8_STAGE(PG8_SB(0, 1), b2 + hstepB, voffB); PG8_STAGE(PG8_SA(0, 0), a2, voffA);
            PG8_WAIT_V(8); PG8_WAIT_L(0); PG8_BAR; PG8_MMA(1, 0, At, B0); PG8_MMA(1, 1, At, B1); PG8_BAR; PG8_SCHED;
            PG8_LDB(B0, 1, 0); PG8_LDB(B1, 1, 1); PG8_SCHED; PG8_LDA(At, 1, 0); PG8_STAGE(PG8_SA(0, 1), a2 + hstepA, voffA);
            PG8_WAIT_V(8); PG8_WAIT_L(0); PG8_BAR; PG8_MMA(0, 0, At, B0); PG8_MMA(0, 1, At, B1); PG8_BAR; PG8_SCHED;
            PG8_LDA(At, 1, 1); PG8_STAGE(PG8_SB(1, 0), b3, voffB); PG8_STAGE(PG8_SB(1, 1), b3 + hstepB, voffB); PG8_STAGE(PG8_SA(1, 0), a3, voffA);
            PG8_WAIT_V(8); PG8_WAIT_L(0); PG8_BAR; PG8_MMA(1, 0, At, B0); PG8_MMA(1, 1, At, B1); PG8_BAR; PG8_SCHED;
            } else {
            PG8_LDB(B0, 0, 0); PG8_SCHED; PG8_LDA(At, 0, 0); PG8_STAGE(PG8_SA(1, 1), a1 + hstepA, voffA);
            PG8_WAIT_L(8); PG8_BAR; PG8_WAIT_L(0); PG8_MMA(0, 0, At, B0); PG8_BAR; PG8_SCHED;
            PG8_LDB(B1, 0, 1); PG8_STAGE(PG8_SB(0, 0), b2, voffB);
            PG8_BAR; PG8_WAIT_L(0); PG8_MMA(0, 1, At, B1); PG8_BAR;
            PG8_LDA(At, 0, 1); PG8_STAGE(PG8_SA(0, 0), a2, voffA);
            PG8_BAR; PG8_WAIT_L(0); PG8_MMA(1, 0, At, B0); PG8_BAR; PG8_SCHED;
            PG8_STAGE(PG8_SB(0, 1), b2 + hstepB, voffB);
            PG8_WAIT_V(6); PG8_BAR; PG8_MMA(1, 1, At, B1); PG8_BAR;
            PG8_LDB(B0, 1, 0); PG8_SCHED; PG8_LDA(At, 1, 0); PG8_STAGE(PG8_SA(0, 1), a2 + hstepA, voffA);
            PG8_WAIT_L(8); PG8_BAR; PG8_WAIT_L(0); PG8_MMA(0, 0, At, B0); PG8_BAR; PG8_SCHED;
            PG8_LDB(B1, 1, 1); PG8_STAGE(PG8_SB(1, 0), b3, voffB);
            PG8_BAR; PG8_WAIT_L(0); PG8_MMA(0, 1, At, B1); PG8_BAR;
            PG8_LDA(At, 1, 1); PG8_STAGE(PG8_SA(1, 0), a3, voffA);
            PG8_BAR; PG8_WAIT_L(0); PG8_MMA(1, 0, At, B0); PG8_BAR; PG8_SCHED;
            PG8_STAGE(PG8_SB(1, 1), b3 + hstepB, voffB);
            PG8_WAIT_V(6); PG8_BAR; PG8_MMA(1, 1, At, B1); PG8_BAR;
            }
        }
        if constexpr (ALIGN_EPI) { if (wr == 0) PG8_BAR; }
        if constexpr (!Epi::AFTER_DRAIN) { E(acc, cur, wr, wc, fr, fq); S.done(cur); }
        if (!has_next) break;
#pragma unroll
        for (int a = 0; a < 2; ++a)
#pragma unroll
            for (int b = 0; b < 2; ++b)
#pragma unroll
                for (int m = 0; m < 4; ++m)
#pragma unroll
                    for (int n = 0; n < 2; ++n) acc[a][b][m][n] = (f32x4){0.f, 0.f, 0.f, 0.f};
        cur = nxt; cA = nA; cA2 = nA2; cB = nB; ++ui;
        if constexpr (ALIGN_EPI) { if (wr == 1) PG8_BAR; }
    }
    PG8_WAIT_V(0);
    if constexpr (!ALIGN_EPI) { if (wr == 0) PG8_BAR; }
    PG8_BAR;
    if constexpr (Epi::AFTER_DRAIN) { E.fused(acc, cur, wr, wc, fr, fq, lds, wid, lane); S.done(cur); }
#undef PG8_UA
#undef PG8_KA
#undef PG8_SA
#undef PG8_SB
#undef PG8_STAGE
#undef PG8_LDA
#undef PG8_LDB
#undef PG8_MMA
#undef PG8_WAIT_V
#undef PG8_WAIT_L
#undef PG8_BAR
#undef PG8_SCHED
}
}
#define LAS __attribute__((address_space(3)))
typedef unsigned short bf16_t;
typedef short bf16x8 __attribute__((ext_vector_type(8)));
typedef float f32x4 __attribute__((ext_vector_type(4)));
typedef float f32x16 __attribute__((ext_vector_type(16)));
typedef unsigned u32x4 __attribute__((ext_vector_type(4)));
typedef unsigned u32x2 __attribute__((ext_vector_type(2)));
typedef float f32x2_t __attribute__((ext_vector_type(2)));
typedef __bf16 bf16x2_t __attribute__((ext_vector_type(2)));

constexpr int MP = 16384, MS = 512, MT = MP + MS, TKS = 2080, MKS = 16 * TKS  ;
constexpr float EPS = 1e-6f;
constexpr size_t MiB = 1u << 20;
constexpr size_t W_BT_DN = 1 * MiB, W_BT_MLA = W_BT_DN + (size_t)4352 * 1024 * 2, W_BT_UKV = 20 * MiB, W_BT_O = 22 * MiB, W_BT_OUT = 26 * MiB;
constexpr size_t W_MOD = 28 * MiB, W_GL = 28 * MiB + 256 * 1024, W_BA = 28 * MiB + 512 * 1024;
constexpr size_t W_QS = 30 * MiB, W_CKVS = 31 * MiB + 512 * 1024, W_KRS = 32 * MiB, W_UAS = 33 * MiB, W_UBS = 34 * MiB, W_MRGS = 35 * MiB;
constexpr size_t W_QKV = 36 * MiB, W_HALO = 135 * MiB, W_KDT = 140 * MiB, W_SQKV = 174 * MiB, W_UAP = 190 * MiB, W_TB = 222 * MiB, W_MB = 239 * MiB, W_UBP = 222 * MiB;
constexpr size_t W_QP = 36 * MiB, W_CKVP = 84 * MiB, W_KRP = 100 * MiB, W_KN = 102 * MiB, W_VT = 134 * MiB;
constexpr size_t W_MRGP = 36 * MiB, W_CKVALL = 68 * MiB, W_KRALL = 101 * MiB, W_KNS = 106 * MiB, W_VTS = 172 * MiB;
static_assert(W_BT_MLA + (size_t)5376 * 1024 * 2 <= W_BT_UKV, "ws map");
static_assert(W_BA + (size_t)MT * 16 * 4 <= W_QS, "ws map");
static_assert(W_QKV + (size_t)MT * 3072 * 2 <= W_HALO && W_HALO + (size_t)264 * 3 * 3072 * 2 <= W_KDT && W_KDT + (size_t)2176 * 8192 * 2 <= W_SQKV && W_SQKV + (size_t)128 * 3 * 8192 * 2 <= W_UAP, "ws map");
static_assert(W_TB + (size_t)2176 * 4096 * 2 <= W_MB && W_MB + (size_t)128 * 2 * 16384 * 4 <= 256 * MiB && W_UAP + (size_t)MP * 1024 * 2 <= W_UBP && W_UBP + (size_t)MP * 1024 * 2 <= 256 * MiB, "ws map");
static_assert(W_QP + (size_t)MP * 1536 * 2 <= W_CKVP && W_CKVP + (size_t)MP * 512 * 2 <= W_KRP && W_KRP + (size_t)MP * 64 * 2 <= W_KN && W_KN + (size_t)MP * 1024 * 2 <= W_VT && W_VT + (size_t)MP * 1024 * 2 <= W_UAP, "ws map");
static_assert(W_MRGP + (size_t)MP * 1024 * 2 <= W_CKVALL && W_CKVALL + (size_t)(MKS + 64) * 512 * 2 <= W_KRALL && W_KRALL + (size_t)(MKS + 64) * 64 * 2 <= W_KNS && W_KNS + (size_t)(MKS + 64) * 1024 * 2 <= W_VTS && W_VTS + (size_t)1024 * MKS * 2 + 256 <= 256 * MiB, "ws map");
constexpr size_t O_YP = 0, O_YS = O_YP + (size_t)MP * 1024, O_CKVP = O_YS + (size_t)MS * 1024, O_KRP = O_CKVP + (size_t)MP * 512, O_SDP = O_KRP + (size_t)MP * 64,
                 O_CVP = O_SDP + 2 * 8 * 128 * 128, O_CKVS = O_CVP + 2 * 3 * 3072, O_KRS = O_CKVS + (size_t)MS * 512, O_SDS = O_KRS + (size_t)MS * 64, O_CVS = O_SDS + (size_t)16 * 8 * 128 * 128;
constexpr int LDS_BYTES = 163840;

struct Params { const float* in[26]; float* out; unsigned char* ws; };
enum { I_XP = 0, I_XS, I_CP, I_CS, I_CCKV, I_CKR, I_SD, I_SC, I_NG, I_WADA, I_BADA, I_WIN, I_WCONV, I_ALOG, I_DTB, I_DNN, I_QNN, I_QRN, I_KNN, I_KRN, I_KVN, I_WUK, I_WUV, I_WODN, I_WOMLA, I_WOUT };

__device__ __forceinline__ float bf2f(unsigned short u) { return __uint_as_float((unsigned)u << 16); }
__device__ __forceinline__ float bflo(unsigned u) { return __uint_as_float(u << 16); }
__device__ __forceinline__ float bfhi(unsigned u) { return __uint_as_float(u & 0xffff0000u); }
__device__ __forceinline__ unsigned pk2(float lo, float hi) { f32x2_t v = {lo, hi}; bf16x2_t b = __builtin_convertvector(v, bf16x2_t); return __builtin_bit_cast(unsigned, b); }
__device__ __forceinline__ unsigned short f2bf(float f) { return (unsigned short)(pk2(f, 0.f) & 0xffffu); }
__device__ __forceinline__ float wave_sum(float v) {
#pragma unroll
    for (int o = 1; o < 64; o <<= 1) v += __shfl_xor(v, o);
    return v;
}
__device__ __forceinline__ float sigmoidf_(float x) { return 1.f / (1.f + __expf(-x)); }
__device__ __forceinline__ float siluf_(float x) { return x / (1.f + __expf(-x)); }
__device__ __forceinline__ void unpack8(u32x4 v, float* f) { f[0] = bflo(v.x); f[1] = bfhi(v.x); f[2] = bflo(v.y); f[3] = bfhi(v.y); f[4] = bflo(v.z); f[5] = bfhi(v.z); f[6] = bflo(v.w); f[7] = bfhi(v.w); }
__device__ __forceinline__ u32x4 pack8(const float* f) { u32x4 v; v.x = pk2(f[0], f[1]); v.y = pk2(f[2], f[3]); v.z = pk2(f[4], f[5]); v.w = pk2(f[6], f[7]); return v; }

using pg8::Unit;
struct EpiStore {
    static constexpr bool PERM = true, AFTER_DRAIN = false, HAS_MID = false;
    bf16_t* O; int ldc;
    __device__ __forceinline__ void operator()(const f32x4 (&acc)[2][2][4][2], const Unit& u, int wr, int wc, int fr, int fq) const {
#pragma unroll
        for (int ai = 0; ai < 2; ++ai)
#pragma unroll
            for (int m = 0; m < 4; ++m) { const int row = u.pm * 256 + ai * 128 + wr * 64 + m * 16 + fr; bf16_t* rp = O + (size_t)row * ldc + u.pn * 256 + wc * 32 + 8 * fq;
#pragma unroll
                for (int bj = 0; bj < 2; ++bj) { const f32x4 v0 = acc[ai][bj][m][0], v1 = acc[ai][bj][m][1]; u32x4 w; w.x = pk2(v0[0], v0[1]); w.y = pk2(v0[2], v0[3]); w.z = pk2(v1[0], v1[1]); w.w = pk2(v1[2], v1[3]);
                    *(u32x4*)(rp + bj * 128) = w; } }
    }
};
struct EpiProj {
    static constexpr bool PERM = true, AFTER_DRAIN = false, HAS_MID = false;
    int pass; unsigned char* ws; float* out;
    __device__ __forceinline__ void operator()(const f32x4 (&acc)[2][2][4][2], const Unit& u, int wr, int wc, int fr, int fq) const {
        bf16_t* bp; bf16_t* bs; int ldc, ct; int kind = 0;
        const int pn = u.pn;
        if (pass == 0) {
            if (pn < 12) { bp = (bf16_t*)(ws + W_QKV); bs = bp + (size_t)MP * 3072; ldc = 3072; ct = pn * 256; kind = 3; }
            else if (pn < 16) { bp = (bf16_t*)(ws + W_UAP); bs = (bf16_t*)(ws + W_UAS); ldc = 1024; ct = (pn - 12) * 256; }
            else { bp = bs = nullptr; ldc = 0; ct = 0; kind = 1; }
        } else {
            if (pn < 6) { bp = (bf16_t*)(ws + W_QP); bs = (bf16_t*)(ws + W_QS); ldc = 1536; ct = pn * 256; }
            else if (pn < 8) { bp = (bf16_t*)(ws + W_CKVP); bs = (bf16_t*)(ws + W_CKVS); ldc = 512; ct = (pn - 6) * 256; }
            else if (pn < 12) { bp = (bf16_t*)(ws + W_UBP); bs = (bf16_t*)(ws + W_UBS); ldc = 1024; ct = (pn - 8) * 256; }
            else if (pn < 20) { bp = (bf16_t*)(out + O_YP); bs = (bf16_t*)(out + O_YS); ldc = 2048; ct = (pn - 12) * 256; }
            else { bp = (bf16_t*)(ws + W_KRP); bs = (bf16_t*)(ws + W_KRS); ldc = 64; ct = 0; kind = 2; }
        }
        if (kind == 1) {
            if (wc != 0 || fq >= 2) return;
            float* ba = (float*)(ws + W_BA);
#pragma unroll
            for (int ai = 0; ai < 2; ++ai)
#pragma unroll
                for (int m = 0; m < 4; ++m) { const int row = u.pm * 256 + ai * 128 + wr * 64 + m * 16 + fr; float* rp = ba + (size_t)row * 16 + 8 * fq;
                    *(f32x4*)rp = acc[ai][0][m][0]; *(f32x4*)(rp + 4) = acc[ai][0][m][1]; }
            return;
        }
        if (kind == 2 && wc >= 2) return;
#pragma unroll
        for (int ai = 0; ai < 2; ++ai)
#pragma unroll
            for (int m = 0; m < 4; ++m) { const int row = u.pm * 256 + ai * 128 + wr * 64 + m * 16 + fr;
                bf16_t* rp = (row < MP ? bp + (size_t)row * ldc : bs + (size_t)(row - MP) * ldc) + ct + wc * 32 + 8 * fq;
#pragma unroll
                for (int bj = 0; bj < 2; ++bj) { if (kind == 2 && bj == 1) continue;
                    const f32x4 v0 = acc[ai][bj][m][0], v1 = acc[ai][bj][m][1]; u32x4 w; w.x = pk2(v0[0], v0[1]); w.y = pk2(v0[2], v0[3]); w.z = pk2(v1[0], v1[1]); w.w = pk2(v1[2], v1[3]);
                    *(u32x4*)(rp + bj * 128) = w;
                    if (kind == 3 && m == 3 && fr >= 13) *(u32x4*)((bf16_t*)(ws + W_HALO) + ((size_t)(row >> 6) * 3 + (fr - 13)) * 3072 + ct + wc * 32 + 8 * fq + bj * 128) = w; } }
    }
};
struct EpiMerge {
    static constexpr bool PERM = true, AFTER_DRAIN = false, HAS_MID = true;
    const bf16_t* G; bf16_t* O;
    __device__ __forceinline__ void mid(f32x4 (&acc)[2][2][4][2], const Unit& u, int wr, int wc, int fr, int fq) const {
#pragma unroll
        for (int ai = 0; ai < 2; ++ai)
#pragma unroll
            for (int m = 0; m < 4; ++m) { const int row = u.pm * 256 + ai * 128 + wr * 64 + m * 16 + fr; const bf16_t* gp = G + (size_t)row * 2048 + u.pn * 256 + wc * 32 + 8 * fq;
#pragma unroll
                for (int bj = 0; bj < 2; ++bj) { float ga[8], gb[8]; unpack8(*(const u32x4*)(gp + bj * 128), ga); unpack8(*(const u32x4*)(gp + 1024 + bj * 128), gb);
#pragma unroll
                    for (int e = 0; e < 8; ++e) { const float f = (1.f + __expf(-gb[e])) / (1.f + __expf(-ga[e])); if (e < 4) acc[ai][bj][m][0][e] *= f; else acc[ai][bj][m][1][e - 4] *= f; } } }
    }
    __device__ __forceinline__ void operator()(const f32x4 (&acc)[2][2][4][2], const Unit& u, int wr, int wc, int fr, int fq) const {
#pragma unroll
        for (int ai = 0; ai < 2; ++ai)
#pragma unroll
            for (int m = 0; m < 4; ++m) { const int row = u.pm * 256 + ai * 128 + wr * 64 + m * 16 + fr; const bf16_t* gp = G + (size_t)row * 2048 + 1024 + u.pn * 256 + wc * 32 + 8 * fq;
                bf16_t* rp = O + (size_t)row * 1024 + u.pn * 256 + wc * 32 + 8 * fq;
#pragma unroll
                for (int bj = 0; bj < 2; ++bj) { float gb[8], v[8]; unpack8(*(const u32x4*)(gp + bj * 128), gb);
#pragma unroll
                    for (int e = 0; e < 8; ++e) v[e] = (e < 4 ? acc[ai][bj][m][0][e] : acc[ai][bj][m][1][e - 4]) * sigmoidf_(gb[e]);
                    *(u32x4*)(rp + bj * 128) = pack8(v); } }
    }
};
struct EpiOut {
    static constexpr bool PERM = true, AFTER_DRAIN = false, HAS_MID = false;
    const float* X; float* Y; const float* mod; int rows_per_batch, mod_row0;
    __device__ __forceinline__ void operator()(const f32x4 (&acc)[2][2][4][2], const Unit& u, int wr, int wc, int fr, int fq) const {
#pragma unroll
        for (int ai = 0; ai < 2; ++ai)
#pragma unroll
            for (int m = 0; m < 4; ++m) { const int row = u.pm * 256 + ai * 128 + wr * 64 + m * 16 + fr; const int col = u.pn * 256 + wc * 32 + 8 * fq;
                const float* gt = mod + (size_t)(mod_row0 + row / rows_per_batch) * 3072 + 2048 + col;
#pragma unroll
                for (int bj = 0; bj < 2; ++bj) {
                    const f32x4 x0 = *(const f32x4*)(X + (size_t)row * 1024 + col + bj * 128), x1 = *(const f32x4*)(X + (size_t)row * 1024 + col + bj * 128 + 4);
                    const f32x4 g0 = *(const f32x4*)(gt + bj * 128), g1 = *(const f32x4*)(gt + bj * 128 + 4);
                    *(f32x4*)(Y + (size_t)row * 1024 + col + bj * 128) = x0 + g0 * acc[ai][bj][m][0];
                    *(f32x4*)(Y + (size_t)row * 1024 + col + bj * 128 + 4) = x1 + g1 * acc[ai][bj][m][1]; } }
    }
};
__device__ __forceinline__ void tr_item(const float* W, int ldw, int n0, int k0, bf16_t* WT, int ldt, int r0, int kdst, LAS float* scr, int lane) {
#pragma unroll 8
    for (int i = 0; i < 32; ++i) { const int kk = 2 * i + (lane >> 5); scr[kk * 33 + (lane & 31)] = W[(size_t)(k0 + kk) * ldw + n0 + (lane & 31)]; }
    asm volatile("s_waitcnt lgkmcnt(0)" ::: "memory");
    const int c = lane & 7;
#pragma unroll
    for (int j = 0; j < 4; ++j) { const int n = (lane >> 3) + 8 * j; const LAS float* s = scr + (8 * c) * 33 + n;
        u32x4 o; o.x = pk2(s[0 * 33], s[1 * 33]); o.y = pk2(s[2 * 33], s[3 * 33]); o.z = pk2(s[4 * 33], s[5 * 33]); o.w = pk2(s[6 * 33], s[7 * 33]);
        *(u32x4*)(WT + (size_t)(r0 + n) * ldt + kdst + k0 + 8 * c) = o; }
    asm volatile("s_waitcnt lgkmcnt(0)" ::: "memory");
}
__device__ __forceinline__ void p0_phase(const Params& p, LAS unsigned char* lds, int tid, int wid, int lane) {
    const int G = gridDim.x, bx = blockIdx.x;
    for (int cb = bx; cb < 48; cb += G) {
        const int j = cb * 64 + lane; float acc[18];
#pragma unroll
        for (int r = 0; r < 18; ++r) acc[r] = 0.f;
        const float* wa = p.in[I_WADA];
        for (int k = wid * 128; k < wid * 128 + 128; ++k) { const float wv = wa[(size_t)k * 3072 + j];
#pragma unroll
            for (int r = 0; r < 18; ++r) { const float cv = r < 2 ? p.in[I_CP][r * 1024 + k] : p.in[I_CS][(r - 2) * 1024 + k]; acc[r] += cv * wv; } }
        LAS float* red = (LAS float*)lds;
#pragma unroll
        for (int r = 0; r < 18; ++r) red[(wid * 18 + r) * 64 + lane] = acc[r];
        __syncthreads();
        for (int o = tid; o < 18 * 64; o += 512) { const int r = o >> 6, l = o & 63; float s = 0.f;
#pragma unroll
            for (int w = 0; w < 8; ++w) s += red[(w * 18 + r) * 64 + l];
            ((float*)(p.ws + W_MOD))[r * 3072 + cb * 64 + l] = s + p.in[I_BADA][cb * 64 + l]; }
        __syncthreads();
    }
    LAS float* scr = (LAS float*)(lds + 40960 + wid * 8448);
    const int gw = bx * 8 + wid, NGW = G * 8;
    constexpr int I_DN = 129 * 16, I_MLA = 162 * 16, I_UK = 32 * 8, I_UV = 32 * 8, I_ODN = 32 * 16, I_OMLA = 32 * 16, I_WO = 32 * 16;
    constexpr int NITEMS = I_DN + I_MLA + I_UK + I_UV + I_ODN + I_OMLA + I_WO;
    for (int it = gw; it < NITEMS; it += NGW) {
        int r = it;
        if (r < I_DN) { const int dg = r >> 4, kb = r & 15; tr_item(p.in[I_WIN], 9296, 32 * dg, 64 * kb, (bf16_t*)(p.ws + W_BT_DN), 1024, 32 * dg, 0, scr, lane); continue; } r -= I_DN;
        if (r < I_MLA) { const int dg = r >> 4, kb = r & 15; int n0;
            if (dg < 48) n0 = 4112 + 32 * dg; else if (dg < 64) n0 = 5648 + 32 * (dg - 48); else if (dg < 96) n0 = 6224 + 32 * (dg - 64); else if (dg < 160) n0 = 7248 + 32 * (dg - 96); else n0 = 6160 + 32 * (dg - 160);
            tr_item(p.in[I_WIN], 9296, n0, 64 * kb, (bf16_t*)(p.ws + W_BT_MLA), 1024, 32 * dg, 0, scr, lane); continue; } r -= I_MLA;
        if (r < I_UK) { const int dg = r >> 3, kb = r & 7; tr_item(p.in[I_WUK], 1024, 32 * dg, 64 * kb, (bf16_t*)(p.ws + W_BT_UKV), 512, 32 * dg, 0, scr, lane); continue; } r -= I_UK;
        if (r < I_UV) { const int dg = r >> 3, kb = r & 7; tr_item(p.in[I_WUV], 1024, 32 * dg, 64 * kb, (bf16_t*)(p.ws + W_BT_UKV), 512, 1024 + 32 * dg, 0, scr, lane); continue; } r -= I_UV;
        if (r < I_ODN) { const int dg = r >> 4, kb = r & 15; tr_item(p.in[I_WODN], 1024, 32 * dg, 64 * kb, (bf16_t*)(p.ws + W_BT_O), 2048, 32 * dg, 0, scr, lane); continue; } r -= I_ODN;
        if (r < I_OMLA) { const int dg = r >> 4, kb = r & 15; tr_item(p.in[I_WOMLA], 1024, 32 * dg, 64 * kb, (bf16_t*)(p.ws + W_BT_O), 2048, 32 * dg, 1024, scr, lane); continue; } r -= I_OMLA;
        { const int dg = r >> 4, kb = r & 15; tr_item(p.in[I_WOUT], 1024, 32 * dg, 64 * kb, (bf16_t*)(p.ws + W_BT_OUT), 1024, 32 * dg, 0, scr, lane); }
    }
}
__device__ __forceinline__ void p1_phase(const Params& p, int wid, int lane) {
    const int gw = blockIdx.x * 8 + wid, NGW = gridDim.x * 8; const float* mod = (const float*)(p.ws + W_MOD);
    for (int row = gw; row < MT; row += NGW) {
        const float* xr = row < MP ? p.in[I_XP] + (size_t)row * 1024 : p.in[I_XS] + (size_t)(row - MP) * 1024;
        const int mr = row < MP ? (row >> 13) : 2 + ((row - MP) >> 5);
        bf16_t* hr = row < MP ? (bf16_t*)(p.out + O_CKVP) + (size_t)row * 1024 : (bf16_t*)(p.out + O_CKVS) + (size_t)(row - MP) * 1024;
        f32x4 v[4]; float s = 0.f;
#pragma unroll
        for (int j = 0; j < 4; ++j) { v[j] = *(const f32x4*)(xr + 4 * lane + 256 * j); s += (v[j].x * v[j].x + v[j].y * v[j].y) + (v[j].z * v[j].z + v[j].w * v[j].w); }
        const float rs = rsqrtf(wave_sum(s) * (1.f / 1024.f) + EPS);
#pragma unroll
        for (int j = 0; j < 4; ++j) { const int c = 4 * lane + 256 * j;
            const f32x4 g = *(const f32x4*)(p.in[I_NG] + c), sh = *(const f32x4*)(mod + mr * 3072 + c), sc = *(const f32x4*)(mod + mr * 3072 + 1024 + c);
            const f32x4 y = v[j] * rs * g * (1.f + sc) + sh; u32x2 o; o.x = pk2(y.x, y.y); o.y = pk2(y.z, y.w); *(u32x2*)(hr + c) = o; }
    }
}
__device__ __forceinline__ void e1_phase(const Params& p, int wid, int lane) {
    const int gw = blockIdx.x * 8 + wid, NGW = gridDim.x * 8;
    const float QSC = 0.07216878364870322f * 1.4426950408889634f;
    for (int row = gw; row < MT; row += NGW) {
        const bool pr = row < MP; const int lr = pr ? row : row - MP;
        const float pos = pr ? (float)(row & 8191) : (float)(2048 + (lr & 31));
        { bf16_t* q = (pr ? (bf16_t*)(p.ws + W_QP) : (bf16_t*)(p.ws + W_QS)) + (size_t)lr * 1536; const int hd = lane >> 3, sub = lane & 7;
          bf16_t* qn = q + hd * 192 + sub * 16; float f[16]; unpack8(*(const u32x4*)qn, f); unpack8(*(const u32x4*)(qn + 8), f + 8);
          float ss = 0.f;
#pragma unroll
          for (int e = 0; e < 16; ++e) ss += f[e] * f[e];
          ss += __shfl_xor(ss, 1); ss += __shfl_xor(ss, 2); ss += __shfl_xor(ss, 4);
          const float rn = rsqrtf(ss * (1.f / 128.f) + EPS) * QSC;
#pragma unroll
          for (int e = 0; e < 16; ++e) f[e] *= rn * p.in[I_QNN][sub * 16 + e];
          *(u32x4*)qn = pack8(f); *(u32x4*)(qn + 8) = pack8(f + 8);
          bf16_t* qr = q + hd * 192 + 128 + sub * 4; const u32x2 a = *(const u32x2*)qr, b = *(const u32x2*)(qr + 32);
          float x1[4] = {bflo(a.x), bfhi(a.x), bflo(a.y), bfhi(a.y)}, x2[4] = {bflo(b.x), bfhi(b.x), bflo(b.y), bfhi(b.y)};
          float s2 = 0.f;
#pragma unroll
          for (int e = 0; e < 4; ++e) s2 += x1[e] * x1[e] + x2[e] * x2[e];
          s2 += __shfl_xor(s2, 1); s2 += __shfl_xor(s2, 2); s2 += __shfl_xor(s2, 4);
          const float rr = rsqrtf(s2 * (1.f / 64.f) + EPS);
          float o1[4], o2[4];
#pragma unroll
          for (int e = 0; e < 4; ++e) { const int i = sub * 4 + e; const float inv = exp2f(-(float)i * (13.287712379549449f / 32.f)); float sn, cs; sincosf(pos * inv, &sn, &cs);
              const float y1 = x1[e] * rr * p.in[I_QRN][i], y2 = x2[e] * rr * p.in[I_QRN][32 + i]; o1[e] = (y1 * cs - y2 * sn) * QSC; o2[e] = (y2 * cs + y1 * sn) * QSC; }
          u32x2 w1, w2; w1.x = pk2(o1[0], o1[1]); w1.y = pk2(o1[2], o1[3]); w2.x = pk2(o2[0], o2[1]); w2.y = pk2(o2[2], o2[3]);
          *(u32x2*)qr = w1; *(u32x2*)(qr + 32) = w2; }
        { bf16_t* c = (pr ? (bf16_t*)(p.ws + W_CKVP) : (bf16_t*)(p.ws + W_CKVS)) + (size_t)lr * 512 + lane * 8; float f[8]; unpack8(*(const u32x4*)c, f);
          float ss = 0.f;
#pragma unroll
          for (int e = 0; e < 8; ++e) ss += f[e] * f[e];
          const float rn = rsqrtf(wave_sum(ss) * (1.f / 512.f) + EPS);
#pragma unroll
          for (int e = 0; e < 8; ++e) f[e] *= rn * p.in[I_KVN][lane * 8 + e];
          float* o = p.out + (pr ? O_CKVP : O_CKVS) + (size_t)lr * 512 + lane * 8;
          *(f32x4*)o = (f32x4){f[0], f[1], f[2], f[3]}; *(f32x4*)(o + 4) = (f32x4){f[4], f[5], f[6], f[7]};
          *(u32x4*)c = pack8(f); }
        { bf16_t* k = (pr ? (bf16_t*)(p.ws + W_KRP) : (bf16_t*)(p.ws + W_KRS)) + (size_t)lr * 64; const int i = lane & 31;
          const float x1 = bf2f(k[i]), x2 = bf2f(k[32 + i]); float ss = x1 * x1 + x2 * x2;
#pragma unroll
          for (int o = 1; o < 32; o <<= 1) ss += __shfl_xor(ss, o);
          const float rr = rsqrtf(ss * (1.f / 64.f) + EPS); const float inv = exp2f(-(float)i * (13.287712379549449f / 32.f)); float sn, cs; sincosf(pos * inv, &sn, &cs);
          const float y1 = x1 * rr * p.in[I_KRN][i], y2 = x2 * rr * p.in[I_KRN][32 + i]; const float o1 = y1 * cs - y2 * sn, o2 = y2 * cs + y1 * sn;
          float* o = p.out + (pr ? O_KRP : O_KRS) + (size_t)lr * 64;
          if (lane < 32) { o[i] = o1; o[32 + i] = o2; k[i] = f2bf(o1); k[32 + i] = f2bf(o2); } }
    }
}
__device__ __forceinline__ void e2_phase(const Params& p, bf16_t* KN, int nrows, int wid, int lane) {
    const int gw = blockIdx.x * 8 + wid, NGW = gridDim.x * 8;
    for (int row = gw; row < nrows; row += NGW) { bf16_t* k = KN + (size_t)row * 1024 + lane * 16; float f[16]; unpack8(*(const u32x4*)k, f); unpack8(*(const u32x4*)(k + 8), f + 8);
        float ss = 0.f;
#pragma unroll
        for (int e = 0; e < 16; ++e) ss += f[e] * f[e];
        ss += __shfl_xor(ss, 1); ss += __shfl_xor(ss, 2); ss += __shfl_xor(ss, 4);
        const float rn = rsqrtf(ss * (1.f / 128.f) + EPS);
#pragma unroll
        for (int e = 0; e < 16; ++e) f[e] *= rn * p.in[I_KNN][(lane & 7) * 16 + e];
        *(u32x4*)k = pack8(f); *(u32x4*)(k + 8) = pack8(f + 8); }
}
__device__ __forceinline__ void build_sample_kv(const Params& p, int wid, int lane) {
    const int gw = blockIdx.x * 8 + wid, NGW = gridDim.x * 8;
    bf16_t* CA = (bf16_t*)(p.ws + W_CKVALL); bf16_t* KA = (bf16_t*)(p.ws + W_KRALL);
    for (int R = gw; R < MKS; R += NGW) { const int b = R / TKS, t = R - b * TKS;
        if (t < 2048) { const float* s = p.in[I_CCKV] + ((size_t)b * 2048 + t) * 512 + lane * 8; const f32x4 a = *(const f32x4*)s, c = *(const f32x4*)(s + 4);
            u32x4 w; w.x = pk2(a.x, a.y); w.y = pk2(a.z, a.w); w.z = pk2(c.x, c.y); w.w = pk2(c.z, c.w); *(u32x4*)(CA + (size_t)R * 512 + lane * 8) = w;
            KA[(size_t)R * 64 + lane] = f2bf(p.in[I_CKR][((size_t)b * 2048 + t) * 64 + lane]); }
        else { const int lr = b * 32 + t - 2048; *(u32x4*)(CA + (size_t)R * 512 + lane * 8) = *(const u32x4*)((const bf16_t*)(p.ws + W_CKVS) + (size_t)lr * 512 + lane * 8);
            KA[(size_t)R * 64 + lane] = ((const bf16_t*)(p.ws + W_KRS))[(size_t)lr * 64 + lane]; } }
}
#define MFMA32(a, b, c) __builtin_amdgcn_mfma_f32_32x32x16_bf16((a), (b), (c), 0, 0, 0)
#define MFMA16(a, b, c) __builtin_amdgcn_mfma_f32_16x16x32_bf16((a), (b), (c), 0, 0, 0)
constexpr int AT_KR = 17408, AT_KB = 26624, AT_BUF = 45056;
template <bool SAMPLE>
__device__ __forceinline__ void attn_unit(LAS unsigned char* lds, const bf16_t* Q, int ldq, const bf16_t* KN, int ldkn, const bf16_t* KR, const bf16_t* VT, int ldvt,
                                          int ntiles, int limit, bool active, bf16_t* UB, int tid, int lane) {
    const int r = lane & 31, hh = lane >> 5;
    bf16x8 qf[12];
#pragma unroll
    for (int s = 0; s < 12; ++s) qf[s] = active ? *(const bf16x8*)(Q + (size_t)r * ldq + 16 * s + 8 * hh) : (bf16x8){0, 0, 0, 0, 0, 0, 0, 0};
    f32x16 o[4];
#pragma unroll
    for (int d = 0; d < 4; ++d)
#pragma unroll
        for (int e = 0; e < 16; ++e) o[d][e] = 0.f;
    float m_run = -__builtin_inff(), l_run = 0.f;
    const int wv = __builtin_amdgcn_readfirstlane(tid >> 6);
    unsigned aoff[6];
#pragma unroll
    for (int i_ = 0; i_ < 6; ++i_) { const int ch_ = wv + 8 * i_; unsigned o_ = 0;
        if (ch_ < 17) { const int sg_ = ch_ * 64 + lane, row_ = sg_ / 17; int c_ = sg_ - row_ * 17; c_ = c_ > 15 ? 15 : c_; o_ = (unsigned)(row_ * ldkn + c_ * 8) * 2u; }
        else if (ch_ < 26) { const int sg_ = (ch_ - 17) * 64 + lane, row_ = sg_ / 9; int c_ = sg_ - row_ * 9; c_ = c_ > 7 ? 7 : c_; o_ = (unsigned)(row_ * 64 + c_ * 8) * 2u; }
        else if (ch_ < 44) { const int sg_ = (ch_ - 26) * 64 + lane, row_ = sg_ / 9; int c_ = sg_ - row_ * 9; c_ = c_ > 7 ? 7 : c_; o_ = (unsigned)(row_ * ldvt + c_ * 8) * 2u; }
        aoff[i_] = o_; }
#define AT_ISSUE(j, buf) do { LAS unsigned char* b_ = lds + (buf) * AT_BUF; const char* kn_ = (const char*)KN + (size_t)(j) * 128 * ldkn; const char* kr_ = (const char*)KR + (size_t)(j) * 8192; const char* vt_ = (const char*)VT + (size_t)(j) * 128; \
        _Pragma("unroll") for (int i_ = 0; i_ < 6; ++i_) { const int ch_ = wv + 8 * i_; unsigned o_ = aoff[i_]; asm volatile("" : "+v"(o_)); \
        if (ch_ < 17) __builtin_amdgcn_global_load_lds((const unsigned*)(kn_ + o_), (LAS unsigned*)(b_ + ch_ * 1024), 16, 0, 0); \
        else if (ch_ < 26) __builtin_amdgcn_global_load_lds((const unsigned*)(kr_ + o_), (LAS unsigned*)(b_ + AT_KR + (ch_ - 17) * 1024), 16, 0, 0); \
        else if (ch_ < 44) __builtin_amdgcn_global_load_lds((const unsigned*)(vt_ + o_), (LAS unsigned*)(b_ + AT_KB + (ch_ - 26) * 1024), 16, 0, 0); } } while (0)
    AT_ISSUE(0, 0); __syncthreads();
    for (int j = 0; j < ntiles; ++j) {
        const bool more = (j + 1 < ntiles);
        if (more) AT_ISSUE(j + 1, (j + 1) & 1);
        if (active && j <= limit) {
            const LAS unsigned char* kb = lds + (j & 1) * AT_BUF; const LAS unsigned char* vb = kb + AT_KB;
            f32x16 s0, s1;
#pragma unroll
            for (int e = 0; e < 16; ++e) { s0[e] = 0.f; s1[e] = 0.f; }
#pragma unroll
            for (int s = 0; s < 12; ++s) { const LAS unsigned char* ka = s < 8 ? kb + r * 272 + s * 32 + hh * 16 : kb + AT_KR + r * 144 + (s - 8) * 32 + hh * 16; const int rs32 = s < 8 ? 32 * 272 : 32 * 144;
                const bf16x8 a0 = *(const LAS bf16x8*)ka, a1 = *(const LAS bf16x8*)(ka + rs32);
                s0 = MFMA32(a0, qf[s], s0); s1 = MFMA32(a1, qf[s], s1); if ((s & 3) == 3) __builtin_amdgcn_sched_barrier(0); }
            if (SAMPLE && j == ntiles - 1) {
#pragma unroll
                for (int e = 0; e < 16; ++e) s1[e] = -__builtin_inff(); }
            float mx = s0[0];
#pragma unroll
            for (int e = 1; e < 16; ++e) mx = fmaxf(mx, s0[e]);
#pragma unroll
            for (int e = 0; e < 16; ++e) mx = fmaxf(mx, s1[e]);
            mx = fmaxf(mx, __shfl_xor(mx, 32));
            const float mn = fmaxf(m_run, mx), alpha = __builtin_amdgcn_exp2f(m_run - mn); m_run = mn;
            float ps = 0.f;
#pragma unroll
            for (int e = 0; e < 16; ++e) { s0[e] = __builtin_amdgcn_exp2f(s0[e] - mn); s1[e] = __builtin_amdgcn_exp2f(s1[e] - mn); ps += s0[e] + s1[e]; }
            l_run = l_run * alpha + ps;
#pragma unroll
            for (int d = 0; d < 4; ++d)
#pragma unroll
                for (int e = 0; e < 16; ++e) o[d][e] *= alpha;
            bf16x8 pf[4];
#pragma unroll
            for (int sp = 0; sp < 4; ++sp) { const int hf = sp & 1; u32x4 w;
                if (sp < 2) { w.x = pk2(s0[8 * hf + 0], s0[8 * hf + 1]); w.y = pk2(s0[8 * hf + 2], s0[8 * hf + 3]); w.z = pk2(s0[8 * hf + 4], s0[8 * hf + 5]); w.w = pk2(s0[8 * hf + 6], s0[8 * hf + 7]); }
                else        { w.x = pk2(s1[8 * hf + 0], s1[8 * hf + 1]); w.y = pk2(s1[8 * hf + 2], s1[8 * hf + 3]); w.z = pk2(s1[8 * hf + 4], s1[8 * hf + 5]); w.w = pk2(s1[8 * hf + 6], s1[8 * hf + 7]); }
                pf[sp] = __builtin_bit_cast(bf16x8, w); }
#pragma unroll
            for (int d = 0; d < 4; ++d) { __builtin_amdgcn_sched_barrier(0);
#pragma unroll
                for (int sp = 0; sp < 4; ++sp) { const LAS unsigned char* va = vb + (32 * d + r) * 144 + (16 * sp + 4 * hh) * 2;
                    const u32x2 lo = *(const LAS u32x2*)va, hi = *(const LAS u32x2*)(va + 16); const u32x4 w = {lo.x, lo.y, hi.x, hi.y};
                    o[d] = MFMA32(__builtin_bit_cast(bf16x8, w), pf[sp], o[d]); } }
        }
        __syncthreads();
    }
#undef AT_ISSUE
    if (active) {
        const float lt = l_run + __shfl_xor(l_run, 32), inv = 1.f / lt;
        int r2 = r, h2 = hh; asm volatile("" : "+v"(r2), "+v"(h2));
        char* ub = (char*)UB;
#pragma unroll
        for (int d = 0; d < 4; ++d)
#pragma unroll
            for (int g4 = 0; g4 < 4; ++g4) { bf16_t* up = (bf16_t*)(ub + (unsigned)(r2 * 1024 + 32 * d + 8 * g4 + 4 * h2) * 2u); const u32x2 z = *(const u32x2*)up;
                const float z0 = bflo(z.x), z1 = bfhi(z.x), z2 = bflo(z.y), z3 = bfhi(z.y);
                u32x2 w; w.x = pk2(o[d][4 * g4 + 0] * inv * siluf_(z0), o[d][4 * g4 + 1] * inv * siluf_(z1)); w.y = pk2(o[d][4 * g4 + 2] * inv * siluf_(z2), o[d][4 * g4 + 3] * inv * siluf_(z3));
                *(u32x2*)up = w; }
    }
}
__device__ __forceinline__ void attn_prompt_phase(const Params& p, LAS unsigned char* lds, int tid, int wid, int lane) {
    const int G = gridDim.x, bx = blockIdx.x; const int vcu = (G % 8 == 0) ? (bx % 8) * (G / 8) + bx / 8 : bx;
    for (int item = vcu; item < 512; item += G) {
        const int pr = item & 255, bh = pr >> 4, pi = pr & 15, qb = item < 256 ? 31 - pi : pi, b = bh >> 3, h = bh & 7;
        const size_t tok0 = (size_t)b * 8192; const int q0 = qb * 256 + wid * 32;
        attn_unit<false>(lds, (const bf16_t*)(p.ws + W_QP) + (tok0 + q0) * 1536 + h * 192, 1536, (const bf16_t*)(p.ws + W_KN) + tok0 * 1024 + h * 128, 1024,
                         (const bf16_t*)(p.ws + W_KRP) + tok0 * 64, (const bf16_t*)(p.ws + W_VT) + (size_t)(h * 128) * MP + tok0, MP,
                         4 * qb + 4, 4 * qb + (wid >> 1), true, (bf16_t*)(p.ws + W_UBP) + (tok0 + q0) * 1024 + h * 128, tid, lane);
    }
}
__device__ __forceinline__ void attn_sample_phase(const Params& p, LAS unsigned char* lds, int tid, int wid, int lane) {
    const int G = gridDim.x, bx = blockIdx.x; const int vcu = (G % 8 == 0) ? (bx % 8) * (G / 8) + bx / 8 : bx;
    for (int item = vcu; item < 128; item += G) { const int b = item >> 3, h = item & 7; const size_t tok0 = (size_t)b * TKS;
        attn_unit<true>(lds, (const bf16_t*)(p.ws + W_QS) + (size_t)(b * 32) * 1536 + h * 192, 1536, (const bf16_t*)(p.ws + W_KNS) + tok0 * 1024 + h * 128, 1024,
                        (const bf16_t*)(p.ws + W_KRALL) + tok0 * 64, (const bf16_t*)(p.ws + W_VTS) + (size_t)(h * 128) * MKS + tok0, MKS,
                        33, 33, wid == 0, (bf16_t*)(p.ws + W_UBS) + (size_t)(b * 32) * 1024 + h * 128, tid, lane);
    }
}
constexpr int PR_KH = 0, PR_QH = 17408, PR_KT = 34816, PR_KT0 = 53248, PR_VT0 = 71680, PR_LM = 90112, PR_TB = 107520, PR_TBE = 116736, PR_AT = 125952, PR_VEC = 134144, PR_TL = 135168;
__device__ __forceinline__ void prep_conv(const Params& p, float (&acc)[16], int part, bool smp, bool valid, int b, int h, int n, int row, int cg, size_t grow0) {
    const bf16_t* QKV = (const bf16_t*)(p.ws + W_QKV); const bf16_t* HALO = (const bf16_t*)(p.ws + W_HALO);
    const int col0 = part * 1024 + h * 128 + cg * 16;
#pragma unroll
    for (int e = 0; e < 16; ++e) acc[e] = 0.f;
#pragma unroll 1
    for (int i = 0; i < 4; ++i) { const int tt = row - 3 + i; float x[16];
#pragma unroll
        for (int e = 0; e < 16; ++e) x[e] = 0.f;
        if (valid) {
            if (tt >= 0 || (!smp && n > 0)) { const bf16_t* s = tt >= 0 ? QKV + (grow0 + tt) * 3072 + col0 : HALO + (((size_t)(b * 128 + n - 1)) * 3 + (tt + 3)) * 3072 + col0;
                unpack8(*(const u32x4*)s, x); unpack8(*(const u32x4*)(s + 8), x + 8); }
            else if (smp) { const float* s = p.in[I_SC] + ((size_t)b * 3 + (tt + 3)) * 3072 + col0;
#pragma unroll
                for (int e = 0; e < 4; ++e) { const f32x4 v = *(const f32x4*)(s + 4 * e); x[4 * e] = v.x; x[4 * e + 1] = v.y; x[4 * e + 2] = v.z; x[4 * e + 3] = v.w; } }
        }
        const float* wc = p.in[I_WCONV] + (size_t)i * 3072 + col0;
#pragma unroll
        for (int e = 0; e < 4; ++e) { const f32x4 w = *(const f32x4*)(wc + 4 * e); acc[4 * e] += x[4 * e] * w.x; acc[4 * e + 1] += x[4 * e + 1] * w.y; acc[4 * e + 2] += x[4 * e + 2] * w.z; acc[4 * e + 3] += x[4 * e + 3] * w.w; }
        if (i == 3) {
            float* o = nullptr;
            if (!smp && n == 127 && row >= 61) o = p.out + O_CVP + ((size_t)b * 3 + (row - 61)) * 3072 + col0;
            if (smp && row >= 29 && row < 32) o = p.out + O_CVS + ((size_t)b * 3 + (row - 29)) * 3072 + col0;
            if (o) {
#pragma unroll
                for (int e = 0; e < 4; ++e) *(f32x4*)(o + 4 * e) = (f32x4){x[4 * e], x[4 * e + 1], x[4 * e + 2], x[4 * e + 3]}; }
        }
    }
#pragma unroll
    for (int e = 0; e < 16; ++e) acc[e] = siluf_(acc[e]);
}
__device__ __forceinline__ void prep_unit(const Params& p, LAS unsigned char* lds, int u, int tid, int wid, int lane) {
    const bool smp = u >= 2048; int b, h, n;
    if (!smp) { b = u >> 10; h = (u >> 7) & 7; n = u & 127; } else { b = (u - 2048) >> 3; h = (u - 2048) & 7; n = 0; }
    const int row = tid >> 3, cg = tid & 7; const bool valid = !smp || row < 32;
    const size_t grow0 = smp ? (size_t)MP + b * 32 : (size_t)b * 8192 + n * 64;
    bf16_t* QKV = (bf16_t*)(p.ws + W_QKV);
    LAS float* gv = (LAS float*)(lds + PR_VEC); LAS float* betav = gv + 64; LAS float* gcv = gv + 128;
    if (wid == 0) { float g = 0.f, bt = 0.f;
        if (!smp || lane < 32) { const float* ba = (const float*)(p.ws + W_BA) + (grow0 + lane) * 16; bt = sigmoidf_(ba[h]); const float xx = ba[8 + h] + p.in[I_DTB][h];
            const float sp = xx > 20.f ? xx : log1pf(__expf(xx)); g = -__expf(p.in[I_ALOG][h]) * sp; }
        betav[lane] = bt; float c = g;
#pragma unroll
        for (int o = 1; o < 64; o <<= 1) { const float t = __shfl_up(c, o); if (lane >= o) c += t; }
        gcv[lane] = c; }
    __syncthreads();
    const float gc = gcv[row], eg = __expf(gc), ed = __expf(gcv[63] - gc);
    bf16_t* dq; if (!smp) dq = QKV + (grow0 + row) * 3072 + h * 128 + cg * 16; else dq = (bf16_t*)(p.ws + W_SQKV) + (size_t)(u - 2048) * 3 * 8192 + row * 128 + cg * 16;
    const size_t pstep = smp ? 8192 : 1024;
    LAS bf16_t* KH = (LAS bf16_t*)(lds + PR_KH); LAS bf16_t* QH = (LAS bf16_t*)(lds + PR_QH); LAS bf16_t* KT = (LAS bf16_t*)(lds + PR_KT); LAS bf16_t* KT0 = (LAS bf16_t*)(lds + PR_KT0); LAS bf16_t* VT0 = (LAS bf16_t*)(lds + PR_VT0);
    {   float a[16]; prep_conv(p, a, 0, smp, valid, b, h, n, row, cg, grow0);
        float sq = 0.f;
#pragma unroll
        for (int e = 0; e < 16; ++e) sq += a[e] * a[e];
        sq += __shfl_xor(sq, 1); sq += __shfl_xor(sq, 2); sq += __shfl_xor(sq, 4);
        const float rq = rsqrtf(sq + EPS) * 0.08838834764831845f;
#pragma unroll
        for (int e = 0; e < 16; ++e) a[e] *= rq;
        __syncthreads();
        *(LAS u32x4*)(QH + row * 136 + cg * 16) = pack8(a); *(LAS u32x4*)(QH + row * 136 + cg * 16 + 8) = pack8(a + 8);
#pragma unroll
        for (int e = 0; e < 16; ++e) a[e] *= eg;
        *(u32x4*)dq = pack8(a); *(u32x4*)(dq + 8) = pack8(a + 8); }
    {   float a[16]; prep_conv(p, a, 1, smp, valid, b, h, n, row, cg, grow0);
        float sk = 0.f;
#pragma unroll
        for (int e = 0; e < 16; ++e) sk += a[e] * a[e];
        sk += __shfl_xor(sk, 1); sk += __shfl_xor(sk, 2); sk += __shfl_xor(sk, 4);
        const float rk = rsqrtf(sk + EPS);
#pragma unroll
        for (int e = 0; e < 16; ++e) a[e] *= rk;
        __syncthreads();
        *(LAS u32x4*)(KH + row * 136 + cg * 16) = pack8(a); *(LAS u32x4*)(KH + row * 136 + cg * 16 + 8) = pack8(a + 8);
#pragma unroll
        for (int e = 0; e < 16; ++e) { KT[(cg * 16 + e) * 72 + row] = f2bf(a[e] * ed); KT0[(cg * 16 + e) * 72 + row] = f2bf(a[e]); } }
    {   float a[16]; prep_conv(p, a, 2, smp, valid, b, h, n, row, cg, grow0);
        __syncthreads();
#pragma unroll
        for (int e = 0; e < 16; ++e) VT0[(cg * 16 + e) * 72 + row] = f2bf(a[e]); }
    __syncthreads();
    {
        const LAS unsigned char* KHb = lds + PR_KH; const LAS unsigned char* QHb = lds + PR_QH; const int c = lane & 15, g = lane >> 4, mi = wid >> 1;
        f32x4 kk[2], qk[2];
#pragma unroll
        for (int j = 0; j < 2; ++j) { kk[j] = (f32x4){0.f, 0.f, 0.f, 0.f}; qk[j] = kk[j]; }
#pragma unroll
        for (int s = 0; s < 4; ++s) { const bf16x8 aK = *(const LAS bf16x8*)(KHb + (16 * mi + c) * 272 + (32 * s + 8 * g) * 2), aQ = *(const LAS bf16x8*)(QHb + (16 * mi + c) * 272 + (32 * s + 8 * g) * 2);
#pragma unroll
            for (int j = 0; j < 2; ++j) { const int nj = 2 * (wid & 1) + j; const bf16x8 bK = *(const LAS bf16x8*)(KHb + (16 * nj + c) * 272 + (32 * s + 8 * g) * 2);
                kk[j] = MFMA16(aK, bK, kk[j]); qk[j] = MFMA16(aQ, bK, qk[j]); } }
        LAS float* LM = (LAS float*)(lds + PR_LM); LAS bf16_t* ATs = (LAS bf16_t*)(lds + PR_AT);
#pragma unroll
        for (int j = 0; j < 2; ++j) { const int cj = 16 * (2 * (wid & 1) + j) + c; const float gj = gcv[cj];
#pragma unroll
            for (int e = 0; e < 4; ++e) { const int ri = 16 * mi + 4 * g + e; const float dec = (cj <= ri) ? __expf(gcv[ri] - gj) : 0.f;
                LM[ri * 68 + cj] = (cj < ri) ? betav[ri] * kk[j][e] * dec : 0.f; ATs[ri * 64 + cj] = f2bf(qk[j][e] * dec); } }
    }
    __syncthreads();
    if (wid == 0) {
        const LAS float* LM = (const LAS float*)(lds + PR_LM); LAS float* TL = (LAS float*)(lds + PR_TL); LAS bf16_t* TBs = (LAS bf16_t*)(lds + PR_TB); LAS bf16_t* TBe = (LAS bf16_t*)(lds + PR_TBE); const float bc = betav[lane], bce = bc * __expf(gcv[lane]);
        for (int i = 0; i < 64; ++i) { float a0 = (i == lane) ? 1.f : 0.f, a1 = 0.f, a2 = 0.f, a3 = 0.f; int j = 0;
            for (; j + 4 <= i; j += 4) { const f32x4 l4 = *(const LAS f32x4*)(LM + i * 68 + j);
                a0 -= l4.x * TL[j * 64 + lane]; a1 -= l4.y * TL[(j + 1) * 64 + lane]; a2 -= l4.z * TL[(j + 2) * 64 + lane]; a3 -= l4.w * TL[(j + 3) * 64 + lane]; }
            for (; j < i; ++j) a0 -= LM[i * 68 + j] * TL[j * 64 + lane];
            const float a = (a0 + a1) + (a2 + a3); TL[i * 64 + lane] = a; TBs[i * 72 + lane] = f2bf(a * bc); TBe[i * 72 + lane] = f2bf(a * bce); }
    }
    __syncthreads();
    {
        const int c = lane & 15, g = lane >> 4;
        f32x4 aw[4], au[4];
#pragma unroll
        for (int mb = 0; mb < 4; ++mb) { aw[mb] = (f32x4){0.f, 0.f, 0.f, 0.f}; au[mb] = aw[mb]; }
#pragma unroll
        for (int s = 0; s < 2; ++s) { const bf16x8 bk = *(const LAS bf16x8*)(lds + PR_KT0 + (16 * wid + c) * 144 + (32 * s + 8 * g) * 2), bv = *(const LAS bf16x8*)(lds + PR_VT0 + (16 * wid + c) * 144 + (32 * s + 8 * g) * 2);
#pragma unroll
            for (int mb = 0; mb < 4; ++mb) { aw[mb] = MFMA16(*(const LAS bf16x8*)(lds + PR_TBE + (16 * mb + c) * 144 + (32 * s + 8 * g) * 2), bk, aw[mb]);
                au[mb] = MFMA16(*(const LAS bf16x8*)(lds + PR_TB + (16 * mb + c) * 144 + (32 * s + 8 * g) * 2), bv, au[mb]); } }
        char* wb = smp ? (char*)((bf16_t*)(p.ws + W_SQKV) + (size_t)(u - 2048) * 3 * 8192 + 8192 + 16 * wid) : (char*)(QKV + grow0 * 3072 + 1024 + h * 128 + 16 * wid);
        const unsigned rs = smp ? 128u : 3072u, us = smp ? 8192u * 2u : 1024u * 2u;
#pragma unroll
        for (int mb = 0; mb < 4; ++mb)
#pragma unroll
            for (int e = 0; e < 4; ++e) { const unsigned off = ((unsigned)(16 * mb + 4 * g + e) * rs + (unsigned)c) * 2u; *(bf16_t*)(wb + off) = f2bf(aw[mb][e]); *(bf16_t*)(wb + us + off) = f2bf(au[mb][e]); }
    }
    {   bf16_t* KDT = (bf16_t*)(p.ws + W_KDT) + (size_t)u * 8192; bf16_t* ATG = (bf16_t*)(p.ws + W_TB) + (size_t)u * 4096;
#pragma unroll
        for (int i = 0; i < 2; ++i) { const int pc = tid + 512 * i, r = pc >> 3, c = pc & 7; *(u32x4*)(KDT + r * 64 + c * 8) = *(const LAS u32x4*)(lds + PR_KT + r * 144 + c * 16); }
        { const int r = tid >> 3, c = tid & 7; *(u32x4*)(ATG + r * 64 + c * 8) = *(const LAS u32x4*)(lds + PR_AT + r * 128 + c * 16); }
        if (tid == 0) ((float*)(p.ws + W_GL))[u] = __expf(gcv[63]);
    }
    __syncthreads();
}
constexpr int SC_QG = 0, SC_W = 17408, SC_KD = 34816, SC_AT = 53248, SC_U = 62464, SC_Z = 78848, SC_WV = 95232, SC_WVB = 6656, SC_EX = 148480;
constexpr int NSEG = 8, SEGLEN = 16;
template <int mode>
__device__ __forceinline__ void scan_chain(const Params& p, LAS unsigned char* lds, int bh, int seg, int tid, int wid, int lane) {
    constexpr bool smp = mode == 3, emit = mode >= 2; const int b = bh >> 3, h = bh & 7; const int nsteps = smp ? 1 : SEGLEN;
    asm volatile("" : "+v"(tid), "+v"(lane));
    const int c = lane & 15, g = lane >> 4;
    LAS unsigned char* ST = lds + SC_WV + wid * SC_WVB; LAS unsigned char* RT = ST + 4352; LAS float* EX = (LAS float*)(lds + SC_EX);
    float* MB = (float*)(p.ws + W_MB);
    f32x4 S[8];
#pragma unroll
    for (int mb = 0; mb < 8; ++mb) S[mb] = (f32x4){0.f, 0.f, 0.f, 0.f};
    if (smp) { const char* sd = (const char*)(p.in[I_SD] + ((size_t)bh * 128) * 128 + 16 * wid);
#pragma unroll
        for (int mb = 0; mb < 8; ++mb)
#pragma unroll
            for (int e = 0; e < 4; ++e) S[mb][e] = *(const float*)(sd + (unsigned)((16 * mb + 4 * g + e) * 128 + c) * 4u); }
    if (mode == 1) {
#pragma unroll
        for (int mb = 0; mb < 8; ++mb)
#pragma unroll
            for (int e = 0; e < 4; ++e) S[mb][e] = (16 * mb + 4 * g + e == 16 * wid + c) ? 1.f : 0.f; }
    if (mode == 2) {
        for (int j = 0; j < seg; ++j) { const float* Mj = MB + (size_t)(bh * NSEG + j) * 2 * 16384; const float* Bj = Mj + 16384;
            __syncthreads();
#pragma unroll 2
            for (int i = 0; i < 8; ++i) { const int pc = tid + 512 * i, r = pc >> 5, cc = pc & 31; const f32x4 v = *(const f32x4*)(Mj + r * 128 + cc * 4); u32x2 w; w.x = pk2(v.x, v.y); w.y = pk2(v.z, v.w); *(LAS u32x2*)(lds + r * 272 + cc * 8) = w; }
#pragma unroll
            for (int mb = 0; mb < 8; ++mb) { u32x2 w; w.x = pk2(S[mb][0], S[mb][1]); w.y = pk2(S[mb][2], S[mb][3]); *(LAS u32x2*)(ST + c * 272 + (16 * mb + 4 * g) * 2) = w; }
            __syncthreads();
            { const char* bj = (const char*)(Bj + 16 * wid);
#pragma unroll
              for (int mb = 0; mb < 8; ++mb)
#pragma unroll
                for (int e = 0; e < 4; ++e) S[mb][e] = *(const float*)(bj + (unsigned)((16 * mb + 4 * g + e) * 128 + c) * 4u); }
#pragma unroll
            for (int s = 0; s < 4; ++s) { const bf16x8 bS = *(const LAS bf16x8*)(ST + c * 272 + (32 * s + 8 * g) * 2);
#pragma unroll
                for (int mb = 0; mb < 8; ++mb) S[mb] = MFMA16(*(const LAS bf16x8*)(lds + (16 * mb + c) * 272 + (32 * s + 8 * g) * 2), bS, S[mb]); }
        }
    }
    const int u0 = smp ? 2048 + bh : bh * 128 + seg * SEGLEN;
    const bf16_t* qb0; unsigned rstride; size_t ustride;
    if (!smp) { qb0 = (const bf16_t*)(p.ws + W_QKV) + ((size_t)b * 8192 + (size_t)seg * SEGLEN * 64) * 3072 + h * 128; rstride = 3072; ustride = (size_t)64 * 3072; }
    else { qb0 = (const bf16_t*)(p.ws + W_SQKV) + (size_t)bh * 3 * 8192; rstride = 128; ustride = 0; }
    const size_t koff = smp ? 8192 : 1024, voff = smp ? 16384 : 2048;
    const bf16_t* KDT = (const bf16_t*)(p.ws + W_KDT) + (size_t)u0 * 8192; const bf16_t* ATG = (const bf16_t*)(p.ws + W_TB) + (size_t)u0 * 4096; const float* GLp = (const float*)(p.ws + W_GL) + u0;
    bf16_t* zb0 = smp ? (bf16_t*)(p.ws + W_UAS) + (size_t)(b * 32) * 1024 + h * 128 : (bf16_t*)(p.ws + W_UAP) + ((size_t)b * 8192 + (size_t)seg * SEGLEN * 64) * 1024 + h * 128;
    const int zrows = smp ? 32 : 64;
    u32x4 rq[2], rk[2], rv[2], rd[2], ra, rz[2]; float gl_next;
    const unsigned oq0 = (unsigned)((tid >> 4) * rstride + (tid & 15) * 8) * 2u, oq1 = (unsigned)(((tid + 512) >> 4) * rstride + (tid & 15) * 8) * 2u, od0 = (unsigned)tid * 16u, od1 = (unsigned)(tid + 512) * 16u;
    const unsigned oz0 = (unsigned)((tid >> 4) * 1024 + (tid & 15) * 8) * 2u, oz1 = (unsigned)(((tid + 512) >> 4) * 1024 + (tid & 15) * 8) * 2u;
#define SC_ISSUE(st) do { const char* qb_ = (const char*)(qb0 + (size_t)(st) * ustride); const char* kb_ = qb_ + koff * 2; const char* vb_ = qb_ + voff * 2; const char* db_ = (const char*)(KDT + (size_t)(st) * 8192); const char* tb_ = (const char*)(ATG + (size_t)(st) * 4096); \
        rq[0] = *(const u32x4*)(qb_ + oq0); rq[1] = *(const u32x4*)(qb_ + oq1); rk[0] = *(const u32x4*)(kb_ + oq0); rk[1] = *(const u32x4*)(kb_ + oq1); rv[0] = *(const u32x4*)(vb_ + oq0); rv[1] = *(const u32x4*)(vb_ + oq1); \
        rd[0] = *(const u32x4*)(db_ + od0); rd[1] = *(const u32x4*)(db_ + od1); ra = *(const u32x4*)(tb_ + od0); gl_next = GLp[st]; \
        if (emit) { const char* z_ = (const char*)(zb0 + (size_t)(st) * 64 * 1024); rz[0] = *(const u32x4*)(z_ + oz0); if ((tid >> 4) + 32 < zrows) rz[1] = *(const u32x4*)(z_ + oz1); } } while (0)
#define SC_WRITE() do { _Pragma("unroll") for (int i_ = 0; i_ < 2; ++i_) { const int pc_ = tid + 512 * i_, r_ = pc_ >> 4, c_ = pc_ & 15; *(LAS u32x4*)(lds + SC_QG + r_ * 272 + c_ * 16) = rq[i_]; *(LAS u32x4*)(lds + SC_W + r_ * 272 + c_ * 16) = rk[i_]; \
            *(LAS u32x4*)(lds + SC_U + r_ * 256 + c_ * 16) = rv[i_]; if (emit) *(LAS u32x4*)(lds + SC_Z + r_ * 256 + c_ * 16) = rz[i_]; const int r2_ = pc_ >> 3, c2_ = pc_ & 7; *(LAS u32x4*)(lds + SC_KD + r2_ * 144 + c2_ * 16) = rd[i_]; } \
        { const int r_ = tid >> 3, c_ = tid & 7; *(LAS u32x4*)(lds + SC_AT + r_ * 144 + c_ * 16) = ra; } } while (0)
#define SC_FLUSH(st_) do { char* z_ = (char*)(zb0 + (size_t)(st_) * 64 * 1024); *(u32x4*)(z_ + oz0) = *(const LAS u32x4*)(lds + SC_Z + (tid >> 4) * 256 + (tid & 15) * 16); \
        if ((tid >> 4) + 32 < zrows) *(u32x4*)(z_ + oz1) = *(const LAS u32x4*)(lds + SC_Z + ((tid >> 4) + 32) * 256 + (tid & 15) * 16); } while (0)
    const float gain = p.in[I_DNN][16 * wid + c];
    rz[0] = (u32x4){0u, 0u, 0u, 0u}; rz[1] = rz[0];
    SC_ISSUE(0);
    for (int st = 0; st < nsteps; ++st) {
        __syncthreads();
        if (emit && st > 0) SC_FLUSH(st - 1);
        SC_WRITE(); const float gl = gl_next;
        __syncthreads();
        if (st + 1 < nsteps) SC_ISSUE(st + 1);
#pragma unroll
        for (int mb = 0; mb < 8; ++mb) { u32x2 w; w.x = pk2(S[mb][0], S[mb][1]); w.y = pk2(S[mb][2], S[mb][3]); *(LAS u32x2*)(ST + c * 272 + (16 * mb + 4 * g) * 2) = w; }
        f32x4 aK[4];
#pragma unroll
        for (int mb = 0; mb < 4; ++mb) aK[mb] = (f32x4){0.f, 0.f, 0.f, 0.f};
#pragma unroll
        for (int s = 0; s < 4; ++s) { const bf16x8 bS = *(const LAS bf16x8*)(ST + c * 272 + (32 * s + 8 * g) * 2);
#pragma unroll
            for (int mb = 0; mb < 4; ++mb) aK[mb] = MFMA16(*(const LAS bf16x8*)(lds + SC_W + (16 * mb + c) * 272 + (32 * s + 8 * g) * 2), bS, aK[mb]); }
        __builtin_amdgcn_sched_barrier(0);
#pragma unroll
        for (int mb = 0; mb < 4; ++mb) { float rr[4];
#pragma unroll
            for (int e = 0; e < 4; ++e) rr[e] = (mode == 1 ? 0.f : bf2f(*(const LAS bf16_t*)(lds + SC_U + (16 * mb + 4 * g + e) * 256 + (16 * wid + c) * 2))) - aK[mb][e];
            u32x2 w; w.x = pk2(rr[0], rr[1]); w.y = pk2(rr[2], rr[3]); *(LAS u32x2*)(RT + c * 144 + (16 * mb + 4 * g) * 2) = w; }
        __builtin_amdgcn_sched_barrier(0);
        f32x4 aQ[4];
        { const bf16x8 b0 = *(const LAS bf16x8*)(RT + c * 144 + (8 * g) * 2), b1 = *(const LAS bf16x8*)(RT + c * 144 + (32 + 8 * g) * 2);
#pragma unroll
          for (int mb = 0; mb < 8; ++mb) { S[mb] = S[mb] * gl;
              S[mb] = MFMA16(*(const LAS bf16x8*)(lds + SC_KD + (16 * mb + c) * 144 + (8 * g) * 2), b0, S[mb]);
              S[mb] = MFMA16(*(const LAS bf16x8*)(lds + SC_KD + (16 * mb + c) * 144 + (32 + 8 * g) * 2), b1, S[mb]); }
          __builtin_amdgcn_sched_barrier(0);
          if (emit) {
#pragma unroll
            for (int mb = 0; mb < 4; ++mb) { aQ[mb] = (f32x4){0.f, 0.f, 0.f, 0.f};
                aQ[mb] = MFMA16(*(const LAS bf16x8*)(lds + SC_AT + (16 * mb + c) * 144 + (8 * g) * 2), b0, aQ[mb]);
                aQ[mb] = MFMA16(*(const LAS bf16x8*)(lds + SC_AT + (16 * mb + c) * 144 + (32 + 8 * g) * 2), b1, aQ[mb]); } } }
        __builtin_amdgcn_sched_barrier(0);
        if (emit) {
#pragma unroll
            for (int s = 0; s < 4; ++s) { const bf16x8 bS = *(const LAS bf16x8*)(ST + c * 272 + (32 * s + 8 * g) * 2);
#pragma unroll
                for (int mb = 0; mb < 4; ++mb) aQ[mb] = MFMA16(*(const LAS bf16x8*)(lds + SC_QG + (16 * mb + c) * 272 + (32 * s + 8 * g) * 2), bS, aQ[mb]); } }
        __builtin_amdgcn_sched_barrier(0);
        if (emit) {
#pragma unroll
            for (int mb = 0; mb < 4; ++mb)
#pragma unroll
                for (int e = 0; e < 4; ++e) { float q = aQ[mb][e] * aQ[mb][e]; q += __shfl_xor(q, 1); q += __shfl_xor(q, 2); q += __shfl_xor(q, 4); q += __shfl_xor(q, 8);
                    if (c == 0) EX[(16 * mb + 4 * g + e) * 8 + wid] = q; }
            __syncthreads();
#pragma unroll
            for (int mb = 0; mb < 4; ++mb)
#pragma unroll
                for (int e = 0; e < 4; ++e) { const int rw = 16 * mb + 4 * g + e; const f32x4 x0 = *(const LAS f32x4*)(EX + rw * 8), x1 = *(const LAS f32x4*)(EX + rw * 8 + 4);
                    const float rn = rsqrtf(((x0.x + x0.y) + (x0.z + x0.w) + (x1.x + x1.y) + (x1.z + x1.w)) * (1.f / 128.f) + EPS);
                    LAS bf16_t* zp = (LAS bf16_t*)(lds + SC_Z + rw * 256 + (16 * wid + c) * 2); *zp = f2bf(aQ[mb][e] * rn * gain * siluf_(bf2f(*zp))); }
        }
    }
    __syncthreads();
    if (emit) SC_FLUSH(nsteps - 1);
#undef SC_ISSUE
#undef SC_WRITE
#undef SC_FLUSH
    if (mode != 2 || seg == NSEG - 1) {
        int c2 = c, g2 = g; asm volatile("" : "+v"(c2), "+v"(g2));
        char* so = mode == 3 ? (char*)(p.out + O_SDS + ((size_t)bh * 128) * 128 + 16 * wid) : mode == 2 ? (char*)(p.out + O_SDP + ((size_t)bh * 128) * 128 + 16 * wid)
                             : (char*)(MB + ((size_t)(bh * NSEG + seg) * 2 + (mode == 0 ? 1 : 0)) * 16384 + 16 * wid);
#pragma unroll
        for (int mb = 0; mb < 8; ++mb)
#pragma unroll
            for (int e = 0; e < 4; ++e) *(float*)(so + (unsigned)((16 * mb + 4 * g2 + e) * 128 + c2) * 4u) = S[mb][e]; }
    __syncthreads();
}

#define XB_TMO      128
#define XB_XCNT(j)  (256  + 64 * (j))
#define XB_XSUB(j)  (1280 + 64 * (j))
#define XB_XGEN(j)  (2304 + 64 * (j))
#define XB_TOP      3328
#define XB_TOPGEN   3392
#define XCD_BAR_WORDS 3456
#define XB_SPIN_CAP (1u << 18)

__device__ __forceinline__ unsigned xb_ld(unsigned* p)              { return __hip_atomic_load(p, __ATOMIC_RELAXED, __HIP_MEMORY_SCOPE_AGENT); }
__device__ __forceinline__ unsigned xb_add(unsigned* p, unsigned v) { return __hip_atomic_fetch_add(p, v, __ATOMIC_RELAXED, __HIP_MEMORY_SCOPE_AGENT); }
__device__ __forceinline__ unsigned xb_xcc_id() { return (unsigned)__builtin_amdgcn_s_getreg((3 << 11) | 20) & 0xFu; }
#define XB_SPIN(cond, bar) do { unsigned _sp = 0; while (cond) { __builtin_amdgcn_s_sleep(1); \
    if ((++_sp & 255u) == 0u) { if (xb_ld(&(bar)[XB_TMO])) break; if (_sp > XB_SPIN_CAP) { atomicAdd(&(bar)[XB_TMO], 1u); break; } } } } while (0)

struct XcdBarrier {
    unsigned* bar; unsigned x;
    volatile LAS unsigned* st;
};

__device__ __forceinline__ XcdBarrier xcd_barrier_post(unsigned* bar, volatile LAS unsigned* st) {
    XcdBarrier b; b.bar = bar; b.x = xb_xcc_id(); b.st = st;
    if (threadIdx.x == 0) (void)xb_add(&bar[XB_XCNT(b.x)], 1u);
    return b;
}
__device__ __forceinline__ void xcd_barrier_complete(unsigned* bar, unsigned x, unsigned& nloc, unsigned& nx) {
    const unsigned G = gridDim.x * gridDim.y * gridDim.z;
    unsigned sum, cnt, mine, sp = 0u;
    for (;;) {
        sum = 0u; cnt = 0u; mine = 0u;
#pragma unroll
        for (unsigned j = 0; j < 16; ++j) { const unsigned c = xb_ld(&bar[XB_XCNT(j)]); sum += c; cnt += (c > 0u) ? 1u : 0u; mine = (j == x) ? c : mine; }
        if (sum == G) break;
        __builtin_amdgcn_s_sleep(1);
        if ((++sp & 255u) == 0u) { if (xb_ld(&bar[XB_TMO])) break; if (sp > XB_SPIN_CAP) { atomicAdd(&bar[XB_TMO], 1u); break; } }
    }
    nloc = mine > 0u ? mine : 1u; nx = cnt > 0u ? cnt : 1u;
}

__device__ __forceinline__ void xcd_barrier(const XcdBarrier& b) {
    asm volatile("s_waitcnt vmcnt(0)" ::: "memory");
    __syncthreads();
    if (threadIdx.x == 0) {
        unsigned* bar = b.bar;
        __builtin_amdgcn_s_waitcnt(0);
        unsigned nloc = b.st[0], nx = b.st[1];
        if (nloc == 0u) { xcd_barrier_complete(bar, b.x, nloc, nx); b.st[0] = nloc; b.st[1] = nx; }
        const unsigned old = xb_add(&bar[XB_XSUB(b.x)], 1u);
        const unsigned gen = old / nloc;
        if (old + 1u == (gen + 1u) * nloc) {
            __builtin_amdgcn_fence(__ATOMIC_RELEASE, "agent");
            asm volatile("s_waitcnt vmcnt(0)" ::: "memory");
            const unsigned og = xb_add(&bar[XB_TOP], 1u);
            const unsigned tg = og / nx;
            if (og + 1u == (tg + 1u) * nx) xb_add(&bar[XB_TOPGEN], 1u);
            else XB_SPIN(xb_ld(&bar[XB_TOPGEN]) == tg, bar);
            __builtin_amdgcn_fence(__ATOMIC_ACQUIRE, "agent");
            xb_add(&bar[XB_XGEN(b.x)], 1u);
            asm volatile("s_waitcnt vmcnt(0)" ::: "memory");
        } else {
            XB_SPIN(xb_ld(&bar[XB_XGEN(b.x)]) == gen, bar);
            __builtin_amdgcn_fence(__ATOMIC_ACQUIRE, "agent");
            asm volatile("s_waitcnt vmcnt(0)" ::: "memory");
        }
    }
    __syncthreads();
}


#ifndef REPG
#define REPG 1
#endif
#ifndef REPS1
#define REPS1 1
#endif
#ifndef REPP
#define REPP 1
#endif
template <class Epi>
__device__ __forceinline__ void run_gemm(LAS unsigned char* lds, const pg8::Gemm& g, const Epi& E) {
    pg8::StaticOrder S; S.init(g.M, g.N, (int)gridDim.x, (int)blockIdx.x);
#pragma unroll 1
    for (int rep_ = 0; rep_ < REPG; ++rep_) pg8::gemm_phase<Epi, pg8::StaticOrder, true, true>((PG8_LAS unsigned char*)lds, g, S, E);
}
__device__ __forceinline__ pg8::Gemm mk_gemm(const bf16_t* A, const bf16_t* As, int pm_split, const bf16_t* Bt, int M, int N, int K, int lda, int ldb) {
    pg8::Gemm g; g.A = A; g.As = As ? As : A; g.A2 = A; g.A2s = g.As; g.Bt = Bt; g.M = M; g.N = N; g.K = K; g.lda = lda; g.ldb = ldb; g.pm_split = pm_split; g.nt1 = K / 64; return g;
}
#ifndef PH_LO
#define PH_LO 0
#endif
#ifndef PH_HI
#define PH_HI 16
#endif
__global__ void __launch_bounds__(512, 2) hybrid_fwd(Params p_arg) {
    extern __shared__ __attribute__((aligned(16))) unsigned char lds_raw[];
    LAS unsigned char* lds = (LAS unsigned char*)lds_raw;
    cg::grid_group grid = cg::this_grid();
    volatile LAS unsigned* MISC = (volatile LAS unsigned*)(lds + LDS_BYTES - 64);
    if (threadIdx.x < 8) MISC[threadIdx.x] = 0u;
    __syncthreads();
    XcdBarrier xbar = xcd_barrier_post((unsigned*)p_arg.ws, MISC);
#define PH(k) if (PH_LO <= (k) && (k) < PH_HI)
#if defined(__HIP_DEVICE_COMPILE__)
#define LOADP() Params p; { const __attribute__((address_space(4))) Params* kp_ = (const __attribute__((address_space(4))) Params*)__builtin_amdgcn_kernarg_segment_ptr(); asm volatile("" : "+s"(kp_)); p = *(const Params*)kp_; } unsigned char* ws = p.ws; (void)ws; int tid = threadIdx.x; asm volatile("" : "+v"(tid)); const int lane = tid & 63, wid = __builtin_amdgcn_readfirstlane(tid >> 6); (void)lane; (void)wid
#else
#define LOADP() Params p = p_arg; unsigned char* ws = p.ws; (void)ws; int tid = threadIdx.x; const int lane = tid & 63, wid = tid >> 6; (void)lane; (void)wid
#endif
#define SYNC(k) if (PH_LO <= (k) && (k) + 1 < PH_HI) { if ((k) == 0) grid.sync(); else xcd_barrier(xbar); }
#ifdef XSYNC
    for (int i_ = 0; i_ < XSYNC; ++i_) xcd_barrier(xbar);
#endif
    PH(0) { LOADP(); for (int rep_ = 0; rep_ < REPP; ++rep_) p0_phase(p, lds, tid, wid, lane); } SYNC(0);
    PH(1) { LOADP(); for (int rep_ = 0; rep_ < REPP; ++rep_) p1_phase(p, wid, lane); } SYNC(1);
    PH(2) { LOADP();
        pg8::Gemm g = mk_gemm((const bf16_t*)(p.out + O_CKVP), (const bf16_t*)(p.out + O_CKVS), 64, (const bf16_t*)(ws + W_BT_DN), MT, 4352, 1024, 1024, 1024);
        EpiProj E{0, ws, p.out}; run_gemm(lds, g, E); } SYNC(2);
    PH(3) { LOADP(); for (int u = blockIdx.x; u < 2176; u += gridDim.x) prep_unit(p, lds, u, tid, wid, lane); } SYNC(3);
    PH(4) { LOADP();
        for (int rep_ = 0; rep_ < REPS1; ++rep_) for (int ci = blockIdx.x; ci < 256; ci += gridDim.x) { if (ci & 1) scan_chain<1>(p, lds, ci >> 4, (ci >> 1) & 7, tid, wid, lane); else scan_chain<0>(p, lds, ci >> 4, (ci >> 1) & 7, tid, wid, lane); }
        xcd_barrier(xbar); }
    PH(4) { LOADP();
        for (int ci = blockIdx.x; ci < 256; ci += gridDim.x) { if (ci < 128) scan_chain<2>(p, lds, ci >> 3, ci & 7, tid, wid, lane); else scan_chain<3>(p, lds, ci - 128, 0, tid, wid, lane); } } SYNC(4);
    PH(5) { LOADP();
        pg8::Gemm g = mk_gemm((const bf16_t*)(p.out + O_CKVP), (const bf16_t*)(p.out + O_CKVS), 64, (const bf16_t*)(ws + W_BT_MLA), MT, 5376, 1024, 1024, 1024);
        EpiProj E{1, ws, p.out}; run_gemm(lds, g, E); } SYNC(5);
    PH(6) { LOADP(); e1_phase(p, wid, lane); } SYNC(6);
    PH(7) { LOADP();
        { pg8::Gemm g = mk_gemm((const bf16_t*)(ws + W_CKVP), nullptr, 1 << 20, (const bf16_t*)(ws + W_BT_UKV), MP, 1024, 512, 512, 512); EpiStore E{(bf16_t*)(ws + W_KN), 1024}; run_gemm(lds, g, E); }
        { pg8::Gemm g = mk_gemm((const bf16_t*)(ws + W_BT_UKV) + (size_t)1024 * 512, nullptr, 1 << 20, (const bf16_t*)(ws + W_CKVP), 1024, MP, 512, 512, 512); EpiStore E{(bf16_t*)(ws + W_VT), MP}; run_gemm(lds, g, E); } } SYNC(7);
    PH(8) { LOADP(); e2_phase(p, (bf16_t*)(ws + W_KN), MP, wid, lane); } SYNC(8);
    PH(9) { LOADP(); attn_prompt_phase(p, lds, tid, wid, lane); } SYNC(9);
    PH(10) { LOADP();
        pg8::Gemm g = mk_gemm((const bf16_t*)(ws + W_UAP), nullptr, 1 << 20, (const bf16_t*)(ws + W_BT_O), MP, 1024, 2048, 1024, 2048); g.A2 = (const bf16_t*)(ws + W_UBP); g.A2s = g.A2; g.nt1 = 16;
        EpiMerge E{(const bf16_t*)(p.out + O_YP), (bf16_t*)(ws + W_MRGP)}; run_gemm(lds, g, E);
        build_sample_kv(p, wid, lane); } SYNC(10);
    PH(11) { LOADP();
        { pg8::Gemm g = mk_gemm((const bf16_t*)(ws + W_MRGP), nullptr, 1 << 20, (const bf16_t*)(ws + W_BT_OUT), MP, 1024, 1024, 1024, 1024);
          EpiOut E{p.in[I_XP], p.out + O_YP, (const float*)(ws + W_MOD), 8192, 0}; run_gemm(lds, g, E); }
        { pg8::Gemm g = mk_gemm((const bf16_t*)(ws + W_CKVALL), nullptr, 1 << 20, (const bf16_t*)(ws + W_BT_UKV), MKS, 1024, 512, 512, 512); EpiStore E{(bf16_t*)(ws + W_KNS), 1024}; run_gemm(lds, g, E); }
        { pg8::Gemm g = mk_gemm((const bf16_t*)(ws + W_BT_UKV) + (size_t)1024 * 512, nullptr, 1 << 20, (const bf16_t*)(ws + W_CKVALL), 1024, MKS, 512, 512, 512); EpiStore E{(bf16_t*)(ws + W_VTS), MKS}; run_gemm(lds, g, E); } } SYNC(11);
    PH(12) { LOADP(); e2_phase(p, (bf16_t*)(ws + W_KNS), MKS, wid, lane); } SYNC(12);
    PH(13) { LOADP(); attn_sample_phase(p, lds, tid, wid, lane); } SYNC(13);
    PH(14) { LOADP(); pg8::Gemm g = mk_gemm((const bf16_t*)(ws + W_UAS), nullptr, 1 << 20, (const bf16_t*)(ws + W_BT_O), MS, 1024, 2048, 1024, 2048); g.A2 = (const bf16_t*)(ws + W_UBS); g.A2s = g.A2; g.nt1 = 16;
        EpiMerge E{(const bf16_t*)(p.out + O_YS), (bf16_t*)(ws + W_MRGS)}; run_gemm(lds, g, E); } SYNC(14);
    PH(15) { LOADP(); pg8::Gemm g = mk_gemm((const bf16_t*)(ws + W_MRGS), nullptr, 1 << 20, (const bf16_t*)(ws + W_BT_OUT), MS, 1024, 1024, 1024, 1024);
        EpiOut E{p.in[I_XS], p.out + O_YS, (const float*)(ws + W_MOD), 32, 2}; run_gemm(lds, g, E); }
}

extern "C" void kernel_launch(void* const* d_in, const int* in_sizes, int n_in, void* d_out, int out_size, void* d_ws, size_t ws_size, hipStream_t stream) {
    static int grid = 0;
    if (grid == 0) {
        int dev = 0, cus = 0, per_cu = 0;
        if (n_in != 26 || ws_size < 256 * MiB) { fprintf(stderr, "kernel_launch: unexpected n_in %d / ws %zu\n", n_in, ws_size); grid = -1; return; }
        hipGetDevice(&dev); hipDeviceGetAttribute(&cus, hipDeviceAttributeMultiprocessorCount, dev);
        if (hipFuncSetAttribute((const void*)hybrid_fwd, hipFuncAttributeMaxDynamicSharedMemorySize, LDS_BYTES) != hipSuccess) { fprintf(stderr, "kernel_launch: hipFuncSetAttribute failed\n"); }
        if (hipOccupancyMaxActiveBlocksPerMultiprocessor(&per_cu, (const void*)hybrid_fwd, 512, LDS_BYTES) != hipSuccess || per_cu < 1) { fprintf(stderr, "kernel_launch: occupancy query says %d\n", per_cu); per_cu = 1; }
        (void)hipGetLastError();
        grid = cus;
    }
    if (grid < 0) return;
    Params p{};
    for (int i = 0; i < 26; ++i) p.in[i] = (const float*)d_in[i];
    p.out = (float*)d_out; p.ws = (unsigned char*)d_ws;
    if (hipMemsetAsync(d_ws, 0, 65536, stream) != hipSuccess) { fprintf(stderr, "kernel_launch: memset failed\n"); return; }
    void* args[] = {&p};
    hipError_t e = hipLaunchCooperativeKernel((const void*)hybrid_fwd, dim3(grid), dim3(512), args, LDS_BYTES, stream);
    if (e != hipSuccess) fprintf(stderr, "cooperative launch failed: %s (grid %d)\n", hipGetErrorString(e), grid);
}
```

```cpp
#include <hip/hip_runtime.h>
#include <hip/hip_cooperative_groups.h>
#include <cstdio>
#include <cstdint>
namespace cg = cooperative_groups;
namespace pg8 {
#define PG8_LAS __attribute__((address_space(3)))
typedef unsigned short bf16_t;
typedef short bf16x8 __attribute__((ext_vector_type(8)));
typedef float f32x4 __attribute__((ext_vector_type(4)));
typedef unsigned u32x4 __attribute__((ext_vector_type(4)));
constexpr int BM = 256, BK = 64, HALF = 128, HTB = HALF * BK * 2  , STAGE_BYTES = 8 * HTB, NXCD = 8, WGM = 8;

__host__ __device__ __forceinline__ int lds_byte(int r, int c) { const int st = (r >> 4) * 2 + (c >> 5), rr = r & 15, cc = c & 31, ob = rr * 64 + cc * 2; return st * 1024 + (ob ^ (((ob >> 9) & 1) << 5)); }
__host__ __device__ __forceinline__ void stage_rc(int b, int& R, int& C) { const int st = b / 1024, sb = b % 1024, swz = sb ^ (((sb >> 9) & 1) << 5); R = (st >> 1) * 16 + swz / 64; C = (st & 1) * 32 + (swz % 64) / 2; }
__host__ __device__ __forceinline__ int perm32(int rho) { const int n = rho >> 4, i = rho & 15; return 8 * (i >> 2) + 4 * n + (i & 3); }

struct Unit { int pm, pn; };
struct Gemm { const bf16_t* A; const bf16_t* As; const bf16_t* A2; const bf16_t* A2s; const bf16_t* Bt; int M, N, K, lda, ldb, pm_split, nt1; };

struct StaticOrder {
    int nM, nN, nwg, G, c;
    __host__ __device__ void init(int M, int N, int G_, int c_) { nM = M / BM; nN = N / BM; nwg = nM * nN; G = G_; c = c_; }
    __host__ __device__ bool next(int i, Unit& u) const {
        const long L = (long)i * G + c; if (L >= nwg) return false;
        int wgid = (int)L; { const int q = nwg / NXCD, r = nwg % NXCD, xcd = wgid % NXCD, off = wgid / NXCD; wgid = (xcd < r ? xcd * (q + 1) : r * (q + 1) + (xcd - r) * q) + off; }
        const int nig = WGM * nN, gid = wgid / nig, fm = gid * WGM, gsz = (nM - fm) < WGM ? (nM - fm) : WGM;
        u.pm = fm + ((wgid % nig) % gsz); u.pn = (wgid % nig) / gsz; return true;
    }
    __device__ __forceinline__ void a_ready(const Unit&) const {}
    __device__ __forceinline__ void done(const Unit&) const {}
};

__device__ __forceinline__ unsigned cvt_pk_bf16(float lo, float hi) { unsigned r; asm volatile("v_cvt_pk_bf16_f32 %0, %1, %2" : "=v"(r) : "v"(lo), "v"(hi)); return r; }

template <class Epi, class Sched, bool ALIGN_EPI = false, bool SP2 = false>
__device__ __forceinline__ void gemm_phase(PG8_LAS unsigned char* lds, const Gemm g, const Sched& S, const Epi& E) {
    int tid_l = threadIdx.x; asm volatile("" : "+v"(tid_l));
    const int tid = tid_l, wid = __builtin_amdgcn_readfirstlane(tid >> 6), lane = tid & 63, wr = wid >> 2, wc = wid & 3, fr = lane & 15, fq = lane >> 4;
    const int K = g.K, nt = K / BK;
    unsigned voffA[2], voffB[2];
#pragma unroll
    for (int i = 0; i < 2; ++i) { int R, C; stage_rc(tid * 16 + i * 8192, R, C); const int Rb = Epi::PERM ? ((R & ~31) + perm32(R & 31)) : R;
        voffA[i] = (unsigned)(R * g.lda + C) * 2u; voffB[i] = (unsigned)(Rb * g.ldb + C) * 2u; }
    const size_t kstep = (size_t)(BK * 2);
    const size_t hstepA = (size_t)HALF * g.lda * 2, hstepB = (size_t)HALF * g.ldb * 2;
    const size_t tstepA = 2 * hstepA, tstepB = 2 * hstepB; const int nt1 = g.nt1;
    const unsigned ldsw = (unsigned)wid * 1024u;
    const int aoff = lds_byte(wr * 64 + fr, fq * 8), boff = lds_byte(wc * 32 + fr, fq * 8);
#define PG8_SA(b, h) (((b) * 2 + (h)) * HTB)
#define PG8_SB(b, h) ((4 + (b) * 2 + (h)) * HTB)
#define PG8_STAGE(bufoff, gbase, voff) do { _Pragma("unroll") for (int _i = 0; _i < 2; ++_i) \
        __builtin_amdgcn_global_load_lds((const unsigned*)((const char*)(gbase) + (voff)[_i]), (PG8_LAS unsigned*)(lds + (bufoff) + ldsw + _i * 8192), 16, 0, 0); } while (0)
#define PG8_LDA(dst, b, h) do { _Pragma("unroll") for (int m = 0; m < 4; ++m) _Pragma("unroll") for (int k = 0; k < 2; ++k) dst[m][k] = *(const PG8_LAS bf16x8*)(lds + PG8_SA(b, h) + aoff + m * 2048 + k * 1024); } while (0)
#define PG8_LDB(dst, b, h) do { _Pragma("unroll") for (int n = 0; n < 2; ++n) _Pragma("unroll") for (int k = 0; k < 2; ++k) dst[n][k] = *(const PG8_LAS bf16x8*)(lds + PG8_SB(b, h) + boff + n * 2048 + k * 1024); } while (0)
#define PG8_MMA(ai, bj, At, Bt) do { __builtin_amdgcn_s_setprio(1); _Pragma("unroll") for (int m = 0; m < 4; ++m) _Pragma("unroll") for (int n = 0; n < 2; ++n) _Pragma("unroll") for (int k = 0; k < 2; ++k) \
        acc[ai][bj][m][n] = __builtin_amdgcn_mfma_f32_16x16x32_bf16(Bt[n][k], At[m][k], acc[ai][bj][m][n], 0, 0, 0); __builtin_amdgcn_s_setprio(0); } while (0)
#define PG8_WAIT_V(n) asm volatile("s_waitcnt vmcnt(" #n ")" ::: "memory")
#define PG8_WAIT_L(n) asm volatile("s_waitcnt lgkmcnt(" #n ")" ::: "memory")
#define PG8_BAR __builtin_amdgcn_s_barrier()
#define PG8_SCHED __builtin_amdgcn_sched_barrier(0)
    Unit cur, nxt; int ui = 0;
    if (!S.next(0, cur)) return;
    f32x4 acc[2][2][4][2];
#pragma unroll
    for (int a = 0; a < 2; ++a)
#pragma unroll
        for (int b = 0; b < 2; ++b)
#pragma unroll
            for (int m = 0; m < 4; ++m)
#pragma unroll
                for (int n = 0; n < 2; ++n) acc[a][b][m][n] = (f32x4){0.f, 0.f, 0.f, 0.f};
    bf16x8 At[4][2], B0[2][2], B1[2][2];
    #define PG8_UA(P, Ps, pm_) ((pm_) < g.pm_split ? (const char*)(P) + (size_t)(pm_) * tstepA : (const char*)(Ps) + (size_t)((pm_) - g.pm_split) * tstepA)
#define PG8_KA(t_) ((t_) < nt1 ? cA + (size_t)(t_) * kstep : cA2 + (size_t)((t_) - nt1) * kstep)
    const char* cA = PG8_UA(g.A, g.As, cur.pm); const char* cA2 = PG8_UA(g.A2, g.A2s, cur.pm); const char* cB = (const char*)g.Bt + (size_t)cur.pn * tstepB;
    S.a_ready(cur);
    if constexpr (SP2) {
        PG8_STAGE(PG8_SB(0, 0), cB, voffB); PG8_STAGE(PG8_SB(0, 1), cB + hstepB, voffB); PG8_STAGE(PG8_SA(0, 0), cA, voffA); PG8_STAGE(PG8_SA(0, 1), cA + hstepA, voffA);
        if (wr == 1) PG8_BAR;
        PG8_WAIT_V(2); PG8_BAR;
        PG8_STAGE(PG8_SB(1, 0), cB + kstep, voffB); PG8_STAGE(PG8_SA(1, 0), cA + kstep, voffA); PG8_STAGE(PG8_SB(1, 1), cB + hstepB + kstep, voffB);
        PG8_WAIT_V(6); PG8_BAR;
    } else {
        PG8_STAGE(PG8_SB(0, 0), cB, voffB); PG8_STAGE(PG8_SA(0, 0), cA, voffA); PG8_STAGE(PG8_SB(0, 1), cB + hstepB, voffB); PG8_STAGE(PG8_SA(0, 1), cA + hstepA, voffA);
        if (wr == 1) PG8_BAR;
        PG8_WAIT_V(4); PG8_BAR;
        PG8_STAGE(PG8_SB(1, 0), cB + kstep, voffB); PG8_STAGE(PG8_SA(1, 0), cA + kstep, voffA); PG8_STAGE(PG8_SB(1, 1), cB + hstepB + kstep, voffB);
        PG8_WAIT_V(6); PG8_BAR;
    }
    for (;;) {
        const bool has_next = S.next(ui + 1, nxt);
        const char* nA = has_next ? PG8_UA(g.A, g.As, nxt.pm) : cA; const char* nA2 = has_next ? PG8_UA(g.A2, g.A2s, nxt.pm) : cA2; const char* nB = has_next ? (const char*)g.Bt + (size_t)nxt.pn * tstepB : cB;
        for (int t = 0; t < nt; t += 2) {
            const bool last = (t == nt - 2);
            if constexpr (Epi::HAS_MID) { if (t == nt1) E.mid(acc, cur, wr, wc, fr, fq); }
            const char* a1 = PG8_KA(t + 1);
            const char* a2 = last ? nA : PG8_KA(t + 2); const char* b2 = last ? nB : cB + (size_t)(t + 2) * kstep;
            const char* a3 = a2 + kstep; const char* b3 = b2 + kstep;
            if (last && has_next) S.a_ready(nxt);
            if constexpr (SP2) {
            PG8_LDB(B0, 0, 0); PG8_LDB(B1, 0, 1); PG8_SCHED; PG8_LDA(At, 0, 0); PG8_STAGE(PG8_SA(1, 1), a1 + hstepA, voffA);
            PG8_WAIT_V(8); PG8_WAIT_L(0); PG8_BAR; PG8_MMA(0, 0, At, B0); PG8_MMA(0, 1, At, B1); PG8_BAR; PG8_SCHED;
            PG8_LDA(At, 0, 1); PG8_STAGE(PG8_SB(0, 0), b2, voffB); PG8_STAGE(PG8_SB(0, 1), b2 + hstepB, voffB); PG8_STAGE(PG8_SA(0, 0), a2, voffA);
            PG8_WAIT_V(8); PG8_WAIT_L(0); PG8_BAR; PG8_MMA(1, 0, At, B0); PG8_MMA(1, 1, At, B1); PG8_BAR; PG8_SCHED;
            PG8_LDB(B0, 1, 0); PG8_LDB(B1, 1, 1); PG8_SCHED; PG8_LDA(At, 1, 0); PG8_STAGE(PG8_SA(0, 1), a2 + hstepA, voffA);
            PG8_WAIT_V(8); PG8_WAIT_L(0); PG8_BAR; PG8_MMA(0, 0, At, B0); PG8_MMA(0, 1, At, B1); PG8_BAR; PG8_SCHED;
            PG8_LDA(At, 1, 1); PG8_STAGE(PG8_SB(1, 0), b3, voffB); PG8_STAGE(PG8_SB(1, 1), b3 + hstepB, voffB); PG8_STAGE(PG8_SA(1, 0), a3, voffA);
            PG8_WAIT_V(8); PG8_WAIT_L(0); PG8_BAR; PG8_MMA(1, 0, At, B0); PG8_MMA(1, 1, At, B1); PG8_BAR; PG8_SCHED;
            } else {
            PG8_LDB(B0, 0, 0); PG8_SCHED; PG8_LDA(At, 0, 0); PG8_STAGE(PG8_SA(1, 1), a1 + hstepA, voffA);
            PG8_WAIT_L(8); PG8_BAR; PG8_WAIT_L(0); PG8_MMA(0, 0, At, B0); PG8_BAR; PG8_SCHED;
            PG8_LDB(B1, 0, 1); PG8_STAGE(PG8_SB(0, 0), b2, voffB);
            PG8_BAR; PG8_WAIT_L(0); PG8_MMA(0, 1, At, B1); PG8_BAR;
            PG8_LDA(At, 0, 1); PG8_STAGE(PG8_SA(0, 0), a2, voffA);
            PG8_BAR; PG8_WAIT_L(0); PG8_MMA(1, 0, At, B0); PG8_BAR; PG8_SCHED;
            PG8_STAGE(PG8_SB(0, 1), b2 + hstepB, voffB);
            PG8_WAIT_V(6); PG8_BAR; PG8_MMA(1, 1, At, B1); PG8_BAR;
            PG8_LDB(B0, 1, 0); PG8_SCHED; PG8_LDA(At, 1, 0); PG8_STAGE(PG8_SA(0, 1), a2 + hstepA, voffA);
            PG8_WAIT_L(8); PG8_BAR; PG8_WAIT_L(0); PG8_MMA(0, 0, At, B0); PG8_BAR; PG8_SCHED;
            PG8_LDB(B1, 1, 1); PG8_STAGE(PG8_SB(1, 0), b3, voffB);
            PG8_BAR; PG8_WAIT_L(0); PG8_MMA(0, 1, At, B1); PG8_BAR;
            PG8_LDA(At, 1, 1); PG8_STAGE(PG8_SA(1, 0), a3, voffA);
            PG8_BAR; PG8_WAIT_L(0); PG8_MMA(1, 0, At, B0); PG8_BAR; PG8_SCHED;
            PG8_STAGE(PG8_SB(1, 1), b3 + hstepB, voffB);
            PG8_WAIT_V(6); PG8_BAR; PG8_MMA(1, 1, At, B1); PG8_BAR;
            }
        }
        if constexpr (ALIGN_EPI) { if (wr == 0) PG8_BAR; }
        if constexpr (!Epi::AFTER_DRAIN) { E(acc, cur, wr, wc, fr, fq); S.done(cur); }
        if (!has_next) break;
#pragma unroll
        for (int a = 0; a < 2; ++a)
#pragma unroll
            for (int b = 0; b < 2; ++b)
#pragma unroll
                for (int m = 0; m < 4; ++m)
#pragma unroll
                    for (int n = 0; n < 2; ++n) acc[a][b][m][n] = (f32x4){0.f, 0.f, 0.f, 0.f};
        cur = nxt; cA = nA; cA2 = nA2; cB = nB; ++ui;
        if constexpr (ALIGN_EPI) { if (wr == 1) PG8_BAR; }
    }
    PG8_WAIT_V(0);
    if constexpr (!ALIGN_EPI) { if (wr == 0) PG8_BAR; }
    PG8_BAR;
    if constexpr (Epi::AFTER_DRAIN) { E.fused(acc, cur, wr, wc, fr, fq, lds, wid, lane); S.done(cur); }
#undef PG8_UA
#undef PG8_KA
#undef PG8_SA
#undef PG8_SB
#undef PG8_STAGE
#undef PG8_LDA
#undef PG8_LDB
#undef PG8_MMA
#undef PG8_WAIT_V
#undef PG8_WAIT_L
#undef PG8_BAR
#undef PG8_SCHED
}
}
#define LAS __attribute__((address_space(3)))
typedef unsigned short bf16_t;
typedef short bf16x8 __attribute__((ext_vector_type(8)));
typedef float f32x4 __attribute__((ext_vector_type(4)));
typedef float f32x16 __attribute__((ext_vector_type(16)));
typedef unsigned u32x4 __attribute__((ext_vector_type(4)));
typedef unsigned u32x2 __attribute__((ext_vector_type(2)));
typedef float f32x2_t __attribute__((ext_vector_type(2)));
typedef __bf16 bf16x2_t __attribute__((ext_vector_type(2)));

constexpr int MP = 16384, MS = 512, MT = MP + MS, TKS = 2080, MKS = 16 * TKS  ;
constexpr float EPS = 1e-6f;
constexpr size_t MiB = 1u << 20;
constexpr size_t W_BT_DN = 1 * MiB, W_BT_MLA = W_BT_DN + (size_t)4352 * 1024 * 2, W_BT_UKV = 20 * MiB, W_BT_O = 22 * MiB, W_BT_OUT = 26 * MiB;
constexpr size_t W_MOD = 28 * MiB, W_GL = 28 * MiB + 256 * 1024, W_BA = 28 * MiB + 512 * 1024;
constexpr size_t W_QS = 30 * MiB, W_CKVS = 31 * MiB + 512 * 1024, W_KRS = 32 * MiB, W_UAS = 33 * MiB, W_UBS = 34 * MiB, W_MRGS = 35 * MiB;
constexpr size_t W_QKV = 36 * MiB, W_HALO = 135 * MiB, W_KDT = 140 * MiB, W_SQKV = 174 * MiB, W_UAP = 190 * MiB, W_TB = 222 * MiB, W_MB = 239 * MiB, W_UBP = 222 * MiB;
constexpr size_t W_QP = 36 * MiB, W_CKVP = 84 * MiB, W_KRP = 100 * MiB, W_KN = 102 * MiB, W_VT = 134 * MiB;
constexpr size_t W_MRGP = 36 * MiB, W_CKVALL = 68 * MiB, W_KRALL = 101 * MiB, W_KNS = 106 * MiB, W_VTS = 172 * MiB;
static_assert(W_BT_MLA + (size_t)5376 * 1024 * 2 <= W_BT_UKV, "ws map");
static_assert(W_BA + (size_t)MT * 16 * 4 <= W_QS, "ws map");
static_assert(W_QKV + (size_t)MT * 3072 * 2 <= W_HALO && W_HALO + (size_t)264 * 3 * 3072 * 2 <= W_KDT && W_KDT + (size_t)2176 * 8192 * 2 <= W_SQKV && W_SQKV + (size_t)128 * 3 * 8192 * 2 <= W_UAP, "ws map");
static_assert(W_TB + (size_t)2176 * 4096 * 2 <= W_MB && W_MB + (size_t)128 * 2 * 16384 * 4 <= 256 * MiB && W_UAP + (size_t)MP * 1024 * 2 <= W_UBP && W_UBP + (size_t)MP * 1024 * 2 <= 256 * MiB, "ws map");
static_assert(W_QP + (size_t)MP * 1536 * 2 <= W_CKVP && W_CKVP + (size_t)MP * 512 * 2 <= W_KRP && W_KRP + (size_t)MP * 64 * 2 <= W_KN && W_KN + (size_t)MP * 1024 * 2 <= W_VT && W_VT + (size_t)MP * 1024 * 2 <= W_UAP, "ws map");
static_assert(W_MRGP + (size_t)MP * 1024 * 2 <= W_CKVALL && W_CKVALL + (size_t)(MKS + 64) * 512 * 2 <= W_KRALL && W_KRALL + (size_t)(MKS + 64) * 64 * 2 <= W_KNS && W_KNS + (size_t)(MKS + 64) * 1024 * 2 <= W_VTS && W_VTS + (size_t)1024 * MKS * 2 + 256 <= 256 * MiB, "ws map");
constexpr size_t O_YP = 0, O_YS = O_YP + (size_t)MP * 1024, O_CKVP = O_YS + (size_t)MS * 1024, O_KRP = O_CKVP + (size_t)MP * 512, O_SDP = O_KRP + (size_t)MP * 64,
                 O_CVP = O_SDP + 2 * 8 * 128 * 128, O_CKVS = O_CVP + 2 * 3 * 3072, O_KRS = O_CKVS + (size_t)MS * 512, O_SDS = O_KRS + (size_t)MS * 64, O_CVS = O_SDS + (size_t)16 * 8 * 128 * 128;
constexpr int LDS_BYTES = 163840;

struct Params { const float* in[26]; float* out; unsigned char* ws; };
enum { I_XP = 0, I_XS, I_CP, I_CS, I_CCKV, I_CKR, I_SD, I_SC, I_NG, I_WADA, I_BADA, I_WIN, I_WCONV, I_ALOG, I_DTB, I_DNN, I_QNN, I_QRN, I_KNN, I_KRN, I_KVN, I_WUK, I_WUV, I_WODN, I_WOMLA, I_WOUT };

__device__ __forceinline__ float bf2f(unsigned short u) { return __uint_as_float((unsigned)u << 16); }
__device__ __forceinline__ float bflo(unsigned u) { return __uint_as_float(u << 16); }
__device__ __forceinline__ float bfhi(unsigned u) { return __uint_as_float(u & 0xffff0000u); }
__device__ __forceinline__ unsigned pk2(float lo, float hi) { f32x2_t v = {lo, hi}; bf16x2_t b = __builtin_convertvector(v, bf16x2_t); return __builtin_bit_cast(unsigned, b); }
__device__ __forceinline__ unsigned short f2bf(float f) { return (unsigned short)(pk2(f, 0.f) & 0xffffu); }
__device__ __forceinline__ float wave_sum(float v) {
#pragma unroll
    for (int o = 1; o < 64; o <<= 1) v += __shfl_xor(v, o);
    return v;
}
__device__ __forceinline__ float sigmoidf_(float x) { return 1.f / (1.f + __expf(-x)); }
__device__ __forceinline__ float siluf_(float x) { return x / (1.f + __expf(-x)); }
__device__ __forceinline__ void unpack8(u32x4 v, float* f) { f[0] = bflo(v.x); f[1] = bfhi(v.x); f[2] = bflo(v.y); f[3] = bfhi(v.y); f[4] = bflo(v.z); f[5] = bfhi(v.z); f[6] = bflo(v.w); f[7] = bfhi(v.w); }
__device__ __forceinline__ u32x4 pack8(const float* f) { u32x4 v; v.x = pk2(f[0], f[1]); v.y = pk2(f[2], f[3]); v.z = pk2(f[4], f[5]); v.w = pk2(f[6], f[7]); return v; }

using pg8::Unit;
struct EpiStore {
    static constexpr bool PERM = true, AFTER_DRAIN = false, HAS_MID = false;
    bf16_t* O; int ldc;
    __device__ __forceinline__ void operator()(const f32x4 (&acc)[2][2][4][2], const Unit& u, int wr, int wc, int fr, int fq) const {
#pragma unroll
        for (int ai = 0; ai < 2; ++ai)
#pragma unroll
            for (int m = 0; m < 4; ++m) { const int row = u.pm * 256 + ai * 128 + wr * 64 + m * 16 + fr; bf16_t* rp = O + (size_t)row * ldc + u.pn * 256 + wc * 32 + 8 * fq;
#pragma unroll
                for (int bj = 0; bj < 2; ++bj) { const f32x4 v0 = acc[ai][bj][m][0], v1 = acc[ai][bj][m][1]; u32x4 w; w.x = pk2(v0[0], v0[1]); w.y = pk2(v0[2], v0[3]); w.z = pk2(v1[0], v1[1]); w.w = pk2(v1[2], v1[3]);
                    *(u32x4*)(rp + bj * 128) = w; } }
    }
};
struct EpiProj {
    static constexpr bool PERM = true, AFTER_DRAIN = false, HAS_MID = false;
    int pass; unsigned char* ws; float* out;
    __device__ __forceinline__ void operator()(const f32x4 (&acc)[2][2][4][2], const Unit& u, int wr, int wc, int fr, int fq) const {
        bf16_t* bp; bf16_t* bs; int ldc, ct; int kind = 0;
        const int pn = u.pn;
        if (pass == 0) {
            if (pn < 12) { bp = (bf16_t*)(ws + W_QKV); bs = bp + (size_t)MP * 3072; ldc = 3072; ct = pn * 256; kind = 3; }
            else if (pn < 16) { bp = (bf16_t*)(ws + W_UAP); bs = (bf16_t*)(ws + W_UAS); ldc = 1024; ct = (pn - 12) * 256; }
            else { bp = bs = nullptr; ldc = 0; ct = 0; kind = 1; }
        } else {
            if (pn < 6) { bp = (bf16_t*)(ws + W_QP); bs = (bf16_t*)(ws + W_QS); ldc = 1536; ct = pn * 256; }
            else if (pn < 8) { bp = (bf16_t*)(ws + W_CKVP); bs = (bf16_t*)(ws + W_CKVS); ldc = 512; ct = (pn - 6) * 256; }
            else if (pn < 12) { bp = (bf16_t*)(ws + W_UBP); bs = (bf16_t*)(ws + W_UBS); ldc = 1024; ct = (pn - 8) * 256; }
            else if (pn < 20) { bp = (bf16_t*)(out + O_YP); bs = (bf16_t*)(out + O_YS); ldc = 2048; ct = (pn - 12) * 256; }
            else { bp = (bf16_t*)(ws + W_KRP); bs = (bf16_t*)(ws + W_KRS); ldc = 64; ct = 0; kind = 2; }
        }
        if (kind == 1) {
            if (wc != 0 || fq >= 2) return;
            float* ba = (float*)(ws + W_BA);
#pragma unroll
            for (int ai = 0; ai < 2; ++ai)
#pragma unroll
                for (int m = 0; m < 4; ++m) { const int row = u.pm * 256 + ai * 128 + wr * 64 + m * 16 + fr; float* rp = ba + (size_t)row * 16 + 8 * fq;
                    *(f32x4*)rp = acc[ai][0][m][0]; *(f32x4*)(rp + 4) = acc[ai][0][m][1]; }
            return;
        }
        if (kind == 2 && wc >= 2) return;
#pragma unroll
        for (int ai = 0; ai < 2; ++ai)
#pragma unroll
            for (int m = 0; m < 4; ++m) { const int row = u.pm * 256 + ai * 128 + wr * 64 + m * 16 + fr;
                bf16_t* rp = (row < MP ? bp + (size_t)row * ldc : bs + (size_t)(row - MP) * ldc) + ct + wc * 32 + 8 * fq;
#pragma unroll
                for (int bj = 0; bj < 2; ++bj) { if (kind == 2 && bj == 1) continue;
                    const f32x4 v0 = acc[ai][bj][m][0], v1 = acc[ai][bj][m][1]; u32x4 w; w.x = pk2(v0[0], v0[1]); w.y = pk2(v0[2], v0[3]); w.z = pk2(v1[0], v1[1]); w.w = pk2(v1[2], v1[3]);
                    *(u32x4*)(rp + bj * 128) = w;
                    if (kind == 3 && m == 3 && fr >= 13) *(u32x4*)((bf16_t*)(ws + W_HALO) + ((size_t)(row >> 6) * 3 + (fr - 13)) * 3072 + ct + wc * 32 + 8 * fq + bj * 128) = w; } }
    }
};
struct EpiMerge {
    static constexpr bool PERM = true, AFTER_DRAIN = false, HAS_MID = true;
    const bf16_t* G; bf16_t* O;
    __device__ __forceinline__ void mid(f32x4 (&acc)[2][2][4][2], const Unit& u, int wr, int wc, int fr, int fq) const {
#pragma unroll
        for (int ai = 0; ai < 2; ++ai)
#pragma unroll
            for (int m = 0; m < 4; ++m) { const int row = u.pm * 256 + ai * 128 + wr * 64 + m * 16 + fr; const bf16_t* gp = G + (size_t)row * 2048 + u.pn * 256 + wc * 32 + 8 * fq;
#pragma unroll
                for (int bj = 0; bj < 2; ++bj) { float ga[8], gb[8]; unpack8(*(const u32x4*)(gp + bj * 128), ga); unpack8(*(const u32x4*)(gp + 1024 + bj * 128), gb);
#pragma unroll
                    for (int e = 0; e < 8; ++e) { const float f = (1.f + __expf(-gb[e])) / (1.f + __expf(-ga[e])); if (e < 4) acc[ai][bj][m][0][e] *= f; else acc[ai][bj][m][1][e - 4] *= f; } } }
    }
    __device__ __forceinline__ void operator()(const f32x4 (&acc)[2][2][4][2], const Unit& u, int wr, int wc, int fr, int fq) const {
#pragma unroll
        for (int ai = 0; ai < 2; ++ai)
#pragma unroll
            for (int m = 0; m < 4; ++m) { const int row = u.pm * 256 + ai * 128 + wr * 64 + m * 16 + fr; const bf16_t* gp = G + (size_t)row * 2048 + 1024 + u.pn * 256 + wc * 32 + 8 * fq;
                bf16_t* rp = O + (size_t)row * 1024 + u.pn * 256 + wc * 32 + 8 * fq;
#pragma unroll
                for (int bj = 0; bj < 2; ++bj) { float gb[8], v[8]; unpack8(*(const u32x4*)(gp + bj * 128), gb);
#pragma unroll
                    for (int e = 0; e < 8; ++e) v[e] = (e < 4 ? acc[ai][bj][m][0][e] : acc[ai][bj][m][1][e - 4]) * sigmoidf_(gb[e]);
                    *(u32x4*)(rp + bj * 128) = pack8(v); } }
    }
};
struct EpiOut {
    static constexpr bool PERM = true, AFTER_DRAIN = false, HAS_MID = false;
    const float* X; float* Y; const float* mod; int rows_per_batch, mod_row0;
    __device__ __forceinline__ void operator()(const f32x4 (&acc)[2][2][4][2], const Unit& u, int wr, int wc, int fr, int fq) const {
#pragma unroll
        for (int ai = 0; ai < 2; ++ai)
#pragma unroll
            for (int m = 0; m < 4; ++m) { const int row = u.pm * 256 + ai * 128 + wr * 64 + m * 16 + fr; const int col = u.pn * 256 + wc * 32 + 8 * fq;
                const float* gt = mod + (size_t)(mod_row0 + row / rows_per_batch) * 3072 + 2048 + col;
#pragma unroll
                for (int bj = 0; bj < 2; ++bj) {
                    const f32x4 x0 = *(const f32x4*)(X + (size_t)row * 1024 + col + bj * 128), x1 = *(const f32x4*)(X + (size_t)row * 1024 + col + bj * 128 + 4);
                    const f32x4 g0 = *(const f32x4*)(gt + bj * 128), g1 = *(const f32x4*)(gt + bj * 128 + 4);
                    *(f32x4*)(Y + (size_t)row * 1024 + col + bj * 128) = x0 + g0 * acc[ai][bj][m][0];
                    *(f32x4*)(Y + (size_t)row * 1024 + col + bj * 128 + 4) = x1 + g1 * acc[ai][bj][m][1]; } }
    }
};
__device__ __forceinline__ void tr_item(const float* W, int ldw, int n0, int k0, bf16_t* WT, int ldt, int r0, int kdst, LAS float* scr, int lane) {
#pragma unroll 8
    for (int i = 0; i < 32; ++i) { const int kk = 2 * i + (lane >> 5); scr[kk * 33 + (lane & 31)] = W[(size_t)(k0 + kk) * ldw + n0 + (lane & 31)]; }
    asm volatile("s_waitcnt lgkmcnt(0)" ::: "memory");
    const int c = lane & 7;
#pragma unroll
    for (int j = 0; j < 4; ++j) { const int n = (lane >> 3) + 8 * j; const LAS float* s = scr + (8 * c) * 33 + n;
        u32x4 o; o.x = pk2(s[0 * 33], s[1 * 33]); o.y = pk2(s[2 * 33], s[3 * 33]); o.z = pk2(s[4 * 33], s[5 * 33]); o.w = pk2(s[6 * 33], s[7 * 33]);
        *(u32x4*)(WT + (size_t)(r0 + n) * ldt + kdst + k0 + 8 * c) = o; }
    asm volatile("s_waitcnt lgkmcnt(0)" ::: "memory");
}
__device__ __forceinline__ void p0_phase(const Params& p, LAS unsigned char* lds, int tid, int wid, int lane) {
    const int G = gridDim.x, bx = blockIdx.x;
    for (int cb = bx; cb < 48; cb += G) {
        const int j = cb * 64 + lane; float acc[18];
#pragma unroll
        for (int r = 0; r < 18; ++r) acc[r] = 0.f;
        const float* wa = p.in[I_WADA];
        for (int k = wid * 128; k < wid * 128 + 128; ++k) { const float wv = wa[(size_t)k * 3072 + j];
#pragma unroll
            for (int r = 0; r < 18; ++r) { const float cv = r < 2 ? p.in[I_CP][r * 1024 + k] : p.in[I_CS][(r - 2) * 1024 + k]; acc[r] += cv * wv; } }
        LAS float* red = (LAS float*)lds;
#pragma unroll
        for (int r = 0; r < 18; ++r) red[(wid * 18 + r) * 64 + lane] = acc[r];
        __syncthreads();
        for (int o = tid; o < 18 * 64; o += 512) { const int r = o >> 6, l = o & 63; float s = 0.f;
#pragma unroll
            for (int w = 0; w < 8; ++w) s += red[(w * 18 + r) * 64 + l];
            ((float*)(p.ws + W_MOD))[r * 3072 + cb * 64 + l] = s + p.in[I_BADA][cb * 64 + l]; }
        __syncthreads();
    }
    LAS float* scr = (LAS float*)(lds + 40960 + wid * 8448);
    const int gw = bx * 8 + wid, NGW = G * 8;
    constexpr int I_DN = 129 * 16, I_MLA = 162 * 16, I_UK = 32 * 8, I_UV = 32 * 8, I_ODN = 32 * 16, I_OMLA = 32 * 16, I_WO = 32 * 16;
    constexpr int NITEMS = I_DN + I_MLA + I_UK + I_UV + I_ODN + I_OMLA + I_WO;
    for (int it = gw; it < NITEMS; it += NGW) {
        int r = it;
        if (r < I_DN) { const int dg = r >> 4, kb = r & 15; tr_item(p.in[I_WIN], 9296, 32 * dg, 64 * kb, (bf16_t*)(p.ws + W_BT_DN), 1024, 32 * dg, 0, scr, lane); continue; } r -= I_DN;
        if (r < I_MLA) { const int dg = r >> 4, kb = r & 15; int n0;
            if (dg < 48) n0 = 4112 + 32 * dg; else if (dg < 64) n0 = 5648 + 32 * (dg - 48); else if (dg < 96) n0 = 6224 + 32 * (dg - 64); else if (dg < 160) n0 = 7248 + 32 * (dg - 96); else n0 = 6160 + 32 * (dg - 160);
            tr_item(p.in[I_WIN], 9296, n0, 64 * kb, (bf16_t*)(p.ws + W_BT_MLA), 1024, 32 * dg, 0, scr, lane); continue; } r -= I_MLA;
        if (r < I_UK) { const int dg = r >> 3, kb = r & 7; tr_item(p.in[I_WUK], 1024, 32 * dg, 64 * kb, (bf16_t*)(p.ws + W_BT_UKV), 512, 32 * dg, 0, scr, lane); continue; } r -= I_UK;
        if (r < I_UV) { const int dg = r >> 3, kb = r & 7; tr_item(p.in[I_WUV], 1024, 32 * dg, 64 * kb, (bf16_t*)(p.ws + W_BT_UKV), 512, 1024 + 32 * dg, 0, scr, lane); continue; } r -= I_UV;
        if (r < I_ODN) { const int dg = r >> 4, kb = r & 15; tr_item(p.in[I_WODN], 1024, 32 * dg, 64 * kb, (bf16_t*)(p.ws + W_BT_O), 2048, 32 * dg, 0, scr, lane); continue; } r -= I_ODN;
        if (r < I_OMLA) { const int dg = r >> 4, kb = r & 15; tr_item(p.in[I_WOMLA], 1024, 32 * dg, 64 * kb, (bf16_t*)(p.ws + W_BT_O), 2048, 32 * dg, 1024, scr, lane); continue; } r -= I_OMLA;
        { const int dg = r >> 4, kb = r & 15; tr_item(p.in[I_WOUT], 1024, 32 * dg, 64 * kb, (bf16_t*)(p.ws + W_BT_OUT), 1024, 32 * dg, 0, scr, lane); }
    }
}
__device__ __forceinline__ void p1_phase(const Params& p, int wid, int lane) {
    const int gw = blockIdx.x * 8 + wid, NGW = gridDim.x * 8; const float* mod = (const float*)(p.ws + W_MOD);
    for (int row = gw; row < MT; row += NGW) {
        const float* xr = row < MP ? p.in[I_XP] + (size_t)row * 1024 : p.in[I_XS] + (size_t)(row - MP) * 1024;
        const int mr = row < MP ? (row >> 13) : 2 + ((row - MP) >> 5);
        bf16_t* hr = row < MP ? (bf16_t*)(p.out + O_CKVP) + (size_t)row * 1024 : (bf16_t*)(p.out + O_CKVS) + (size_t)(row - MP) * 1024;
        f32x4 v[4]; float s = 0.f;
#pragma unroll
        for (int j = 0; j < 4; ++j) { v[j] = *(const f32x4*)(xr + 4 * lane + 256 * j); s += (v[j].x * v[j].x + v[j].y * v[j].y) + (v[j].z * v[j].z + v[j].w * v[j].w); }
        const float rs = rsqrtf(wave_sum(s) * (1.f / 1024.f) + EPS);
#pragma unroll
        for (int j = 0; j < 4; ++j) { const int c = 4 * lane + 256 * j;
            const f32x4 g = *(const f32x4*)(p.in[I_NG] + c), sh = *(const f32x4*)(mod + mr * 3072 + c), sc = *(const f32x4*)(mod + mr * 3072 + 1024 + c);
            const f32x4 y = v[j] * rs * g * (1.f + sc) + sh; u32x2 o; o.x = pk2(y.x, y.y); o.y = pk2(y.z, y.w); *(u32x2*)(hr + c) = o; }
    }
}
__device__ __forceinline__ void e1_phase(const Params& p, int wid, int lane) {
    const int gw = blockIdx.x * 8 + wid, NGW = gridDim.x * 8;
    const float QSC = 0.07216878364870322f * 1.4426950408889634f;
    for (int row = gw; row < MT; row += NGW) {
        const bool pr = row < MP; const int lr = pr ? row : row - MP;
        const float pos = pr ? (float)(row & 8191) : (float)(2048 + (lr & 31));
        { bf16_t* q = (pr ? (bf16_t*)(p.ws + W_QP) : (bf16_t*)(p.ws + W_QS)) + (size_t)lr * 1536; const int hd = lane >> 3, sub = lane & 7;
          bf16_t* qn = q + hd * 192 + sub * 16; float f[16]; unpack8(*(const u32x4*)qn, f); unpack8(*(const u32x4*)(qn + 8), f + 8);
          float ss = 0.f;
#pragma unroll
          for (int e = 0; e < 16; ++e) ss += f[e] * f[e];
          ss += __shfl_xor(ss, 1); ss += __shfl_xor(ss, 2); ss += __shfl_xor(ss, 4);
          const float rn = rsqrtf(ss * (1.f / 128.f) + EPS) * QSC;
#pragma unroll
          for (int e = 0; e < 16; ++e) f[e] *= rn * p.in[I_QNN][sub * 16 + e];
          *(u32x4*)qn = pack8(f); *(u32x4*)(qn + 8) = pack8(f + 8);
          bf16_t* qr = q + hd * 192 + 128 + sub * 4; const u32x2 a = *(const u32x2*)qr, b = *(const u32x2*)(qr + 32);
          float x1[4] = {bflo(a.x), bfhi(a.x), bflo(a.y), bfhi(a.y)}, x2[4] = {bflo(b.x), bfhi(b.x), bflo(b.y), bfhi(b.y)};
          float s2 = 0.f;
#pragma unroll
          for (int e = 0; e < 4; ++e) s2 += x1[e] * x1[e] + x2[e] * x2[e];
          s2 += __shfl_xor(s2, 1); s2 += __shfl_xor(s2, 2); s2 += __shfl_xor(s2, 4);
          const float rr = rsqrtf(s2 * (1.f / 64.f) + EPS);
          float o1[4], o2[4];
#pragma unroll
          for (int e = 0; e < 4; ++e) { const int i = sub * 4 + e; const float inv = exp2f(-(float)i * (13.287712379549449f / 32.f)); float sn, cs; sincosf(pos * inv, &sn, &cs);
              const float y1 = x1[e] * rr * p.in[I_QRN][i], y2 = x2[e] * rr * p.in[I_QRN][32 + i]; o1[e] = (y1 * cs - y2 * sn) * QSC; o2[e] = (y2 * cs + y1 * sn) * QSC; }
          u32x2 w1, w2; w1.x = pk2(o1[0], o1[1]); w1.y = pk2(o1[2], o1[3]); w2.x = pk2(o2[0], o2[1]); w2.y = pk2(o2[2], o2[3]);
          *(u32x2*)qr = w1; *(u32x2*)(qr + 32) = w2; }
        { bf16_t* c = (pr ? (bf16_t*)(p.ws + W_CKVP) : (bf16_t*)(p.ws + W_CKVS)) + (size_t)lr * 512 + lane * 8; float f[8]; unpack8(*(const u32x4*)c, f);
          float ss = 0.f;
#pragma unroll
          for (int e = 0; e < 8; ++e) ss += f[e] * f[e];
          const float rn = rsqrtf(wave_sum(ss) * (1.f / 512.f) + EPS);
#pragma unroll
          for (int e = 0; e < 8; ++e) f[e] *= rn * p.in[I_KVN][lane * 8 + e];
          float* o = p.out + (pr ? O_CKVP : O_CKVS) + (size_t)lr * 512 + lane * 8;
          *(f32x4*)o = (f32x4){f[0], f[1], f[2], f[3]}; *(f32x4*)(o + 4) = (f32x4){f[4], f[5], f[6], f[7]};
          *(u32x4*)c = pack8(f); }
        { bf16_t* k = (pr ? (bf16_t*)(p.ws + W_KRP) : (bf16_t*)(p.ws + W_KRS)) + (size_t)lr * 64; const int i = lane & 31;
          const float x1 = bf2f(k[i]), x2 = bf2f(k[32 + i]); float ss = x1 * x1 + x2 * x2;
#pragma unroll
          for (int o = 1; o < 32; o <<= 1) ss += __shfl_xor(ss, o);
          const float rr = rsqrtf(ss * (1.f / 64.f) + EPS); const float inv = exp2f(-(float)i * (13.287712379549449f / 32.f)); float sn, cs; sincosf(pos * inv, &sn, &cs);
          const float y1 = x1 * rr * p.in[I_KRN][i], y2 = x2 * rr * p.in[I_KRN][32 + i]; const float o1 = y1 * cs - y2 * sn, o2 = y2 * cs + y1 * sn;
          float* o = p.out + (pr ? O_KRP : O_KRS) + (size_t)lr * 64;
          if (lane < 32) { o[i] = o1; o[32 + i] = o2; k[i] = f2bf(o1); k[32 + i] = f2bf(o2); } }
    }
}
__device__ __forceinline__ void e2_phase(const Params& p, bf16_t* KN, int nrows, int wid, int lane) {
    const int gw = blockIdx.x * 8 + wid, NGW = gridDim.x * 8;
    for (int row = gw; row < nrows; row += NGW) { bf16_t* k = KN + (size_t)row * 1024 + lane * 16; float f[16]; unpack8(*(const u32x4*)k, f); unpack8(*(const u32x4*)(k + 8), f + 8);
        float ss = 0.f;
#pragma unroll
        for (int e = 0; e < 16; ++e) ss += f[e] * f[e];
        ss += __shfl_xor(ss, 1); ss += __shfl_xor(ss, 2); ss += __shfl_xor(ss, 4);
        const float rn = rsqrtf(ss * (1.f / 128.f) + EPS);
#pragma unroll
        for (int e = 0; e < 16; ++e) f[e] *= rn * p.in[I_KNN][(lane & 7) * 16 + e];
        *(u32x4*)k = pack8(f); *(u32x4*)(k + 8) = pack8(f + 8); }
}
__device__ __forceinline__ void build_sample_kv(const Params& p, int wid, int lane) {
    const int gw = blockIdx.x * 8 + wid, NGW = gridDim.x * 8;
    bf16_t* CA = (bf16_t*)(p.ws + W_CKVALL); bf16_t* KA = (bf16_t*)(p.ws + W_KRALL);
    for (int R = gw; R < MKS; R += NGW) { const int b = R / TKS, t = R - b * TKS;
        if (t < 2048) { const float* s = p.in[I_CCKV] + ((size_t)b * 2048 + t) * 512 + lane * 8; const f32x4 a = *(const f32x4*)s, c = *(const f32x4*)(s + 4);
            u32x4 w; w.x = pk2(a.x, a.y); w.y = pk2(a.z, a.w); w.z = pk2(c.x, c.y); w.w = pk2(c.z, c.w); *(u32x4*)(CA + (size_t)R * 512 + lane * 8) = w;
            KA[(size_t)R * 64 + lane] = f2bf(p.in[I_CKR][((size_t)b * 2048 + t) * 64 + lane]); }
        else { const int lr = b * 32 + t - 2048; *(u32x4*)(CA + (size_t)R * 512 + lane * 8) = *(const u32x4*)((const bf16_t*)(p.ws + W_CKVS) + (size_t)lr * 512 + lane * 8);
            KA[(size_t)R * 64 + lane] = ((const bf16_t*)(p.ws + W_KRS))[(size_t)lr * 64 + lane]; } }
}
#define MFMA32(a, b, c) __builtin_amdgcn_mfma_f32_32x32x16_bf16((a), (b), (c), 0, 0, 0)
#define MFMA16(a, b, c) __builtin_amdgcn_mfma_f32_16x16x32_bf16((a), (b), (c), 0, 0, 0)
constexpr int AT_KR = 17408, AT_KB = 26624, AT_BUF = 45056;
template <bool SAMPLE, bool DRY = false>
__device__ __forceinline__ void attn_unit(LAS unsigned char* lds, const bf16_t* Q, int ldq, const bf16_t* KN, int ldkn, const bf16_t* KR, const bf16_t* VT, int ldvt,
                                          int ntiles, int limit, bool active, bf16_t* UB, int tid, int lane) {
    const int r = lane & 31, hh = lane >> 5;
    bf16x8 qf[12];
#pragma unroll
    for (int s = 0; s < 12; ++s) qf[s] = active ? *(const bf16x8*)(Q + (size_t)r * ldq + 16 * s + 8 * hh) : (bf16x8){0, 0, 0, 0, 0, 0, 0, 0};
    f32x16 o[4];
#pragma unroll
    for (int d = 0; d < 4; ++d)
#pragma unroll
        for (int e = 0; e < 16; ++e) o[d][e] = 0.f;
    float m_run = -__builtin_inff(), l_run = 0.f;
    const int wv = __builtin_amdgcn_readfirstlane(tid >> 6);
    unsigned aoff[6];
#pragma unroll
    for (int i_ = 0; i_ < 6; ++i_) { const int ch_ = wv + 8 * i_; unsigned o_ = 0;
        if (ch_ < 17) { const int sg_ = ch_ * 64 + lane, row_ = sg_ / 17; int c_ = sg_ - row_ * 17; c_ = c_ > 15 ? 15 : c_; o_ = (unsigned)(row_ * ldkn + c_ * 8) * 2u; }
        else if (ch_ < 26) { const int sg_ = (ch_ - 17) * 64 + lane, row_ = sg_ / 9; int c_ = sg_ - row_ * 9; c_ = c_ > 7 ? 7 : c_; o_ = (unsigned)(row_ * 64 + c_ * 8) * 2u; }
        else if (ch_ < 44) { const int sg_ = (ch_ - 26) * 64 + lane, row_ = sg_ / 9; int c_ = sg_ - row_ * 9; c_ = c_ > 7 ? 7 : c_; o_ = (unsigned)(row_ * ldvt + c_ * 8) * 2u; }
        aoff[i_] = o_; }
#define AT_ISSUE(j, buf) do { LAS unsigned char* b_ = lds + (buf) * AT_BUF; const char* kn_ = (const char*)KN + (size_t)(j) * 128 * ldkn; const char* kr_ = (const char*)KR + (size_t)(j) * 8192; const char* vt_ = (const char*)VT + (size_t)(j) * 128; \
        _Pragma("unroll") for (int i_ = 0; i_ < 6; ++i_) { const int ch_ = wv + 8 * i_; unsigned o_ = aoff[i_]; asm volatile("" : "+v"(o_)); \
        if (ch_ < 17) __builtin_amdgcn_global_load_lds((const unsigned*)(kn_ + o_), (LAS unsigned*)(b_ + ch_ * 1024), 16, 0, 0); \
        else if (ch_ < 26) __builtin_amdgcn_global_load_lds((const unsigned*)(kr_ + o_), (LAS unsigned*)(b_ + AT_KR + (ch_ - 17) * 1024), 16, 0, 0); \
        else if (ch_ < 44) __builtin_amdgcn_global_load_lds((const unsigned*)(vt_ + o_), (LAS unsigned*)(b_ + AT_KB + (ch_ - 26) * 1024), 16, 0, 0); } } while (0)
    AT_ISSUE(0, 0); __syncthreads();
    for (int j = 0; j < ntiles; ++j) {
        const bool more = (j + 1 < ntiles);
        if (more) AT_ISSUE(j + 1, (j + 1) & 1);
        if (active && j <= limit) {
            const LAS unsigned char* kb = lds + (j & 1) * AT_BUF; const LAS unsigned char* vb = kb + AT_KB;
            f32x16 s0, s1;
#pragma unroll
            for (int e = 0; e < 16; ++e) { s0[e] = 0.f; s1[e] = 0.f; }
#pragma unroll
            for (int s = 0; s < 12; ++s) { const LAS unsigned char* ka = s < 8 ? kb + r * 272 + s * 32 + hh * 16 : kb + AT_KR + r * 144 + (s - 8) * 32 + hh * 16; const int rs32 = s < 8 ? 32 * 272 : 32 * 144;
                const bf16x8 a0 = *(const LAS bf16x8*)ka, a1 = *(const LAS bf16x8*)(ka + rs32);
                s0 = MFMA32(a0, qf[s], s0); s1 = MFMA32(a1, qf[s], s1); if ((s & 3) == 3) __builtin_amdgcn_sched_barrier(0); }
            if (SAMPLE && j == ntiles - 1) {
#pragma unroll
                for (int e = 0; e < 16; ++e) s1[e] = -__builtin_inff(); }
            float mx = s0[0];
#pragma unroll
            for (int e = 1; e < 16; ++e) mx = fmaxf(mx, s0[e]);
#pragma unroll
            for (int e = 0; e < 16; ++e) mx = fmaxf(mx, s1[e]);
            mx = fmaxf(mx, __shfl_xor(mx, 32));
            const float mn = fmaxf(m_run, mx), alpha = __builtin_amdgcn_exp2f(m_run - mn); m_run = mn;
            float ps = 0.f;
#pragma unroll
            for (int e = 0; e < 16; ++e) { s0[e] = __builtin_amdgcn_exp2f(s0[e] - mn); s1[e] = __builtin_amdgcn_exp2f(s1[e] - mn); ps += s0[e] + s1[e]; }
            l_run = l_run * alpha + ps;
#pragma unroll
            for (int d = 0; d < 4; ++d)
#pragma unroll
                for (int e = 0; e < 16; ++e) o[d][e] *= alpha;
            bf16x8 pf[4];
#pragma unroll
            for (int sp = 0; sp < 4; ++sp) { const int hf = sp & 1; u32x4 w;
                if (sp < 2) { w.x = pk2(s0[8 * hf + 0], s0[8 * hf + 1]); w.y = pk2(s0[8 * hf + 2], s0[8 * hf + 3]); w.z = pk2(s0[8 * hf + 4], s0[8 * hf + 5]); w.w = pk2(s0[8 * hf + 6], s0[8 * hf + 7]); }
                else        { w.x = pk2(s1[8 * hf + 0], s1[8 * hf + 1]); w.y = pk2(s1[8 * hf + 2], s1[8 * hf + 3]); w.z = pk2(s1[8 * hf + 4], s1[8 * hf + 5]); w.w = pk2(s1[8 * hf + 6], s1[8 * hf + 7]); }
                pf[sp] = __builtin_bit_cast(bf16x8, w); }
#pragma unroll
            for (int d = 0; d < 4; ++d) { __builtin_amdgcn_sched_barrier(0);
#pragma unroll
                for (int sp = 0; sp < 4; ++sp) { const LAS unsigned char* va = vb + (32 * d + r) * 144 + (16 * sp + 4 * hh) * 2;
                    const u32x2 lo = *(const LAS u32x2*)va, hi = *(const LAS u32x2*)(va + 16); const u32x4 w = {lo.x, lo.y, hi.x, hi.y};
                    o[d] = MFMA32(__builtin_bit_cast(bf16x8, w), pf[sp], o[d]); } }
        }
        __syncthreads();
    }
#undef AT_ISSUE
    if (active && !(DRY && l_run >= 0.f)) {
        const float lt = l_run + __shfl_xor(l_run, 32), inv = 1.f / lt;
        int r2 = r, h2 = hh; asm volatile("" : "+v"(r2), "+v"(h2));
        char* ub = (char*)UB;
#pragma unroll
        for (int d = 0; d < 4; ++d)
#pragma unroll
            for (int g4 = 0; g4 < 4; ++g4) { bf16_t* up = (bf16_t*)(ub + (unsigned)(r2 * 1024 + 32 * d + 8 * g4 + 4 * h2) * 2u); const u32x2 z = *(const u32x2*)up;
                const float z0 = bflo(z.x), z1 = bfhi(z.x), z2 = bflo(z.y), z3 = bfhi(z.y);
                u32x2 w; w.x = pk2(o[d][4 * g4 + 0] * inv * siluf_(z0), o[d][4 * g4 + 1] * inv * siluf_(z1)); w.y = pk2(o[d][4 * g4 + 2] * inv * siluf_(z2), o[d][4 * g4 + 3] * inv * siluf_(z3));
                *(u32x2*)up = w; }
    }
}
template <bool DRY>
__device__ __forceinline__ void attn_prompt_phase(const Params& p, LAS unsigned char* lds, int tid, int wid, int lane) {
    const int G = gridDim.x, bx = blockIdx.x; const int vcu = (G % 8 == 0) ? (bx % 8) * (G / 8) + bx / 8 : bx;
    for (int item = vcu; item < 512; item += G) {
        const int pr = item & 255, bh = pr >> 4, pi = pr & 15, qb = item < 256 ? 31 - pi : pi, b = bh >> 3, h = bh & 7;
        const size_t tok0 = (size_t)b * 8192; const int q0 = qb * 256 + wid * 32;
        attn_unit<false, DRY>(lds, (const bf16_t*)(p.ws + W_QP) + (tok0 + q0) * 1536 + h * 192, 1536, (const bf16_t*)(p.ws + W_KN) + tok0 * 1024 + h * 128, 1024,
                         (const bf16_t*)(p.ws + W_KRP) + tok0 * 64, (const bf16_t*)(p.ws + W_VT) + (size_t)(h * 128) * MP + tok0, MP,
                         4 * qb + 4, 4 * qb + (wid >> 1), true, (bf16_t*)(p.ws + W_UBP) + (tok0 + q0) * 1024 + h * 128, tid, lane);
    }
}
__device__ __forceinline__ void attn_sample_phase(const Params& p, LAS unsigned char* lds, int tid, int wid, int lane) {
    const int G = gridDim.x, bx = blockIdx.x; const int vcu = (G % 8 == 0) ? (bx % 8) * (G / 8) + bx / 8 : bx;
    for (int item = vcu; item < 128; item += G) { const int b = item >> 3, h = item & 7; const size_t tok0 = (size_t)b * TKS;
        attn_unit<true>(lds, (const bf16_t*)(p.ws + W_QS) + (size_t)(b * 32) * 1536 + h * 192, 1536, (const bf16_t*)(p.ws + W_KNS) + tok0 * 1024 + h * 128, 1024,
                        (const bf16_t*)(p.ws + W_KRALL) + tok0 * 64, (const bf16_t*)(p.ws + W_VTS) + (size_t)(h * 128) * MKS + tok0, MKS,
                        33, 33, wid == 0, (bf16_t*)(p.ws + W_UBS) + (size_t)(b * 32) * 1024 + h * 128, tid, lane);
    }
}
constexpr int PR_KH = 0, PR_QH = 17408, PR_KT = 34816, PR_KT0 = 53248, PR_VT0 = 71680, PR_LM = 90112, PR_TB = 107520, PR_TBE = 116736, PR_AT = 125952, PR_VEC = 134144, PR_TL = 135168;
constexpr int PR_XT = 151552;
__device__ __forceinline__ void prep_conv(const Params& p, float (&acc)[16], const u32x4 (&raw)[4][2], int col0) {
#pragma unroll
    for (int e = 0; e < 16; ++e) acc[e] = 0.f;
#pragma unroll
    for (int i = 0; i < 4; ++i) { float x[16]; unpack8(raw[i][0], x); unpack8(raw[i][1], x + 8);
        const float* wc = p.in[I_WCONV] + (size_t)i * 3072 + col0;
#pragma unroll
        for (int e = 0; e < 4; ++e) { const f32x4 w = *(const f32x4*)(wc + 4 * e); acc[4 * e] += x[4 * e] * w.x; acc[4 * e + 1] += x[4 * e + 1] * w.y; acc[4 * e + 2] += x[4 * e + 2] * w.z; acc[4 * e + 3] += x[4 * e + 3] * w.w; } }
#pragma unroll
    for (int e = 0; e < 16; ++e) acc[e] = siluf_(acc[e]);
}
template <bool DRY>
__device__ __forceinline__ void prep_unit(const Params& p, LAS unsigned char* lds, int u, int tid0, int wid, int lane0) {
    const bool smp = u >= 2048; int b, h, n;
    if (!smp) { b = u >> 10; h = (u >> 7) & 7; n = u & 127; } else { b = (u - 2048) >> 3; h = (u - 2048) & 7; n = 0; }
    const size_t grow0 = smp ? (size_t)MP + b * 32 : (size_t)b * 8192 + n * 64;
    bf16_t* QKV = (bf16_t*)(p.ws + W_QKV); const bf16_t* HALO = (const bf16_t*)(p.ws + W_HALO);
    int tid = tid0, lane = lane0; asm volatile("" : "+v"(tid), "+v"(lane));
    int row = tid >> 3, cg = tid & 7; const bool valid = !smp || row < 32;
    u32x4 raw[3][4][2];
#define PREP_STAGE(P0_, P1_) _Pragma("unroll") for (int part = P0_; part < P1_; ++part) { \
        const char* qb_ = (const char*)(QKV + grow0 * 3072 + part * 1024 + h * 128); const char* hb_ = (const char*)(HALO + ((size_t)(b * 128 + n - 1) * 3) * 3072 + part * 1024 + h * 128); \
        const char* sb_ = (const char*)(p.in[I_SC] + ((size_t)b * 3) * 3072 + part * 1024 + h * 128); \
        _Pragma("unroll") for (int i = 0; i < 4; ++i) { const int tt = row - 3 + i; raw[part][i][0] = (u32x4){0u, 0u, 0u, 0u}; raw[part][i][1] = raw[part][i][0]; \
            if (valid) { \
                if (tt >= 0) { const unsigned off_ = (unsigned)(tt * 3072 + cg * 16) * 2u; raw[part][i][0] = *(const u32x4*)(qb_ + off_); raw[part][i][1] = *(const u32x4*)(qb_ + off_ + 16); } \
                else if (!smp && n > 0) { const unsigned off_ = (unsigned)((tt + 3) * 3072 + cg * 16) * 2u; raw[part][i][0] = *(const u32x4*)(hb_ + off_); raw[part][i][1] = *(const u32x4*)(hb_ + off_ + 16); } \
                else if (smp) { const unsigned off_ = (unsigned)((tt + 3) * 3072 + cg * 16) * 4u; float x[16]; \
                    _Pragma("unroll") for (int e = 0; e < 4; ++e) { const f32x4 v = *(const f32x4*)(sb_ + off_ + 16 * e); x[4 * e] = v.x; x[4 * e + 1] = v.y; x[4 * e + 2] = v.z; x[4 * e + 3] = v.w; } \
                    raw[part][i][0] = pack8(x); raw[part][i][1] = pack8(x + 8); } \
            } } }
    PREP_STAGE(0, 2)
    LAS float* gv = (LAS float*)(lds + PR_VEC); LAS float* betav = gv + 64; LAS float* gcv = gv + 128;
    if (wid == 0) { float g = 0.f, bt = 0.f;
        if (!smp || lane < 32) { const float* ba = (const float*)(p.ws + W_BA) + (grow0 + lane) * 16; bt = sigmoidf_(ba[h]); const float xx = ba[8 + h] + p.in[I_DTB][h];
            const float sp = xx > 20.f ? xx : log1pf(__expf(xx)); g = -__expf(p.in[I_ALOG][h]) * sp; }
        betav[lane] = bt; float c = g;
#pragma unroll
        for (int o = 1; o < 64; o <<= 1) { const float t = __shfl_up(c, o); if (lane >= o) c += t; }
        gcv[lane] = c; }
    asm volatile("s_waitcnt vmcnt(0)" ::: "memory");
    __syncthreads();
    PREP_STAGE(2, 3)
#undef PREP_STAGE
    __builtin_amdgcn_sched_barrier(0);
    asm volatile("" : "+v"(row), "+v"(cg));
    if (!DRY) { float* o = nullptr;
        if (!smp && n == 127 && row >= 61) o = p.out + O_CVP + ((size_t)b * 3 + (row - 61)) * 3072;
        if (smp && row >= 29 && row < 32) o = p.out + O_CVS + ((size_t)b * 3 + (row - 29)) * 3072;
        if (o) {
#pragma unroll
            for (int part = 0; part < 3; ++part) { float x[16]; unpack8(raw[part][3][0], x); unpack8(raw[part][3][1], x + 8); float* op = o + part * 1024 + h * 128 + cg * 16;
#pragma unroll
                for (int e = 0; e < 4; ++e) *(f32x4*)(op + 4 * e) = (f32x4){x[4 * e], x[4 * e + 1], x[4 * e + 2], x[4 * e + 3]}; } } }
    const float gc = gcv[row], eg = __expf(gc), ed = __expf(gcv[63] - gc);
    bf16_t* dq; if (!smp) dq = (bf16_t*)((char*)(QKV + grow0 * 3072 + h * 128) + (unsigned)(row * 3072 + cg * 16) * 2u); else dq = (bf16_t*)((char*)((bf16_t*)(p.ws + W_SQKV) + (size_t)(u - 2048) * 3 * 8192) + (unsigned)(row * 128 + cg * 16) * 2u);
    LAS bf16_t* KH = (LAS bf16_t*)(lds + PR_KH); LAS bf16_t* QH = (LAS bf16_t*)(lds + PR_QH); LAS bf16_t* KT = (LAS bf16_t*)(lds + PR_KT); LAS bf16_t* KT0 = (LAS bf16_t*)(lds + PR_KT0); LAS bf16_t* VT0 = (LAS bf16_t*)(lds + PR_VT0);
    {   float a[16]; prep_conv(p, a, raw[0], h * 128 + cg * 16);
        float sq = 0.f;
#pragma unroll
        for (int e = 0; e < 16; ++e) sq += a[e] * a[e];
        sq += __shfl_xor(sq, 1); sq += __shfl_xor(sq, 2); sq += __shfl_xor(sq, 4);
        const float rq = rsqrtf(sq + EPS) * 0.08838834764831845f;
#pragma unroll
        for (int e = 0; e < 16; ++e) a[e] *= rq;
        *(LAS u32x4*)(QH + row * 136 + cg * 16) = pack8(a); *(LAS u32x4*)(QH + row * 136 + cg * 16 + 8) = pack8(a + 8);
#pragma unroll
        for (int e = 0; e < 16; ++e) a[e] *= eg;
        if (!DRY) { *(u32x4*)dq = pack8(a); *(u32x4*)(dq + 8) = pack8(a + 8); } }
    __builtin_amdgcn_sched_barrier(0);
    {   float a[16]; prep_conv(p, a, raw[1], 1024 + h * 128 + cg * 16);
        float sk = 0.f;
#pragma unroll
        for (int e = 0; e < 16; ++e) sk += a[e] * a[e];
        sk += __shfl_xor(sk, 1); sk += __shfl_xor(sk, 2); sk += __shfl_xor(sk, 4);
        const float rk = rsqrtf(sk + EPS);
#pragma unroll
        for (int e = 0; e < 16; ++e) a[e] *= rk;
        *(LAS u32x4*)(KH + row * 136 + cg * 16) = pack8(a); *(LAS u32x4*)(KH + row * 136 + cg * 16 + 8) = pack8(a + 8);
#pragma unroll
        for (int e = 0; e < 16; ++e) { KT[(cg * 16 + e) * 72 + row] = f2bf(a[e] * ed); KT0[(cg * 16 + e) * 72 + row] = f2bf(a[e]); } }
    __builtin_amdgcn_sched_barrier(0);
    {   float a[16]; prep_conv(p, a, raw[2], 2048 + h * 128 + cg * 16);
#pragma unroll
        for (int e = 0; e < 16; ++e) VT0[(cg * 16 + e) * 72 + row] = f2bf(a[e]); }
    __syncthreads();
    asm volatile("" : "+v"(tid), "+v"(lane));
    {
        const LAS unsigned char* KHb = lds + PR_KH; const LAS unsigned char* QHb = lds + PR_QH; const int c = lane & 15, g = lane >> 4, mi = wid >> 1;
        f32x4 kk[2], qk[2];
#pragma unroll
        for (int j = 0; j < 2; ++j) { kk[j] = (f32x4){0.f, 0.f, 0.f, 0.f}; qk[j] = kk[j]; }
#pragma unroll
        for (int s = 0; s < 4; ++s) { const bf16x8 aK = *(const LAS bf16x8*)(KHb + (16 * mi + c) * 272 + (32 * s + 8 * g) * 2), aQ = *(const LAS bf16x8*)(QHb + (16 * mi + c) * 272 + (32 * s + 8 * g) * 2);
#pragma unroll
            for (int j = 0; j < 2; ++j) { const int nj = 2 * (wid & 1) + j; const bf16x8 bK = *(const LAS bf16x8*)(KHb + (16 * nj + c) * 272 + (32 * s + 8 * g) * 2);
                kk[j] = MFMA16(aK, bK, kk[j]); qk[j] = MFMA16(aQ, bK, qk[j]); } }
        LAS float* LM = (LAS float*)(lds + PR_LM); LAS bf16_t* ATs = (LAS bf16_t*)(lds + PR_AT);
#pragma unroll
        for (int j = 0; j < 2; ++j) { const int cj = 16 * (2 * (wid & 1) + j) + c; const float gj = gcv[cj];
#pragma unroll
            for (int e = 0; e < 4; ++e) { const int ri = 16 * mi + 4 * g + e; const float dec = (cj <= ri) ? __expf(gcv[ri] - gj) : 0.f;
                LM[ri * 68 + cj] = (cj < ri) ? betav[ri] * kk[j][e] * dec : 0.f; ATs[ri * 64 + cj] = f2bf(qk[j][e] * dec); } }
    }
    __syncthreads();
    asm volatile("" : "+v"(tid), "+v"(lane));
    {
        const LAS float* LM = (const LAS float*)(lds + PR_LM); LAS float* TL = (LAS float*)(lds + PR_TL); LAS float* XT = (LAS float*)(lds + PR_XT);
        LAS bf16_t* TBs = (LAS bf16_t*)(lds + PR_TB); LAS bf16_t* TBe = (LAS bf16_t*)(lds + PR_TBE);
#pragma unroll
        for (int i = 0; i < 8; ++i) TL[tid + 512 * i] = 0.f;
        __syncthreads();
        if (wid == 0) { const int blk = lane >> 4, col = lane & 15; float x[16];
#pragma unroll
            for (int r = 0; r < 16; ++r) { float a = (r == col) ? 1.f : 0.f;
#pragma unroll
                for (int k = 0; k < r; ++k) a -= LM[(16 * blk + r) * 68 + 16 * blk + k] * x[k];
                x[r] = a; TL[(16 * blk + r) * 64 + 16 * blk + col] = a; } }
        __syncthreads();
        for (int i = 1; i < 4; ++i) {
            for (int e = tid; e < i * 256; e += 512) { const int j = e >> 8, r = (e >> 4) & 15, c = e & 15; float a = 0.f;
                for (int kk = 16 * j; kk < 16 * i; ++kk) a += LM[(16 * i + r) * 68 + kk] * TL[kk * 64 + 16 * j + c];
                XT[e] = a; }
            __syncthreads();
            for (int e = tid; e < i * 256; e += 512) { const int j = e >> 8, r = (e >> 4) & 15, c = e & 15; float a = 0.f;
#pragma unroll
                for (int k = 0; k < 16; ++k) a += TL[(16 * i + r) * 64 + 16 * i + k] * XT[(j << 8) + (k << 4) + c];
                TL[(16 * i + r) * 64 + 16 * j + c] = -a; }
            __syncthreads();
        }
#pragma unroll
        for (int i = 0; i < 8; ++i) { const int e = tid + 512 * i, ri = e >> 6, cj = e & 63; const float t = TL[e] * betav[cj]; TBs[ri * 72 + cj] = f2bf(t); TBe[ri * 72 + cj] = f2bf(t * __expf(gcv[cj])); }
    }
    __syncthreads();
    asm volatile("" : "+v"(tid), "+v"(lane));
    {
        const int c = lane & 15, g = lane >> 4;
        f32x4 aw[4], au[4];
#pragma unroll
        for (int mb = 0; mb < 4; ++mb) { aw[mb] = (f32x4){0.f, 0.f, 0.f, 0.f}; au[mb] = aw[mb]; }
#pragma unroll
        for (int s = 0; s < 2; ++s) { const bf16x8 bk = *(const LAS bf16x8*)(lds + PR_KT0 + (16 * wid + c) * 144 + (32 * s + 8 * g) * 2), bv = *(const LAS bf16x8*)(lds + PR_VT0 + (16 * wid + c) * 144 + (32 * s + 8 * g) * 2);
#pragma unroll
            for (int mb = 0; mb < 4; ++mb) { aw[mb] = MFMA16(*(const LAS bf16x8*)(lds + PR_TBE + (16 * mb + c) * 144 + (32 * s + 8 * g) * 2), bk, aw[mb]);
                au[mb] = MFMA16(*(const LAS bf16x8*)(lds + PR_TB + (16 * mb + c) * 144 + (32 * s + 8 * g) * 2), bv, au[mb]); } }
        char* wb = smp ? (char*)((bf16_t*)(p.ws + W_SQKV) + (size_t)(u - 2048) * 3 * 8192 + 8192 + 16 * wid) : (char*)(QKV + grow0 * 3072 + 1024 + h * 128 + 16 * wid);
        const unsigned rs = smp ? 128u : 3072u, us = smp ? 8192u * 2u : 1024u * 2u;
#pragma unroll
        for (int mb = 0; mb < 4; ++mb)
#pragma unroll
            for (int e = 0; e < 4; ++e) { const unsigned off = ((unsigned)(16 * mb + 4 * g + e) * rs + (unsigned)c) * 2u; if (!DRY || aw[mb][e] == 123456.f) { *(bf16_t*)(wb + off) = f2bf(aw[mb][e]); *(bf16_t*)(wb + us + off) = f2bf(au[mb][e]); } }
    }
    asm volatile("" : "+v"(tid), "+v"(lane));
    if (!DRY) {   bf16_t* KDT = (bf16_t*)(p.ws + W_KDT) + (size_t)u * 8192; bf16_t* ATG = (bf16_t*)(p.ws + W_TB) + (size_t)u * 4096;
#pragma unroll
        for (int i = 0; i < 2; ++i) { const int pc = tid + 512 * i, r = pc >> 3, c = pc & 7; *(u32x4*)(KDT + r * 64 + c * 8) = *(const LAS u32x4*)(lds + PR_KT + r * 144 + c * 16); }
        { const int r = tid >> 3, c = tid & 7; *(u32x4*)(ATG + r * 64 + c * 8) = *(const LAS u32x4*)(lds + PR_AT + r * 128 + c * 16); }
        if (tid == 0) ((float*)(p.ws + W_GL))[u] = __expf(gcv[63]);
    }
    __syncthreads();
}
constexpr int SC_QG = 0, SC_W = 17408, SC_KD = 34816, SC_AT = 53248, SC_U = 62464, SC_Z = 78848, SC_WV = 95232, SC_WVB = 6656, SC_EX = 148480;
constexpr int NSEG = 8, SEGLEN = 16;
template <int mode>
__device__ __forceinline__ void scan_chain(const Params& p, LAS unsigned char* lds, int bh, int seg, int tid, int wid, int lane) {
    constexpr bool smp = mode == 3, emit = mode >= 2; const int b = bh >> 3, h = bh & 7; const int nsteps = smp ? 1 : SEGLEN;
    asm volatile("" : "+v"(tid), "+v"(lane));
    const int c = lane & 15, g = lane >> 4;
    LAS unsigned char* ST = lds + SC_WV + wid * SC_WVB; LAS unsigned char* RT = ST + 4352; LAS float* EX = (LAS float*)(lds + SC_EX);
    float* MB = (float*)(p.ws + W_MB);
    f32x4 S[8];
#pragma unroll
    for (int mb = 0; mb < 8; ++mb) S[mb] = (f32x4){0.f, 0.f, 0.f, 0.f};
    if (smp) { const char* sd = (const char*)(p.in[I_SD] + ((size_t)bh * 128) * 128 + 16 * wid);
#pragma unroll
        for (int mb = 0; mb < 8; ++mb)
#pragma unroll
            for (int e = 0; e < 4; ++e) S[mb][e] = *(const float*)(sd + (unsigned)((16 * mb + 4 * g + e) * 128 + c) * 4u); }
    if (mode == 1) {
#pragma unroll
        for (int mb = 0; mb < 8; ++mb)
#pragma unroll
            for (int e = 0; e < 4; ++e) S[mb][e] = (16 * mb + 4 * g + e == 16 * wid + c) ? 1.f : 0.f; }
    if (mode == 2) {
        for (int j = 0; j < seg; ++j) { const float* Mj = MB + (size_t)(bh * NSEG + j) * 2 * 16384; const float* Bj = Mj + 16384;
            __syncthreads();
#pragma unroll 2
            for (int i = 0; i < 8; ++i) { const int pc = tid + 512 * i, r = pc >> 5, cc = pc & 31; const f32x4 v = *(const f32x4*)(Mj + r * 128 + cc * 4); u32x2 w; w.x = pk2(v.x, v.y); w.y = pk2(v.z, v.w); *(LAS u32x2*)(lds + r * 272 + cc * 8) = w; }
#pragma unroll
            for (int mb = 0; mb < 8; ++mb) { u32x2 w; w.x = pk2(S[mb][0], S[mb][1]); w.y = pk2(S[mb][2], S[mb][3]); *(LAS u32x2*)(ST + c * 272 + (16 * mb + 4 * g) * 2) = w; }
            __syncthreads();
            { const char* bj = (const char*)(Bj + 16 * wid);
#pragma unroll
              for (int mb = 0; mb < 8; ++mb)
#pragma unroll
                for (int e = 0; e < 4; ++e) S[mb][e] = *(const float*)(bj + (unsigned)((16 * mb + 4 * g + e) * 128 + c) * 4u); }
#pragma unroll
            for (int s = 0; s < 4; ++s) { const bf16x8 bS = *(const LAS bf16x8*)(ST + c * 272 + (32 * s + 8 * g) * 2);
#pragma unroll
                for (int mb = 0; mb < 8; ++mb) S[mb] = MFMA16(*(const LAS bf16x8*)(lds + (16 * mb + c) * 272 + (32 * s + 8 * g) * 2), bS, S[mb]); }
        }
    }
    const int u0 = smp ? 2048 + bh : bh * 128 + seg * SEGLEN;
    const bf16_t* qb0; unsigned rstride; size_t ustride;
    if (!smp) { qb0 = (const bf16_t*)(p.ws + W_QKV) + ((size_t)b * 8192 + (size_t)seg * SEGLEN * 64) * 3072 + h * 128; rstride = 3072; ustride = (size_t)64 * 3072; }
    else { qb0 = (const bf16_t*)(p.ws + W_SQKV) + (size_t)bh * 3 * 8192; rstride = 128; ustride = 0; }
    const size_t koff = smp ? 8192 : 1024, voff = smp ? 16384 : 2048;
    const bf16_t* KDT = (const bf16_t*)(p.ws + W_KDT) + (size_t)u0 * 8192; const bf16_t* ATG = (const bf16_t*)(p.ws + W_TB) + (size_t)u0 * 4096; const float* GLp = (const float*)(p.ws + W_GL) + u0;
    bf16_t* zb0 = smp ? (bf16_t*)(p.ws + W_UAS) + (size_t)(b * 32) * 1024 + h * 128 : (bf16_t*)(p.ws + W_UAP) + ((size_t)b * 8192 + (size_t)seg * SEGLEN * 64) * 1024 + h * 128;
    const int zrows = smp ? 32 : 64;
    u32x4 rq[2], rk[2], rv[2], rd[2], ra, rz[2]; float gl_next;
    const unsigned oq0 = (unsigned)((tid >> 4) * rstride + (tid & 15) * 8) * 2u, oq1 = (unsigned)(((tid + 512) >> 4) * rstride + (tid & 15) * 8) * 2u, od0 = (unsigned)tid * 16u, od1 = (unsigned)(tid + 512) * 16u;
    const unsigned oz0 = (unsigned)((tid >> 4) * 1024 + (tid & 15) * 8) * 2u, oz1 = (unsigned)(((tid + 512) >> 4) * 1024 + (tid & 15) * 8) * 2u;
#define SC_ISSUE(st) do { const char* qb_ = (const char*)(qb0 + (size_t)(st) * ustride); const char* kb_ = qb_ + koff * 2; const char* vb_ = qb_ + voff * 2; const char* db_ = (const char*)(KDT + (size_t)(st) * 8192); const char* tb_ = (const char*)(ATG + (size_t)(st) * 4096); \
        rq[0] = *(const u32x4*)(qb_ + oq0); rq[1] = *(const u32x4*)(qb_ + oq1); rk[0] = *(const u32x4*)(kb_ + oq0); rk[1] = *(const u32x4*)(kb_ + oq1); rv[0] = *(const u32x4*)(vb_ + oq0); rv[1] = *(const u32x4*)(vb_ + oq1); \
        rd[0] = *(const u32x4*)(db_ + od0); rd[1] = *(const u32x4*)(db_ + od1); ra = *(const u32x4*)(tb_ + od0); gl_next = GLp[st]; \
        if (emit) { const char* z_ = (const char*)(zb0 + (size_t)(st) * 64 * 1024); rz[0] = *(const u32x4*)(z_ + oz0); if ((tid >> 4) + 32 < zrows) rz[1] = *(const u32x4*)(z_ + oz1); } } while (0)
#define SC_WRITE() do { _Pragma("unroll") for (int i_ = 0; i_ < 2; ++i_) { const int pc_ = tid + 512 * i_, r_ = pc_ >> 4, c_ = pc_ & 15; *(LAS u32x4*)(lds + SC_QG + r_ * 272 + c_ * 16) = rq[i_]; *(LAS u32x4*)(lds + SC_W + r_ * 272 + c_ * 16) = rk[i_]; \
            *(LAS u32x4*)(lds + SC_U + r_ * 256 + c_ * 16) = rv[i_]; if (emit) *(LAS u32x4*)(lds + SC_Z + r_ * 256 + c_ * 16) = rz[i_]; const int r2_ = pc_ >> 3, c2_ = pc_ & 7; *(LAS u32x4*)(lds + SC_KD + r2_ * 144 + c2_ * 16) = rd[i_]; } \
        { const int r_ = tid >> 3, c_ = tid & 7; *(LAS u32x4*)(lds + SC_AT + r_ * 144 + c_ * 16) = ra; } } while (0)
#define SC_FLUSH(st_) do { char* z_ = (char*)(zb0 + (size_t)(st_) * 64 * 1024); *(u32x4*)(z_ + oz0) = *(const LAS u32x4*)(lds + SC_Z + (tid >> 4) * 256 + (tid & 15) * 16); \
        if ((tid >> 4) + 32 < zrows) *(u32x4*)(z_ + oz1) = *(const LAS u32x4*)(lds + SC_Z + ((tid >> 4) + 32) * 256 + (tid & 15) * 16); } while (0)
    const float gain = p.in[I_DNN][16 * wid + c];
    rz[0] = (u32x4){0u, 0u, 0u, 0u}; rz[1] = rz[0];
    SC_ISSUE(0);
    for (int st = 0; st < nsteps; ++st) {
        __syncthreads();
        if (emit && st > 0) SC_FLUSH(st - 1);
        SC_WRITE(); const float gl = gl_next;
        __syncthreads();
        if (st + 1 < nsteps) SC_ISSUE(st + 1);
#pragma unroll
        for (int mb = 0; mb < 8; ++mb) { u32x2 w; w.x = pk2(S[mb][0], S[mb][1]); w.y = pk2(S[mb][2], S[mb][3]); *(LAS u32x2*)(ST + c * 272 + (16 * mb + 4 * g) * 2) = w; }
        f32x4 aK[4];
#pragma unroll
        for (int mb = 0; mb < 4; ++mb) aK[mb] = (f32x4){0.f, 0.f, 0.f, 0.f};
#pragma unroll
        for (int s = 0; s < 4; ++s) { const bf16x8 bS = *(const LAS bf16x8*)(ST + c * 272 + (32 * s + 8 * g) * 2);
#pragma unroll
            for (int mb = 0; mb < 4; ++mb) aK[mb] = MFMA16(*(const LAS bf16x8*)(lds + SC_W + (16 * mb + c) * 272 + (32 * s + 8 * g) * 2), bS, aK[mb]); }
        __builtin_amdgcn_sched_barrier(0);
#pragma unroll
        for (int mb = 0; mb < 4; ++mb) { float rr[4];
#pragma unroll
            for (int e = 0; e < 4; ++e) rr[e] = (mode == 1 ? 0.f : bf2f(*(const LAS bf16_t*)(lds + SC_U + (16 * mb + 4 * g + e) * 256 + (16 * wid + c) * 2))) - aK[mb][e];
            u32x2 w; w.x = pk2(rr[0], rr[1]); w.y = pk2(rr[2], rr[3]); *(LAS u32x2*)(RT + c * 144 + (16 * mb + 4 * g) * 2) = w; }
        __builtin_amdgcn_sched_barrier(0);
        f32x4 aQ[4];
        { const bf16x8 b0 = *(const LAS bf16x8*)(RT + c * 144 + (8 * g) * 2), b1 = *(const LAS bf16x8*)(RT + c * 144 + (32 + 8 * g) * 2);
#pragma unroll
          for (int mb = 0; mb < 8; ++mb) { S[mb] = S[mb] * gl;
              S[mb] = MFMA16(*(const LAS bf16x8*)(lds + SC_KD + (16 * mb + c) * 144 + (8 * g) * 2), b0, S[mb]);
              S[mb] = MFMA16(*(const LAS bf16x8*)(lds + SC_KD + (16 * mb + c) * 144 + (32 + 8 * g) * 2), b1, S[mb]); }
          __builtin_amdgcn_sched_barrier(0);
          if (emit) {
#pragma unroll
            for (int mb = 0; mb < 4; ++mb) { aQ[mb] = (f32x4){0.f, 0.f, 0.f, 0.f};
                aQ[mb] = MFMA16(*(const LAS bf16x8*)(lds + SC_AT + (16 * mb + c) * 144 + (8 * g) * 2), b0, aQ[mb]);
                aQ[mb] = MFMA16(*(const LAS bf16x8*)(lds + SC_AT + (16 * mb + c) * 144 + (32 + 8 * g) * 2), b1, aQ[mb]); } } }
        __builtin_amdgcn_sched_barrier(0);
        if (emit) {
#pragma unroll
            for (int s = 0; s < 4; ++s) { const bf16x8 bS = *(const LAS bf16x8*)(ST + c * 272 + (32 * s + 8 * g) * 2);
#pragma unroll
                for (int mb = 0; mb < 4; ++mb) aQ[mb] = MFMA16(*(const LAS bf16x8*)(lds + SC_QG + (16 * mb + c) * 272 + (32 * s + 8 * g) * 2), bS, aQ[mb]); } }
        __builtin_amdgcn_sched_barrier(0);
        if (emit) {
#pragma unroll
            for (int mb = 0; mb < 4; ++mb)
#pragma unroll
                for (int e = 0; e < 4; ++e) { float q = aQ[mb][e] * aQ[mb][e]; q += __shfl_xor(q, 1); q += __shfl_xor(q, 2); q += __shfl_xor(q, 4); q += __shfl_xor(q, 8);
                    if (c == 0) EX[(16 * mb + 4 * g + e) * 8 + wid] = q; }
            __syncthreads();
#pragma unroll
            for (int mb = 0; mb < 4; ++mb)
#pragma unroll
                for (int e = 0; e < 4; ++e) { const int rw = 16 * mb + 4 * g + e; const f32x4 x0 = *(const LAS f32x4*)(EX + rw * 8), x1 = *(const LAS f32x4*)(EX + rw * 8 + 4);
                    const float rn = rsqrtf(((x0.x + x0.y) + (x0.z + x0.w) + (x1.x + x1.y) + (x1.z + x1.w)) * (1.f / 128.f) + EPS);
                    LAS bf16_t* zp = (LAS bf16_t*)(lds + SC_Z + rw * 256 + (16 * wid + c) * 2); *zp = f2bf(aQ[mb][e] * rn * gain * siluf_(bf2f(*zp))); }
        }
    }
    __syncthreads();
    if (emit) SC_FLUSH(nsteps - 1);
#undef SC_ISSUE
#undef SC_WRITE
#undef SC_FLUSH
    if (mode != 2 || seg == NSEG - 1) {
        int c2 = c, g2 = g; asm volatile("" : "+v"(c2), "+v"(g2));
        char* so = mode == 3 ? (char*)(p.out + O_SDS + ((size_t)bh * 128) * 128 + 16 * wid) : mode == 2 ? (char*)(p.out + O_SDP + ((size_t)bh * 128) * 128 + 16 * wid)
                             : (char*)(MB + ((size_t)(bh * NSEG + seg) * 2 + (mode == 0 ? 1 : 0)) * 16384 + 16 * wid);
#pragma unroll
        for (int mb = 0; mb < 8; ++mb)
#pragma unroll
            for (int e = 0; e < 4; ++e) *(float*)(so + (unsigned)((16 * mb + 4 * g2 + e) * 128 + c2) * 4u) = S[mb][e]; }
    __syncthreads();
}

#define XB_TMO      128
#define XB_XCNT(j)  (256  + 64 * (j))
#define XB_XSUB(j)  (1280 + 64 * (j))
#define XB_XGEN(j)  (2304 + 64 * (j))
#define XB_TOP      3328
#define XB_TOPGEN   3392
#define XCD_BAR_WORDS 3456
#define XB_SPIN_CAP (1u << 18)

__device__ __forceinline__ unsigned xb_ld(unsigned* p)              { return __hip_atomic_load(p, __ATOMIC_RELAXED, __HIP_MEMORY_SCOPE_AGENT); }
__device__ __forceinline__ unsigned xb_add(unsigned* p, unsigned v) { return __hip_atomic_fetch_add(p, v, __ATOMIC_RELAXED, __HIP_MEMORY_SCOPE_AGENT); }
__device__ __forceinline__ unsigned xb_xcc_id() { return (unsigned)__builtin_amdgcn_s_getreg((3 << 11) | 20) & 0xFu; }
#define XB_SPIN(cond, bar) do { unsigned _sp = 0; while (cond) { __builtin_amdgcn_s_sleep(1); \
    if ((++_sp & 255u) == 0u) { if (xb_ld(&(bar)[XB_TMO])) break; if (_sp > XB_SPIN_CAP) { atomicAdd(&(bar)[XB_TMO], 1u); break; } } } } while (0)

struct XcdBarrier {
    unsigned* bar; unsigned x;
    volatile LAS unsigned* st;
};

__device__ __forceinline__ XcdBarrier xcd_barrier_post(unsigned* bar, volatile LAS unsigned* st) {
    XcdBarrier b; b.bar = bar; b.x = xb_xcc_id(); b.st = st;
    if (threadIdx.x == 0) (void)xb_add(&bar[XB_XCNT(b.x)], 1u);
    return b;
}
__device__ __forceinline__ void xcd_barrier_complete(unsigned* bar, unsigned x, unsigned& nloc, unsigned& nx) {
    const unsigned G = gridDim.x * gridDim.y * gridDim.z;
    unsigned sum, cnt, mine, sp = 0u;
    for (;;) {
        sum = 0u; cnt = 0u; mine = 0u;
#pragma unroll
        for (unsigned j = 0; j < 16; ++j) { const unsigned c = xb_ld(&bar[XB_XCNT(j)]); sum += c; cnt += (c > 0u) ? 1u : 0u; mine = (j == x) ? c : mine; }
        if (sum == G) break;
        __builtin_amdgcn_s_sleep(1);
        if ((++sp & 255u) == 0u) { if (xb_ld(&bar[XB_TMO])) break; if (sp > XB_SPIN_CAP) { atomicAdd(&bar[XB_TMO], 1u); break; } }
    }
    nloc = mine > 0u ? mine : 1u; nx = cnt > 0u ? cnt : 1u;
}

__device__ __forceinline__ void xcd_barrier(const XcdBarrier& b) {
    asm volatile("s_waitcnt vmcnt(0)" ::: "memory");
    __syncthreads();
    if (threadIdx.x == 0) {
        unsigned* bar = b.bar;
        __builtin_amdgcn_s_waitcnt(0);
        unsigned nloc = b.st[0], nx = b.st[1];
        if (nloc == 0u) { xcd_barrier_complete(bar, b.x, nloc, nx); b.st[0] = nloc; b.st[1] = nx; }
        const unsigned old = xb_add(&bar[XB_XSUB(b.x)], 1u);
        const unsigned gen = old / nloc;
        if (old + 1u == (gen + 1u) * nloc) {
            __builtin_amdgcn_fence(__ATOMIC_RELEASE, "agent");
            asm volatile("s_waitcnt vmcnt(0)" ::: "memory");
            const unsigned og = xb_add(&bar[XB_TOP], 1u);
            const unsigned tg = og / nx;
            if (og + 1u == (tg + 1u) * nx) xb_add(&bar[XB_TOPGEN], 1u);
            else XB_SPIN(xb_ld(&bar[XB_TOPGEN]) == tg, bar);
            __builtin_amdgcn_fence(__ATOMIC_ACQUIRE, "agent");
            xb_add(&bar[XB_XGEN(b.x)], 1u);
            asm volatile("s_waitcnt vmcnt(0)" ::: "memory");
        } else {
            XB_SPIN(xb_ld(&bar[XB_XGEN(b.x)]) == gen, bar);
            __builtin_amdgcn_fence(__ATOMIC_ACQUIRE, "agent");
            asm volatile("s_waitcnt vmcnt(0)" ::: "memory");
        }
    }
    __syncthreads();
}


#ifndef REPG
#define REPG 1
#endif
#ifndef REPS1
#define REPS1 1
#endif
#ifndef REPP
#define REPP 1
#endif
template <class Epi>
__device__ __forceinline__ void run_gemm(LAS unsigned char* lds, const pg8::Gemm& g, const Epi& E) {
    pg8::StaticOrder S; S.init(g.M, g.N, (int)gridDim.x, (int)blockIdx.x);
#pragma unroll 1
    for (int rep_ = 0; rep_ < REPG; ++rep_) pg8::gemm_phase<Epi, pg8::StaticOrder, true, true>((PG8_LAS unsigned char*)lds, g, S, E);
}
__device__ __forceinline__ pg8::Gemm mk_gemm(const bf16_t* A, const bf16_t* As, int pm_split, const bf16_t* Bt, int M, int N, int K, int lda, int ldb) {
    pg8::Gemm g; g.A = A; g.As = As ? As : A; g.A2 = A; g.A2s = g.As; g.Bt = Bt; g.M = M; g.N = N; g.K = K; g.lda = lda; g.ldb = ldb; g.pm_split = pm_split; g.nt1 = K / 64; return g;
}
#ifndef PH_LO
#define PH_LO 0
#endif
#ifndef PH_HI
#define PH_HI 16
#endif
__global__ void __launch_bounds__(512, 2) hybrid_fwd(Params p_arg) {
    extern __shared__ __attribute__((aligned(16))) unsigned char lds_raw[];
    LAS unsigned char* lds = (LAS unsigned char*)lds_raw;
    cg::grid_group grid = cg::this_grid();
    volatile LAS unsigned* MISC = (volatile LAS unsigned*)(lds + LDS_BYTES - 64);
    if (threadIdx.x < 8) MISC[threadIdx.x] = 0u;
    __syncthreads();
    XcdBarrier xbar = xcd_barrier_post((unsigned*)p_arg.ws, MISC);
#define PH(k) if (PH_LO <= (k) && (k) < PH_HI)
#if defined(__HIP_DEVICE_COMPILE__)
#define LOADP() Params p; { const __attribute__((address_space(4))) Params* kp_ = (const __attribute__((address_space(4))) Params*)__builtin_amdgcn_kernarg_segment_ptr(); asm volatile("" : "+s"(kp_)); p = *(const Params*)kp_; } unsigned char* ws = p.ws; (void)ws; int tid = threadIdx.x; asm volatile("" : "+v"(tid)); const int lane = tid & 63, wid = __builtin_amdgcn_readfirstlane(tid >> 6); (void)lane; (void)wid
#else
#define LOADP() Params p = p_arg; unsigned char* ws = p.ws; (void)ws; int tid = threadIdx.x; const int lane = tid & 63, wid = tid >> 6; (void)lane; (void)wid
#endif
#define SYNC(k) if (PH_LO <= (k) && (k) + 1 < PH_HI) { if ((k) == 0) grid.sync(); else xcd_barrier(xbar); }
#ifdef XSYNC
    for (int i_ = 0; i_ < XSYNC; ++i_) xcd_barrier(xbar);
#endif
    PH(0) { LOADP(); for (int rep_ = 0; rep_ < REPP; ++rep_) p0_phase(p, lds, tid, wid, lane); } SYNC(0);
    PH(1) { LOADP(); for (int rep_ = 0; rep_ < REPP; ++rep_) p1_phase(p, wid, lane); } SYNC(1);
    PH(2) { LOADP();
        pg8::Gemm g = mk_gemm((const bf16_t*)(p.out + O_CKVP), (const bf16_t*)(p.out + O_CKVS), 64, (const bf16_t*)(ws + W_BT_DN), MT, 4352, 1024, 1024, 1024);
        EpiProj E{0, ws, p.out}; run_gemm(lds, g, E); } SYNC(2);
    PH(3) { LOADP();
#ifdef XPREP
        for (int u = blockIdx.x; u < 2176; u += gridDim.x) prep_unit<true>(p, lds, u, tid, wid, lane);
#endif
        for (int u = blockIdx.x; u < 2176; u += gridDim.x) prep_unit<false>(p, lds, u, tid, wid, lane); } SYNC(3);
    PH(4) { LOADP();
        for (int rep_ = 0; rep_ < REPS1; ++rep_) for (int ci = blockIdx.x; ci < 256; ci += gridDim.x) { if (ci & 1) scan_chain<1>(p, lds, ci >> 4, (ci >> 1) & 7, tid, wid, lane); else scan_chain<0>(p, lds, ci >> 4, (ci >> 1) & 7, tid, wid, lane); }
        xcd_barrier(xbar); }
    PH(4) { LOADP();
        for (int ci = blockIdx.x; ci < 256; ci += gridDim.x) { if (ci < 128) scan_chain<2>(p, lds, ci >> 3, ci & 7, tid, wid, lane); else scan_chain<3>(p, lds, ci - 128, 0, tid, wid, lane); } } SYNC(4);
    PH(5) { LOADP();
        pg8::Gemm g = mk_gemm((const bf16_t*)(p.out + O_CKVP), (const bf16_t*)(p.out + O_CKVS), 64, (const bf16_t*)(ws + W_BT_MLA), MT, 5376, 1024, 1024, 1024);
        EpiProj E{1, ws, p.out}; run_gemm(lds, g, E); } SYNC(5);
    PH(6) { LOADP(); e1_phase(p, wid, lane); } SYNC(6);
    PH(7) { LOADP();
        { pg8::Gemm g = mk_gemm((const bf16_t*)(ws + W_CKVP), nullptr, 1 << 20, (const bf16_t*)(ws + W_BT_UKV), MP, 1024, 512, 512, 512); EpiStore E{(bf16_t*)(ws + W_KN), 1024}; run_gemm(lds, g, E); }
        { pg8::Gemm g = mk_gemm((const bf16_t*)(ws + W_BT_UKV) + (size_t)1024 * 512, nullptr, 1 << 20, (const bf16_t*)(ws + W_CKVP), 1024, MP, 512, 512, 512); EpiStore E{(bf16_t*)(ws + W_VT), MP}; run_gemm(lds, g, E); } } SYNC(7);
    PH(8) { LOADP(); e2_phase(p, (bf16_t*)(ws + W_KN), MP, wid, lane); } SYNC(8);
    PH(9) { LOADP();
#ifdef XATTN
        attn_prompt_phase<true>(p, lds, tid, wid, lane);
#endif
        attn_prompt_phase<false>(p, lds, tid, wid, lane); } SYNC(9);
    PH(10) { LOADP();
        pg8::Gemm g = mk_gemm((const bf16_t*)(ws + W_UAP), nullptr, 1 << 20, (const bf16_t*)(ws + W_BT_O), MP, 1024, 2048, 1024, 2048); g.A2 = (const bf16_t*)(ws + W_UBP); g.A2s = g.A2; g.nt1 = 16;
        EpiMerge E{(const bf16_t*)(p.out + O_YP), (bf16_t*)(ws + W_MRGP)}; run_gemm(lds, g, E);
        build_sample_kv(p, wid, lane); } SYNC(10);
    PH(11) { LOADP();
        { pg8::Gemm g = mk_gemm((const bf16_t*)(ws + W_MRGP), nullptr, 1 << 20, (const bf16_t*)(ws + W_BT_OUT), MP, 1024, 1024, 1024, 1024);
          EpiOut E{p.in[I_XP], p.out + O_YP, (const float*)(ws + W_MOD), 8192, 0}; run_gemm(lds, g, E); }
        { pg8::Gemm g = mk_gemm((const bf16_t*)(ws + W_CKVALL), nullptr, 1 << 20, (const bf16_t*)(ws + W_BT_UKV), MKS, 1024, 512, 512, 512); EpiStore E{(bf16_t*)(ws + W_KNS), 1024}; run_gemm(lds, g, E); }
        { pg8::Gemm g = mk_gemm((const bf16_t*)(ws + W_BT_UKV) + (size_t)1024 * 512, nullptr, 1 << 20, (const bf16_t*)(ws + W_CKVALL), 1024, MKS, 512, 512, 512); EpiStore E{(bf16_t*)(ws + W_VTS), MKS}; run_gemm(lds, g, E); } } SYNC(11);
    PH(12) { LOADP(); e2_phase(p, (bf16_t*)(ws + W_KNS), MKS, wid, lane); } SYNC(12);
    PH(13) { LOADP(); attn_sample_phase(p, lds, tid, wid, lane); } SYNC(13);
    PH(14) { LOADP(); pg8::Gemm g = mk_gemm((const bf16_t*)(ws + W_UAS), nullptr, 1 << 20, (const bf16_t*)(ws + W_BT_O), MS, 1024, 2048, 1024, 2048); g.A2 = (const bf16_t*)(ws + W_UBS); g.A2s = g.A2; g.nt1 = 16;
        EpiMerge E{(const bf16_t*)(p.out + O_YS), (bf16_t*)(ws + W_MRGS)}; run_gemm(lds, g, E); } SYNC(14);
    PH(15) { LOADP(); pg8::Gemm g = mk_gemm((const bf16_t*)(ws + W_MRGS), nullptr, 1 << 20, (const bf16_t*)(ws + W_BT_OUT), MS, 1024, 1024, 1024, 1024);
        EpiOut E{p.in[I_XS], p.out + O_YS, (const float*)(ws + W_MOD), 32, 2}; run_gemm(lds, g, E); }
}

extern "C" void kernel_launch(void* const* d_in, const int* in_sizes, int n_in, void* d_out, int out_size, void* d_ws, size_t ws_size, hipStream_t stream) {
    static int grid = 0;
    if (grid == 0) {
        int dev = 0, cus = 0, per_cu = 0;
        if (n_in != 26 || ws_size < 256 * MiB) { fprintf(stderr, "kernel_launch: unexpected n_in %d / ws %zu\n", n_in, ws_size); grid = -1; return; }
        hipGetDevice(&dev); hipDeviceGetAttribute(&cus, hipDeviceAttributeMultiprocessorCount, dev);
        if (hipFuncSetAttribute((const void*)hybrid_fwd, hipFuncAttributeMaxDynamicSharedMemorySize, LDS_BYTES) != hipSuccess) { fprintf(stderr, "kernel_launch: hipFuncSetAttribute failed\n"); }
        if (hipOccupancyMaxActiveBlocksPerMultiprocessor(&per_cu, (const void*)hybrid_fwd, 512, LDS_BYTES) != hipSuccess || per_cu < 1) { fprintf(stderr, "kernel_launch: occupancy query says %d\n", per_cu); per_cu = 1; }
        (void)hipGetLastError();
        grid = cus;
    }
    if (grid < 0) return;
    Params p{};
    for (int i = 0; i < 26; ++i) p.in[i] = (const float*)d_in[i];
    p.out = (float*)d_out; p.ws = (unsigned char*)d_ws;
    if (hipMemsetAsync(d_ws, 0, 65536, stream) != hipSuccess) { fprintf(stderr, "kernel_launch: memset failed\n"); return; }
    void* args[] = {&p};
    hipError_t e = hipLaunchCooperativeKernel((const void*)hybrid_fwd, dim3(grid), dim3(512), args, LDS_BYTES, stream);
    if (e != hipSuccess) fprintf(stderr, "cooperative launch failed: %s (grid %d)\n", hipGetErrorString(e), grid);
}
```

```cpp
#include <hip/hip_runtime.h>
#include <hip/hip_cooperative_groups.h>
#include <cstdio>
#include <cstdint>
namespace cg = cooperative_groups;
namespace pg8 {
#define PG8_LAS __attribute__((address_space(3)))
typedef unsigned short bf16_t;
typedef short bf16x8 __attribute__((ext_vector_type(8)));
typedef float f32x4 __attribute__((ext_vector_type(4)));
typedef unsigned u32x4 __attribute__((ext_vector_type(4)));
constexpr int BM = 256, BK = 64, HALF = 128, HTB = HALF * BK * 2  , STAGE_BYTES = 8 * HTB, NXCD = 8, WGM = 8;

__host__ __device__ __forceinline__ int lds_byte(int r, int c) { const int st = (r >> 4) * 2 + (c >> 5), rr = r & 15, cc = c & 31, ob = rr * 64 + cc * 2; return st * 1024 + (ob ^ (((ob >> 9) & 1) << 5)); }
__host__ __device__ __forceinline__ void stage_rc(int b, int& R, int& C) { const int st = b / 1024, sb = b % 1024, swz = sb ^ (((sb >> 9) & 1) << 5); R = (st >> 1) * 16 + swz / 64; C = (st & 1) * 32 + (swz % 64) / 2; }
__host__ __device__ __forceinline__ int perm32(int rho) { const int n = rho >> 4, i = rho & 15; return 8 * (i >> 2) + 4 * n + (i & 3); }

struct Unit { int pm, pn; };
struct Gemm { const bf16_t* A; const bf16_t* As; const bf16_t* A2; const bf16_t* A2s; const bf16_t* Bt; int M, N, K, lda, ldb, pm_split, nt1; };

struct StaticOrder {
    int nM, nN, nwg, G, c;
    __host__ __device__ void init(int M, int N, int G_, int c_) { nM = M / BM; nN = N / BM; nwg = nM * nN; G = G_; c = c_; }
    __host__ __device__ bool next(int i, Unit& u) const {
        const long L = (long)i * G + c; if (L >= nwg) return false;
        int wgid = (int)L; { const int q = nwg / NXCD, r = nwg % NXCD, xcd = wgid % NXCD, off = wgid / NXCD; wgid = (xcd < r ? xcd * (q + 1) : r * (q + 1) + (xcd - r) * q) + off; }
        const int nig = WGM * nN, gid = wgid / nig, fm = gid * WGM, gsz = (nM - fm) < WGM ? (nM - fm) : WGM;
        u.pm = fm + ((wgid % nig) % gsz); u.pn = (wgid % nig) / gsz; return true;
    }
    __device__ __forceinline__ void a_ready(const Unit&) const {}
    __device__ __forceinline__ void done(const Unit&) const {}
};

__device__ __forceinline__ unsigned cvt_pk_bf16(float lo, float hi) { unsigned r; asm volatile("v_cvt_pk_bf16_f32 %0, %1, %2" : "=v"(r) : "v"(lo), "v"(hi)); return r; }

template <class Epi, class Sched, bool ALIGN_EPI = false, bool SP2 = false>
__device__ __forceinline__ void gemm_phase(PG8_LAS unsigned char* lds, const Gemm g, const Sched& S, const Epi& E) {
    int tid_l = threadIdx.x; asm volatile("" : "+v"(tid_l));
    const int tid = tid_l, wid = __builtin_amdgcn_readfirstlane(tid >> 6), lane = tid & 63, wr = wid >> 2, wc = wid & 3, fr = lane & 15, fq = lane >> 4;
    const int K = g.K, nt = K / BK;
    unsigned voffA[2], voffB[2];
#pragma unroll
    for (int i = 0; i < 2; ++i) { int R, C; stage_rc(tid * 16 + i * 8192, R, C); const int Rb = Epi::PERM ? ((R & ~31) + perm32(R & 31)) : R;
        voffA[i] = (unsigned)(R * g.lda + C) * 2u; voffB[i] = (unsigned)(Rb * g.ldb + C) * 2u; }
    const size_t kstep = (size_t)(BK * 2);
    const size_t hstepA = (size_t)HALF * g.lda * 2, hstepB = (size_t)HALF * g.ldb * 2;
    const size_t tstepA = 2 * hstepA, tstepB = 2 * hstepB; const int nt1 = g.nt1;
    const unsigned ldsw = (unsigned)wid * 1024u;
    const int aoff = lds_byte(wr * 64 + fr, fq * 8), boff = lds_byte(wc * 32 + fr, fq * 8);
#define PG8_SA(b, h) (((b) * 2 + (h)) * HTB)
#define PG8_SB(b, h) ((4 + (b) * 2 + (h)) * HTB)
#define PG8_STAGE(bufoff, gbase, voff) do { _Pragma("unroll") for (int _i = 0; _i < 2; ++_i) \
        __builtin_amdgcn_global_load_lds((const unsigned*)((const char*)(gbase) + (voff)[_i]), (PG8_LAS unsigned*)(lds + (bufoff) + ldsw + _i * 8192), 16, 0, 0); } while (0)
#define PG8_LDA(dst, b, h) do { _Pragma("unroll") for (int m = 0; m < 4; ++m) _Pragma("unroll") for (int k = 0; k < 2; ++k) dst[m][k] = *(const PG8_LAS bf16x8*)(lds + PG8_SA(b, h) + aoff + m * 2048 + k * 1024); } while (0)
#define PG8_LDB(dst, b, h) do { _Pragma("unroll") for (int n = 0; n < 2; ++n) _Pragma("unroll") for (int k = 0; k < 2; ++k) dst[n][k] = *(const PG8_LAS bf16x8*)(lds + PG8_SB(b, h) + boff + n * 2048 + k * 1024); } while (0)
#define PG8_MMA(ai, bj, At, Bt) do { __builtin_amdgcn_s_setprio(1); _Pragma("unroll") for (int m = 0; m < 4; ++m) _Pragma("unroll") for (int n = 0; n < 2; ++n) _Pragma("unroll") for (int k = 0; k < 2; ++k) \
        acc[ai][bj][m][n] = __builtin_amdgcn_mfma_f32_16x16x32_bf16(Bt[n][k], At[m][k], acc[ai][bj][m][n], 0, 0, 0); __builtin_amdgcn_s_setprio(0); } while (0)
#define PG8_WAIT_V(n) asm volatile("s_waitcnt vmcnt(" #n ")" ::: "memory")
#define PG8_WAIT_L(n) asm volatile("s_waitcnt lgkmcnt(" #n ")" ::: "memory")
#define PG8_BAR __builtin_amdgcn_s_barrier()
#define PG8_SCHED __builtin_amdgcn_sched_barrier(0)
    Unit cur, nxt; int ui = 0;
    if (!S.next(0, cur)) return;
    f32x4 acc[2][2][4][2];
#pragma unroll
    for (int a = 0; a < 2; ++a)
#pragma unroll
        for (int b = 0; b < 2; ++b)
#pragma unroll
            for (int m = 0; m < 4; ++m)
#pragma unroll
                for (int n = 0; n < 2; ++n) acc[a][b][m][n] = (f32x4){0.f, 0.f, 0.f, 0.f};
    bf16x8 At[4][2], B0[2][2], B1[2][2];
    #define PG8_UA(P, Ps, pm_) ((pm_) < g.pm_split ? (const char*)(P) + (size_t)(pm_) * tstepA : (const char*)(Ps) + (size_t)((pm_) - g.pm_split) * tstepA)
#define PG8_KA(t_) ((t_) < nt1 ? cA + (size_t)(t_) * kstep : cA2 + (size_t)((t_) - nt1) * kstep)
    const char* cA = PG8_UA(g.A, g.As, cur.pm); const char* cA2 = PG8_UA(g.A2, g.A2s, cur.pm); const char* cB = (const char*)g.Bt + (size_t)cur.pn * tstepB;
    S.a_ready(cur);
    if constexpr (SP2) {
        PG8_STAGE(PG8_SB(0, 0), cB, voffB); PG8_STAGE(PG8_SB(0, 1), cB + hstepB, voffB); PG8_STAGE(PG8_SA(0, 0), cA, voffA); PG8_STAGE(PG8_SA(0, 1), cA + hstepA, voffA);
        if (wr == 1) PG8_BAR;
        PG8_WAIT_V(2); PG8_BAR;
        PG8_STAGE(PG8_SB(1, 0), cB + kstep, voffB); PG8_STAGE(PG8_SA(1, 0), cA + kstep, voffA); PG8_STAGE(PG8_SB(1, 1), cB + hstepB + kstep, voffB);
        PG8_WAIT_V(6); PG8_BAR;
    } else {
        PG8_STAGE(PG8_SB(0, 0), cB, voffB); PG8_STAGE(PG8_SA(0, 0), cA, voffA); PG8_STAGE(PG8_SB(0, 1), cB + hstepB, voffB); PG8_STAGE(PG8_SA(0, 1), cA + hstepA, voffA);
        if (wr == 1) PG8_BAR;
        PG8_WAIT_V(4); PG8_BAR;
        PG8_STAGE(PG8_SB(1, 0), cB + kstep, voffB); PG8_STAGE(PG8_SA(1, 0), cA + kstep, voffA); PG8_STAGE(PG8_SB(1, 1), cB + hstepB + kstep, voffB);
        PG8_WAIT_V(6); PG8_BAR;
    }
    for (;;) {
        const bool has_next = S.next(ui + 1, nxt);
        const char* nA = has_next ? PG8_UA(g.A, g.As, nxt.pm) : cA; const char* nA2 = has_next ? PG8_UA(g.A2, g.A2s, nxt.pm) : cA2; const char* nB = has_next ? (const char*)g.Bt + (size_t)nxt.pn * tstepB : cB;
        for (int t = 0; t < nt; t += 2) {
            const bool last = (t == nt - 2);
            if constexpr (Epi::HAS_MID) { if (t == nt1) E.mid(acc, cur, wr, wc, fr, fq); }
            const char* a1 = PG8_KA(t + 1);
            const char* a2 = last ? nA : PG8_KA(t + 2); const char* b2 = last ? nB : cB + (size_t)(t + 2) * kstep;
            const char* a3 = a2 + kstep; const char* b3 = b2 + kstep;
            if (last && has_next) S.a_ready(nxt);
            if constexpr (SP2) {
            PG8_LDB(B0, 0, 0); PG8_LDB(B1, 0, 1); PG8_SCHED; PG8_LDA(At, 0, 0); PG8_STAGE(PG8_SA(1, 1), a1 + hstepA, voffA);
            PG8_WAIT_V(8); PG8_WAIT_L(0); PG8_BAR; PG8_MMA(0, 0, At, B0); PG8_MMA(0, 1, At, B1); PG8_BAR; PG8_SCHED;
            PG8_LDA(At, 0, 1); PG8_STAGE(PG8_SB(0, 0), b2, voffB); PG8_STAGE(PG8_SB(0, 1), b2 + hstepB, voffB); PG8_STAGE(PG8_SA(0, 0), a2, voffA);
            PG8_WAIT_V(8); PG8_WAIT_L(0); PG8_BAR; PG8_MMA(1, 0, At, B0); PG8_MMA(1, 1, At, B1); PG8_BAR; PG8_SCHED;
            PG8_LDB(B0, 1, 0); PG8_LDB(B1, 1, 1); PG8_SCHED; PG8_LDA(At, 1, 0); PG8_STAGE(PG8_SA(0, 1), a2 + hstepA, voffA);
            PG8_WAIT_V(8); PG8_WAIT_L(0); PG8_BAR; PG8_MMA(0, 0, At, B0); PG8_MMA(0, 1, At, B1); PG8_BAR; PG8_SCHED;
            PG8_LDA(At, 1, 1); PG8_STAGE(PG8_SB(1, 0), b3, voffB); PG8_STAGE(PG8_SB(1, 1), b3 + hstepB, voffB); PG8_STAGE(PG8_SA(1, 0), a3, voffA);
            PG8_WAIT_V(8); PG8_WAIT_L(0); PG8_BAR; PG8_MMA(1, 0, At, B0); PG8_MMA(1, 1, At, B1); PG8_BAR; PG8_SCHED;
            } else {
            PG8_LDB(B0, 0, 0); PG8_SCHED; PG8_LDA(At, 0, 0); PG8_STAGE(PG8_SA(1, 1), a1 + hstepA, voffA);
            PG8_WAIT_L(8); PG8_BAR; PG8_WAIT_L(0); PG8_MMA(0, 0, At, B0); PG8_BAR; PG8_SCHED;
            PG8_LDB(B1, 0, 1); PG8_STAGE(PG8_SB(0, 0), b2, voffB);
            PG8_BAR; PG8_WAIT_L(0); PG8_MMA(0, 1, At, B1); PG8_BAR;
            PG8_LDA(At, 0, 1); PG8_STAGE(PG8_SA(0, 0), a2, voffA);
            PG8_BAR; PG8_WAIT_L(0); PG8_MMA(1, 0, At, B0); PG8_BAR; PG8_SCHED;
            PG8_STAGE(PG8_SB(0, 1), b2 + hstepB, voffB);
            PG8_WAIT_V(6); PG8_BAR; PG8_MMA(1, 1, At, B1); PG8_BAR;
            PG8_LDB(B0, 1, 0); PG8_SCHED; PG8_LDA(At, 1, 0); PG8_STAGE(PG8_SA(0, 1), a2 + hstepA, voffA);
            PG8_WAIT_L(8); PG8_BAR; PG8_WAIT_L(0); PG8_MMA(0, 0, At, B0); PG8_BAR; PG8_SCHED;
            PG8_LDB(B1, 1, 1); PG8_STAGE(PG8_SB(1, 0), b3, voffB);
            PG8_BAR; PG8_WAIT_L(0); PG8_MMA(0, 1, At, B1); PG8_BAR;
            PG8_LDA(At, 1, 1); PG8_STAGE(PG8_SA(1, 0), a3, voffA);
            PG8_BAR; PG8_WAIT_L(0); PG8_MMA(1, 0, At, B0); PG8_BAR; PG8_SCHED;
            PG8_STAGE(PG8_SB(1, 1), b3 + hstepB, voffB);
            PG8_WAIT_V(6); PG8_BAR; PG8_MMA(1, 1, At, B1); PG8_BAR;
            }
        }
        if constexpr (ALIGN_EPI) { if (wr == 0) PG8_BAR; }
        if constexpr (!Epi::AFTER_DRAIN) { E(acc, cur, wr, wc, fr, fq); S.done(cur); }
        if (!has_next) break;
#pragma unroll
        for (int a = 0; a < 2; ++a)
#pragma unroll
            for (int b = 0; b < 2; ++b)
#pragma unroll
                for (int m = 0; m < 4; ++m)
#pragma unroll
                    for (int n = 0; n < 2; ++n) acc[a][b][m][n] = (f32x4){0.f, 0.f, 0.f, 0.f};
        cur = nxt; cA = nA; cA2 = nA2; cB = nB; ++ui;
        if constexpr (ALIGN_EPI) { if (wr == 1) PG8_BAR; }
    }
    PG8_WAIT_V(0);
    if constexpr (!ALIGN_EPI) { if (wr == 0) PG8_BAR; }
    PG8_BAR;
    if constexpr (Epi::AFTER_DRAIN) { E.fused(acc, cur, wr, wc, fr, fq, lds, wid, lane); S.done(cur); }
#undef PG8_UA
#undef PG8_KA
#undef PG8_SA
#undef PG8_SB
#undef PG8_STAGE
#undef PG8_LDA
#undef PG8_LDB
#undef PG8_MMA
#undef PG8_WAIT_V
#undef PG8_WAIT_L
#undef PG8_BAR
#undef PG8_SCHED
}
}
#define LAS __attribute__((address_space(3)))
typedef unsigned short bf16_t;
typedef short bf16x8 __attribute__((ext_vector_type(8)));
typedef float f32x4 __attribute__((ext_vector_type(4)));
typedef float f32x16 __attribute__((ext_vector_type(16)));
typedef unsigned u32x4 __attribute__((ext_vector_type(4)));
typedef unsigned u32x2 __attribute__((ext_vector_type(2)));
typedef float f32x2_t __attribute__((ext_vector_type(2)));
typedef __bf16 bf16x2_t __attribute__((ext_vector_type(2)));

constexpr int MP = 16384, MS = 512, MT = MP + MS, TKS = 2080, MKS = 16 * TKS  ;
constexpr float EPS = 1e-6f;
constexpr size_t MiB = 1u << 20;
constexpr size_t W_BT_DN = 1 * MiB, W_BT_MLA = W_BT_DN + (size_t)4352 * 1024 * 2, W_BT_UKV = 20 * MiB, W_BT_O = 22 * MiB, W_BT_OUT = 26 * MiB;
constexpr size_t W_MOD = 28 * MiB, W_GL = 28 * MiB + 256 * 1024, W_BA = 28 * MiB + 512 * 1024;
constexpr size_t W_QS = 30 * MiB, W_CKVS = 31 * MiB + 512 * 1024, W_KRS = 32 * MiB, W_UAS = 33 * MiB, W_UBS = 34 * MiB, W_MRGS = 35 * MiB;
constexpr size_t W_QKV = 36 * MiB, W_HALO = 135 * MiB, W_KDT = 140 * MiB, W_SQKV = 174 * MiB, W_UAP = 189 * MiB, W_TB = 221 * MiB, W_MB = 238 * MiB, W_UBP = 222 * MiB;
constexpr size_t W_QP = 36 * MiB, W_CKVP = 84 * MiB, W_KRP = 100 * MiB, W_KN = 102 * MiB, W_VT = 134 * MiB;
constexpr size_t W_SA = 36 * MiB, W_SB = 52 * MiB;
constexpr size_t W_ROPE = 180 * MiB;
constexpr size_t W_GS = 254 * MiB, W_MF32 = 2 * MiB, W_CVT = 4 * MiB, W_PART = 8 * MiB, W_CNT = 32768;
constexpr size_t W_MRGP = 36 * MiB, W_CKVALL = 68 * MiB, W_KRALL = 101 * MiB, W_KNS = 106 * MiB, W_VTS = 172 * MiB;
static_assert(W_BT_MLA + (size_t)5376 * 1024 * 2 <= W_BT_UKV, "ws map");
static_assert(W_BA + (size_t)MT * 16 * 4 <= W_QS, "ws map");
static_assert(W_QKV + (size_t)MT * 3072 * 2 <= W_HALO && W_HALO + (size_t)264 * 3 * 3072 * 2 <= W_KDT && W_KDT + (size_t)2176 * 8192 * 2 <= W_SQKV && W_SQKV + (size_t)128 * 3 * 8192 * 2 <= W_UAP, "ws map");
static_assert(W_TB + (size_t)2176 * 4096 * 2 <= W_MB && W_MB + (size_t)128 * 2 * 16384 * 4 <= 256 * MiB && W_UAP + (size_t)MP * 1024 * 2 <= W_UBP && W_UBP + (size_t)MP * 1024 * 2 <= 256 * MiB, "ws map");
static_assert(W_QP + (size_t)MP * 1536 * 2 <= W_CKVP && W_CKVP + (size_t)MP * 512 * 2 <= W_KRP && W_KRP + (size_t)MP * 64 * 2 <= W_KN && W_KN + (size_t)MP * 1024 * 2 <= W_VT && W_VT + (size_t)MP * 1024 * 2 <= W_UAP, "ws map");
static_assert(W_MRGP + (size_t)MP * 1024 * 2 <= W_CKVALL && W_CKVALL + (size_t)(MKS + 64) * 512 * 2 <= W_KRALL && W_KRALL + (size_t)(MKS + 64) * 64 * 2 <= W_KNS && W_KNS + (size_t)(MKS + 64) * 1024 * 2 <= W_VTS && W_VTS + (size_t)1024 * MKS * 2 + 256 <= 256 * MiB, "ws map");
constexpr size_t O_YP = 0, O_YS = O_YP + (size_t)MP * 1024, O_CKVP = O_YS + (size_t)MS * 1024, O_KRP = O_CKVP + (size_t)MP * 512, O_SDP = O_KRP + (size_t)MP * 64,
                 O_CVP = O_SDP + 2 * 8 * 128 * 128, O_CKVS = O_CVP + 2 * 3 * 3072, O_KRS = O_CKVS + (size_t)MS * 512, O_SDS = O_KRS + (size_t)MS * 64, O_CVS = O_SDS + (size_t)16 * 8 * 128 * 128;
constexpr int LDS_BYTES = 163840;

struct Params { const float* in[26]; float* out; unsigned char* ws; };
enum { I_XP = 0, I_XS, I_CP, I_CS, I_CCKV, I_CKR, I_SD, I_SC, I_NG, I_WADA, I_BADA, I_WIN, I_WCONV, I_ALOG, I_DTB, I_DNN, I_QNN, I_QRN, I_KNN, I_KRN, I_KVN, I_WUK, I_WUV, I_WODN, I_WOMLA, I_WOUT };

__device__ __forceinline__ float bf2f(unsigned short u) { return __uint_as_float((unsigned)u << 16); }
__device__ __forceinline__ float bflo(unsigned u) { return __uint_as_float(u << 16); }
__device__ __forceinline__ float bfhi(unsigned u) { return __uint_as_float(u & 0xffff0000u); }
__device__ __forceinline__ unsigned pk2(float lo, float hi) { f32x2_t v = {lo, hi}; bf16x2_t b = __builtin_convertvector(v, bf16x2_t); return __builtin_bit_cast(unsigned, b); }
__device__ __forceinline__ unsigned short f2bf(float f) { return (unsigned short)(pk2(f, 0.f) & 0xffffu); }
__device__ __forceinline__ float wave_sum(float v) {
#pragma unroll
    for (int o = 1; o < 64; o <<= 1) v += __shfl_xor(v, o);
    return v;
}
__device__ __forceinline__ float sigmoidf_(float x) { return __builtin_amdgcn_rcpf(1.f + __expf(-x)); }
__device__ __forceinline__ float siluf_(float x) { return x * __builtin_amdgcn_rcpf(1.f + __expf(-x)); }
__device__ __forceinline__ void unpack8(u32x4 v, float* f) { f[0] = bflo(v.x); f[1] = bfhi(v.x); f[2] = bflo(v.y); f[3] = bfhi(v.y); f[4] = bflo(v.z); f[5] = bfhi(v.z); f[6] = bflo(v.w); f[7] = bfhi(v.w); }
__device__ __forceinline__ u32x4 pack8(const float* f) { u32x4 v; v.x = pk2(f[0], f[1]); v.y = pk2(f[2], f[3]); v.z = pk2(f[4], f[5]); v.w = pk2(f[6], f[7]); return v; }

using pg8::Unit;
struct EpiStore {
    static constexpr bool PERM = true, AFTER_DRAIN = false, HAS_MID = false;
    bf16_t* O; int ldc; int swz;
    __device__ __forceinline__ void operator()(const f32x4 (&acc)[2][2][4][2], const Unit& u, int wr, int wc, int fr, int fq) const {
#pragma unroll
        for (int ai = 0; ai < 2; ++ai)
#pragma unroll
            for (int m = 0; m < 4; ++m) { const int row = u.pm * 256 + ai * 128 + wr * 64 + m * 16 + fr; bf16_t* rp = O + (size_t)row * ldc + u.pn * 256 + wc * 32 + 8 * fq;
#pragma unroll
                for (int bj = 0; bj < 2; ++bj) { const bool sw = swz && (m & 1); const f32x4 v0 = sw ? acc[ai][bj][m][1] : acc[ai][bj][m][0], v1 = sw ? acc[ai][bj][m][0] : acc[ai][bj][m][1]; u32x4 w; w.x = pk2(v0[0], v0[1]); w.y = pk2(v0[2], v0[3]); w.z = pk2(v1[0], v1[1]); w.w = pk2(v1[2], v1[3]);
                    *(u32x4*)(rp + bj * 128) = w; } }
    }
};
struct EpiProj {
    static constexpr bool PERM = true, AFTER_DRAIN = false, HAS_MID = false;
    int pass; unsigned char* ws; float* out; int smp, pm_off, pn_off;
    __device__ __forceinline__ void operator()(const f32x4 (&acc)[2][2][4][2], const Unit& u, int wr, int wc, int fr, int fq) const {
        bf16_t* bp; bf16_t* bs; int ldc, ct; int kind = 0;
        const int pn = u.pn + pn_off, pm = u.pm + pm_off;
        if (pass == 0) {
            if (pn < 12) { bp = (bf16_t*)(ws + W_QKV); bs = bp + (size_t)MP * 3072; ldc = 3072; ct = pn * 256; kind = 3; }
            else if (pn < 16) { bp = (bf16_t*)(ws + W_UAP); bs = (bf16_t*)(ws + W_UAS); ldc = 1024; ct = (pn - 12) * 256; }
            else { bp = bs = nullptr; ldc = 0; ct = 0; kind = 1; }
        } else {
            if (pn < 6) { bp = (bf16_t*)(ws + W_QP); bs = (bf16_t*)(ws + W_QS); ldc = 1536; ct = pn * 256; }
            else if (pn < 8) { bp = (bf16_t*)(ws + W_CKVP); bs = (bf16_t*)(ws + W_CKVS); ldc = 512; ct = (pn - 6) * 256; }
            else if (pn < 12) { bp = (bf16_t*)(ws + W_UBP); bs = (bf16_t*)(ws + W_UBS); ldc = 1024; ct = (pn - 8) * 256; }
            else if (pn < 20) { bp = (bf16_t*)(out + O_YP); bs = (bf16_t*)(ws + W_GS); ldc = 2048; ct = (pn - 12) * 256; }
            else { bp = (bf16_t*)(ws + W_KRP); bs = (bf16_t*)(ws + W_KRS); ldc = 64; ct = 0; kind = 2; }
        }
        if (kind == 1) {
            if (wc != 0 || fq >= 2) return;
            float* ba = (float*)(ws + W_BA) + (smp ? (size_t)MP * 16 : 0);
#pragma unroll
            for (int ai = 0; ai < 2; ++ai)
#pragma unroll
                for (int m = 0; m < 4; ++m) { const int row = pm * 256 + ai * 128 + wr * 64 + m * 16 + fr; float* rp = ba + (size_t)row * 16 + 8 * fq;
                    *(f32x4*)rp = acc[ai][0][m][0]; *(f32x4*)(rp + 4) = acc[ai][0][m][1]; }
            return;
        }
        if (kind == 2 && wc >= 2) return;
        bf16_t* base = smp ? bs : bp;
#pragma unroll
        for (int ai = 0; ai < 2; ++ai)
#pragma unroll
            for (int m = 0; m < 4; ++m) { const int row = pm * 256 + ai * 128 + wr * 64 + m * 16 + fr;
                bf16_t* rp = base + (size_t)row * ldc + ct + wc * 32 + 8 * fq;
#pragma unroll
                for (int bj = 0; bj < 2; ++bj) { if (kind == 2 && bj == 1) continue;
                    const f32x4 v0 = acc[ai][bj][m][0], v1 = acc[ai][bj][m][1]; u32x4 w; w.x = pk2(v0[0], v0[1]); w.y = pk2(v0[2], v0[3]); w.z = pk2(v1[0], v1[1]); w.w = pk2(v1[2], v1[3]);
                    *(u32x4*)(rp + bj * 128) = w;
                    if (kind == 3 && !smp && m == 3 && fr >= 13) *(u32x4*)((bf16_t*)(ws + W_HALO) + ((size_t)(row >> 6) * 3 + (fr - 13)) * 3072 + ct + wc * 32 + 8 * fq + bj * 128) = w; } }
    }
};
struct EpiMerge {
    static constexpr bool PERM = true, AFTER_DRAIN = false, HAS_MID = true;
    const bf16_t* G; bf16_t* O;
    __device__ __forceinline__ void mid(f32x4 (&acc)[2][2][4][2], const Unit& u, int wr, int wc, int fr, int fq) const {
#pragma unroll
        for (int ai = 0; ai < 2; ++ai)
#pragma unroll
            for (int m = 0; m < 4; ++m) { const int row = u.pm * 256 + ai * 128 + wr * 64 + m * 16 + fr; const bf16_t* gp = G + (size_t)row * 2048 + u.pn * 256 + wc * 32 + 8 * fq;
#pragma unroll
                for (int bj = 0; bj < 2; ++bj) { float ga[8], gb[8]; unpack8(*(const u32x4*)(gp + bj * 128), ga); unpack8(*(const u32x4*)(gp + 1024 + bj * 128), gb);
#pragma unroll
                    for (int e = 0; e < 8; ++e) { const float f = (1.f + __expf(-gb[e])) * __builtin_amdgcn_rcpf(1.f + __expf(-ga[e])); if (e < 4) acc[ai][bj][m][0][e] *= f; else acc[ai][bj][m][1][e - 4] *= f; } } }
    }
    __device__ __forceinline__ void operator()(const f32x4 (&acc)[2][2][4][2], const Unit& u, int wr, int wc, int fr, int fq) const {
#pragma unroll
        for (int ai = 0; ai < 2; ++ai)
#pragma unroll
            for (int m = 0; m < 4; ++m) { const int row = u.pm * 256 + ai * 128 + wr * 64 + m * 16 + fr; const bf16_t* gp = G + (size_t)row * 2048 + 1024 + u.pn * 256 + wc * 32 + 8 * fq;
                bf16_t* rp = O + (size_t)row * 1024 + u.pn * 256 + wc * 32 + 8 * fq;
#pragma unroll
                for (int bj = 0; bj < 2; ++bj) { float gb[8], v[8]; unpack8(*(const u32x4*)(gp + bj * 128), gb);
#pragma unroll
                    for (int e = 0; e < 8; ++e) v[e] = (e < 4 ? acc[ai][bj][m][0][e] : acc[ai][bj][m][1][e - 4]) * sigmoidf_(gb[e]);
                    *(u32x4*)(rp + bj * 128) = pack8(v); } }
    }
};
struct EpiOut {
    static constexpr bool PERM = true, AFTER_DRAIN = false, HAS_MID = false;
    const float* X; float* Y; const float* mod; int rows_per_batch, mod_row0;
    __device__ __forceinline__ void operator()(const f32x4 (&acc)[2][2][4][2], const Unit& u, int wr, int wc, int fr, int fq) const {
#pragma unroll
        for (int ai = 0; ai < 2; ++ai)
#pragma unroll
            for (int m = 0; m < 4; ++m) { const int row = u.pm * 256 + ai * 128 + wr * 64 + m * 16 + fr; const int col = u.pn * 256 + wc * 32 + 8 * fq;
                const float* gt = mod + (size_t)(mod_row0 + (row >> rows_per_batch)) * 3072 + 2048 + col;
#pragma unroll
                for (int bj = 0; bj < 2; ++bj) {
                    const f32x4 x0 = __builtin_nontemporal_load((const f32x4*)(X + (size_t)row * 1024 + col + bj * 128)), x1 = __builtin_nontemporal_load((const f32x4*)(X + (size_t)row * 1024 + col + bj * 128 + 4));
                    const f32x4 g0 = *(const f32x4*)(gt + bj * 128), g1 = *(const f32x4*)(gt + bj * 128 + 4);
                    __builtin_nontemporal_store(x0 + g0 * acc[ai][bj][m][0], (f32x4*)(Y + (size_t)row * 1024 + col + bj * 128));
                    __builtin_nontemporal_store(x1 + g1 * acc[ai][bj][m][1], (f32x4*)(Y + (size_t)row * 1024 + col + bj * 128 + 4)); } }
    }
};

struct EpiPartMerge {
    static constexpr bool PERM = true, AFTER_DRAIN = false, HAS_MID = false;
    const bf16_t* G; float* O; int pm, pn, goff;
    __device__ __forceinline__ void operator()(const f32x4 (&acc)[2][2][4][2], const Unit&, int wr, int wc, int fr, int fq) const {
#pragma unroll
        for (int ai = 0; ai < 2; ++ai)
#pragma unroll
            for (int m = 0; m < 4; ++m) { const int row = pm * 256 + ai * 128 + wr * 64 + m * 16 + fr; const int col = pn * 256 + wc * 32 + 8 * fq;
#pragma unroll
                for (int bj = 0; bj < 2; ++bj) { float gg[8]; unpack8(*(const u32x4*)(G + (size_t)row * 2048 + goff + col + bj * 128), gg); float* op = O + (size_t)row * 1024 + col + bj * 128;
#pragma unroll
                    for (int e = 0; e < 8; ++e) unsafeAtomicAdd(op + e, sigmoidf_(gg[e]) * (e < 4 ? acc[ai][bj][m][0][e] : acc[ai][bj][m][1][e - 4])); } }
    }
};
struct EpiPartOut {
    static constexpr bool PERM = true, AFTER_DRAIN = false, HAS_MID = false;
    const float* X; float* Y; const float* mod; int pm, pn, addx;
    __device__ __forceinline__ void operator()(const f32x4 (&acc)[2][2][4][2], const Unit&, int wr, int wc, int fr, int fq) const {
#pragma unroll
        for (int ai = 0; ai < 2; ++ai)
#pragma unroll
            for (int m = 0; m < 4; ++m) { const int row = pm * 256 + ai * 128 + wr * 64 + m * 16 + fr; const int col = pn * 256 + wc * 32 + 8 * fq;
                const float* gt = mod + (size_t)(2 + (row >> 5)) * 3072 + 2048 + col;
#pragma unroll
                for (int bj = 0; bj < 2; ++bj) { float* yp = Y + (size_t)row * 1024 + col + bj * 128; const float* xp = X + (size_t)row * 1024 + col + bj * 128;
#pragma unroll
                    for (int e = 0; e < 8; ++e) { float v = gt[bj * 128 + e] * (e < 4 ? acc[ai][bj][m][0][e] : acc[ai][bj][m][1][e - 4]); if (addx) v += xp[e]; unsafeAtomicAdd(yp + e, v); } } }
    }
};

struct EpiSlabMerge {
    static constexpr bool PERM = true, AFTER_DRAIN = false, HAS_MID = false;
    const bf16_t* G; float* S; int pm, pn, goff;
    __device__ __forceinline__ void operator()(const f32x4 (&acc)[2][2][4][2], const Unit&, int wr, int wc, int fr, int fq) const {
#pragma unroll
        for (int ai = 0; ai < 2; ++ai)
#pragma unroll
            for (int m = 0; m < 4; ++m) { const int row = pm * 256 + ai * 128 + wr * 64 + m * 16 + fr; const int col = pn * 256 + wc * 32 + 8 * fq;
#pragma unroll
                for (int bj = 0; bj < 2; ++bj) { float gg[8]; unpack8(*(const u32x4*)(G + (size_t)row * 2048 + goff + col + bj * 128), gg); float* op = S + (size_t)row * 1024 + col + bj * 128;
                    f32x4 v0 = acc[ai][bj][m][0], v1 = acc[ai][bj][m][1];
                    v0.x *= sigmoidf_(gg[0]); v0.y *= sigmoidf_(gg[1]); v0.z *= sigmoidf_(gg[2]); v0.w *= sigmoidf_(gg[3]); v1.x *= sigmoidf_(gg[4]); v1.y *= sigmoidf_(gg[5]); v1.z *= sigmoidf_(gg[6]); v1.w *= sigmoidf_(gg[7]);
                    *(f32x4*)op = v0; *(f32x4*)(op + 4) = v1; } }
    }
};
struct EpiSlabOut {
    static constexpr bool PERM = true, AFTER_DRAIN = false, HAS_MID = false;
    float* S; int pm, pn;
    __device__ __forceinline__ void operator()(const f32x4 (&acc)[2][2][4][2], const Unit&, int wr, int wc, int fr, int fq) const {
#pragma unroll
        for (int ai = 0; ai < 2; ++ai)
#pragma unroll
            for (int m = 0; m < 4; ++m) { const int row = pm * 256 + ai * 128 + wr * 64 + m * 16 + fr; const int col = pn * 256 + wc * 32 + 8 * fq;
#pragma unroll
                for (int bj = 0; bj < 2; ++bj) { float* op = S + (size_t)row * 1024 + col + bj * 128; *(f32x4*)op = acc[ai][bj][m][0]; *(f32x4*)(op + 4) = acc[ai][bj][m][1]; } }
    }
};

struct EpiKN {
    static constexpr bool PERM = true, AFTER_DRAIN = false, HAS_MID = false;
    bf16_t* O; const float* gain; PG8_LAS float* P;
    __device__ __forceinline__ void operator()(const f32x4 (&acc)[2][2][4][2], const Unit& u, int wr, int wc, int fr, int fq) const {
#pragma unroll
        for (int ai = 0; ai < 2; ++ai)
#pragma unroll
            for (int m = 0; m < 4; ++m)
#pragma unroll
                for (int bj = 0; bj < 2; ++bj) { const f32x4 v0 = acc[ai][bj][m][0], v1 = acc[ai][bj][m][1];
                    float s = (v0.x * v0.x + v0.y * v0.y) + (v0.z * v0.z + v0.w * v0.w) + (v1.x * v1.x + v1.y * v1.y) + (v1.z * v1.z + v1.w * v1.w);
                    s += __shfl_xor(s, 16); s += __shfl_xor(s, 32);
                    if (fq == 0) P[((ai * 128 + wr * 64 + m * 16 + fr) * 2 + bj) * 4 + wc] = s; }
        asm volatile("s_waitcnt lgkmcnt(0)" ::: "memory"); __builtin_amdgcn_s_barrier(); asm volatile("" ::: "memory");
        float gn[8];
#pragma unroll
        for (int e = 0; e < 8; ++e) gn[e] = gain[wc * 32 + 8 * fq + e];
#pragma unroll
        for (int ai = 0; ai < 2; ++ai)
#pragma unroll
            for (int m = 0; m < 4; ++m) { const int rl = ai * 128 + wr * 64 + m * 16 + fr; bf16_t* rp = O + (size_t)(u.pm * 256 + rl) * 1024 + u.pn * 256 + wc * 32 + 8 * fq;
#pragma unroll
                for (int bj = 0; bj < 2; ++bj) { const f32x4 ps = *(const PG8_LAS f32x4*)(P + (rl * 2 + bj) * 4); const float rn = rsqrtf(((ps.x + ps.y) + (ps.z + ps.w)) * (1.f / 128.f) + EPS);
                    const f32x4 v0 = acc[ai][bj][m][0], v1 = acc[ai][bj][m][1]; u32x4 w;
                    w.x = pk2(v0.x * rn * gn[0], v0.y * rn * gn[1]); w.y = pk2(v0.z * rn * gn[2], v0.w * rn * gn[3]); w.z = pk2(v1.x * rn * gn[4], v1.y * rn * gn[5]); w.w = pk2(v1.z * rn * gn[6], v1.w * rn * gn[7]);
                    *(u32x4*)(rp + bj * 128) = w; } }
        asm volatile("s_waitcnt lgkmcnt(0)" ::: "memory"); __builtin_amdgcn_s_barrier(); asm volatile("" ::: "memory");
    }
};
struct TrItem { const float* W; bf16_t* WT; int ldw, n0, k0, ldt, r0, kdst; };
__device__ __forceinline__ void tr_load(const TrItem& d, float (&tv)[32], int lane) {
#pragma unroll
    for (int i = 0; i < 32; ++i) tv[i] = d.W[(size_t)(d.k0 + 2 * i + (lane >> 5)) * d.ldw + d.n0 + (lane & 31)];
}
__device__ __forceinline__ void tr_store(const TrItem& d, const float (&tv)[32], LAS float* scr, int lane) {
#pragma unroll
    for (int i = 0; i < 32; ++i) scr[(2 * i + (lane >> 5)) * 33 + (lane & 31)] = tv[i];
    asm volatile("s_waitcnt lgkmcnt(0)" ::: "memory");
    const int c = lane & 7;
#pragma unroll
    for (int j = 0; j < 4; ++j) { const int n = (lane >> 3) + 8 * j; const LAS float* s = scr + (8 * c) * 33 + n;
        u32x4 o; o.x = pk2(s[0 * 33], s[1 * 33]); o.y = pk2(s[2 * 33], s[3 * 33]); o.z = pk2(s[4 * 33], s[5 * 33]); o.w = pk2(s[6 * 33], s[7 * 33]);
        *(u32x4*)(d.WT + (size_t)(d.r0 + n) * d.ldt + d.kdst + d.k0 + 8 * c) = o; }
    asm volatile("s_waitcnt lgkmcnt(0)" ::: "memory");
}
__device__ __forceinline__ void p0_phase(const Params& p, LAS unsigned char* lds, int tid, int wid, int lane) {
    const int G = gridDim.x, bx = blockIdx.x;
    for (int task = bx; task < 288; task += G) {
        const int cb = task % 48, rg = task / 48; LAS float* cl = (LAS float*)(lds + 65536);
        __syncthreads();
        for (int i = tid; i < 3 * 1024; i += 512) { const int r = rg * 3 + (i >> 10), k = i & 1023; cl[i] = r < 2 ? p.in[I_CP][r * 1024 + k] : p.in[I_CS][(r - 2) * 1024 + k]; }
        __syncthreads();
        const int j = cb * 64 + lane; float a0 = 0.f, a1 = 0.f, a2 = 0.f; const float* wa = p.in[I_WADA] + j;
#pragma unroll 16
        for (int k = wid * 128; k < wid * 128 + 128; ++k) { const float wv = wa[(size_t)k * 3072]; a0 += cl[k] * wv; a1 += cl[1024 + k] * wv; a2 += cl[2048 + k] * wv; }
        LAS float* red = (LAS float*)lds;
        red[(wid * 3 + 0) * 64 + lane] = a0; red[(wid * 3 + 1) * 64 + lane] = a1; red[(wid * 3 + 2) * 64 + lane] = a2;
        __syncthreads();
        if (tid < 192) { const int r = tid >> 6, l = tid & 63; float s = 0.f;
#pragma unroll
            for (int w = 0; w < 8; ++w) s += red[(w * 3 + r) * 64 + l];
            ((float*)(p.ws + W_MOD))[(rg * 3 + r) * 3072 + cb * 64 + l] = s + p.in[I_BADA][cb * 64 + l]; }
    }
    __syncthreads();
    for (int idx = bx * 512 + tid; idx < 8192 * 32; idx += G * 512) { const int i = idx & 31; const float inv = exp2f(-(float)i * (13.287712379549449f / 32.f)); float sn, cs; sincosf((float)(idx >> 5) * inv, &sn, &cs);
        ((f32x2_t*)(p.ws + W_ROPE))[idx] = (f32x2_t){cs, sn}; }
    LAS float* scr = (LAS float*)(lds + 81920 + wid * 8448);
    const int gw = bx * 8 + wid, NGW = G * 8;
    constexpr int I_DN = 129 * 16, I_MLA = 162 * 16, I_UK = 32 * 8, I_UV = 32 * 8, I_ODN = 32 * 16, I_OMLA = 32 * 16, I_WO = 32 * 16;
    constexpr int NITEMS = I_DN + I_MLA + I_UK + I_UV + I_ODN + I_OMLA + I_WO;
    auto decode = [&](int it) { TrItem d; int r = it;
        if (r < I_DN) { const int dg = r >> 4, kb = r & 15; d = TrItem{p.in[I_WIN], (bf16_t*)(p.ws + W_BT_DN), 9296, 32 * dg, 64 * kb, 1024, 32 * dg, 0}; return d; } r -= I_DN;
        if (r < I_MLA) { const int dg = r >> 4, kb = r & 15; int n0;
            if (dg < 48) n0 = 4112 + 32 * dg; else if (dg < 64) n0 = 5648 + 32 * (dg - 48); else if (dg < 96) n0 = 6224 + 32 * (dg - 64); else if (dg < 160) n0 = 7248 + 32 * (dg - 96); else n0 = 6160 + 32 * (dg - 160);
            d = TrItem{p.in[I_WIN], (bf16_t*)(p.ws + W_BT_MLA), 9296, n0, 64 * kb, 1024, 32 * dg, 0}; return d; } r -= I_MLA;
        if (r < I_UK) { const int dg = r >> 3, kb = r & 7; d = TrItem{p.in[I_WUK], (bf16_t*)(p.ws + W_BT_UKV), 1024, 32 * dg, 64 * kb, 512, 32 * dg, 0}; return d; } r -= I_UK;
        if (r < I_UV) { const int dg = r >> 3, kb = r & 7; d = TrItem{p.in[I_WUV], (bf16_t*)(p.ws + W_BT_UKV), 1024, 32 * dg, 64 * kb, 512, 1024 + 32 * dg, 0}; return d; } r -= I_UV;
        if (r < I_ODN) { const int dg = r >> 4, kb = r & 15; d = TrItem{p.in[I_WODN], (bf16_t*)(p.ws + W_BT_O), 1024, 32 * dg, 64 * kb, 2048, 32 * dg, 0}; return d; } r -= I_ODN;
        if (r < I_OMLA) { const int dg = r >> 4, kb = r & 15; d = TrItem{p.in[I_WOMLA], (bf16_t*)(p.ws + W_BT_O), 1024, 32 * dg, 64 * kb, 2048, 32 * dg, 1024}; return d; } r -= I_OMLA;
        { const int dg = r >> 4, kb = r & 15; d = TrItem{p.in[I_WOUT], (bf16_t*)(p.ws + W_BT_OUT), 1024, 32 * dg, 64 * kb, 1024, 32 * dg, 0}; return d; } };
    if (gw < NITEMS) { float ta[32], tb[32]; TrItem da = decode(gw), db = da; tr_load(da, ta, lane);
        for (int it = gw; it < NITEMS; it += 2 * NGW) {
            const bool hb = it + NGW < NITEMS; if (hb) { db = decode(it + NGW); tr_load(db, tb, lane); }
            tr_store(da, ta, scr, lane);
            if (!hb) break;
            const bool ha = it + 2 * NGW < NITEMS; if (ha) { da = decode(it + 2 * NGW); tr_load(da, ta, lane); }
            tr_store(db, tb, scr, lane);
            if (!ha) break; } }
}
__device__ __forceinline__ void p1_phase(const Params& p, int wid, int lane) {
    const int gw = blockIdx.x * 8 + wid, NGW = gridDim.x * 8; const float* mod = (const float*)(p.ws + W_MOD);
    for (int row0 = gw; row0 < MT; row0 += 2 * NGW) {
        f32x4 v[2][4]; float s[2] = {0.f, 0.f};
#pragma unroll
        for (int t = 0; t < 2; ++t) { const int row = row0 + t * NGW; if (row < MT) { const float* xr = row < MP ? p.in[I_XP] + (size_t)row * 1024 : p.in[I_XS] + (size_t)(row - MP) * 1024;
#pragma unroll
            for (int j = 0; j < 4; ++j) v[t][j] = __builtin_nontemporal_load((const f32x4*)(xr + 4 * lane + 256 * j)); } }
#pragma unroll
        for (int t = 0; t < 2; ++t) { const int row = row0 + t * NGW; if (row < MT) {
#pragma unroll
            for (int j = 0; j < 4; ++j) s[t] += (v[t][j].x * v[t][j].x + v[t][j].y * v[t][j].y) + (v[t][j].z * v[t][j].z + v[t][j].w * v[t][j].w);
            const float rs = rsqrtf(wave_sum(s[t]) * (1.f / 1024.f) + EPS);
            const int mr = row < MP ? (row >> 13) : 2 + ((row - MP) >> 5);
            bf16_t* hr = row < MP ? (bf16_t*)(p.out + O_CKVP) + (size_t)row * 1024 : (bf16_t*)(p.out + O_CKVS) + (size_t)(row - MP) * 1024;
#pragma unroll
            for (int j = 0; j < 4; ++j) { const int c = 4 * lane + 256 * j;
                const f32x4 g = *(const f32x4*)(p.in[I_NG] + c), sh = *(const f32x4*)(mod + mr * 3072 + c), sc = *(const f32x4*)(mod + mr * 3072 + 1024 + c);
                const f32x4 y = v[t][j] * rs * g * (1.f + sc) + sh; u32x2 o; o.x = pk2(y.x, y.y); o.y = pk2(y.z, y.w); *(u32x2*)(hr + c) = o; } } }
    }
}
__device__ __forceinline__ void e1_phase(const Params& p, int wid, int lane) {
    const int gw = blockIdx.x * 8 + wid, NGW = gridDim.x * 8;
    const float QSC = 0.07216878364870322f * 1.4426950408889634f;
    for (int row = gw; row < MT; row += NGW) {
        const bool pr = row < MP; const int lr = pr ? row : row - MP;
        const f32x2_t* rope = (const f32x2_t*)(p.ws + W_ROPE) + (size_t)(pr ? (row & 8191) : (2048 + (lr & 31))) * 32;
        const u32x4 ckv_raw = *(const u32x4*)((pr ? (const bf16_t*)(p.ws + W_CKVP) : (const bf16_t*)(p.ws + W_CKVS)) + (size_t)lr * 512 + lane * 8);
        const bf16_t* krp_ = (pr ? (const bf16_t*)(p.ws + W_KRP) : (const bf16_t*)(p.ws + W_KRS)) + (size_t)lr * 64; const unsigned short kr1_raw = krp_[lane & 31], kr2_raw = krp_[32 + (lane & 31)];
        { bf16_t* q = (pr ? (bf16_t*)(p.ws + W_QP) : (bf16_t*)(p.ws + W_QS)) + (size_t)lr * 1536; const int hd = lane >> 3, sub = lane & 7;
          bf16_t* qn = q + hd * 192 + sub * 16; float f[16]; unpack8(*(const u32x4*)qn, f); unpack8(*(const u32x4*)(qn + 8), f + 8);
          float ss = 0.f;
#pragma unroll
          for (int e = 0; e < 16; ++e) ss += f[e] * f[e];
          ss += __shfl_xor(ss, 1); ss += __shfl_xor(ss, 2); ss += __shfl_xor(ss, 4);
          const float rn = rsqrtf(ss * (1.f / 128.f) + EPS) * QSC;
#pragma unroll
          for (int e = 0; e < 16; ++e) f[e] *= rn * p.in[I_QNN][sub * 16 + e];
          *(u32x4*)qn = pack8(f); *(u32x4*)(qn + 8) = pack8(f + 8);
          bf16_t* qr = q + hd * 192 + 128 + sub * 4; const u32x2 a = *(const u32x2*)qr, b = *(const u32x2*)(qr + 32);
          float x1[4] = {bflo(a.x), bfhi(a.x), bflo(a.y), bfhi(a.y)}, x2[4] = {bflo(b.x), bfhi(b.x), bflo(b.y), bfhi(b.y)};
          float s2 = 0.f;
#pragma unroll
          for (int e = 0; e < 4; ++e) s2 += x1[e] * x1[e] + x2[e] * x2[e];
          s2 += __shfl_xor(s2, 1); s2 += __shfl_xor(s2, 2); s2 += __shfl_xor(s2, 4);
          const float rr = rsqrtf(s2 * (1.f / 64.f) + EPS);
          float o1[4], o2[4];
#pragma unroll
          for (int e = 0; e < 4; ++e) { const int i = sub * 4 + e; const f32x2_t t2 = rope[i]; const float cs = t2.x, sn = t2.y;
              const float y1 = x1[e] * rr * p.in[I_QRN][i], y2 = x2[e] * rr * p.in[I_QRN][32 + i]; o1[e] = (y1 * cs - y2 * sn) * QSC; o2[e] = (y2 * cs + y1 * sn) * QSC; }
          u32x2 w1, w2; w1.x = pk2(o1[0], o1[1]); w1.y = pk2(o1[2], o1[3]); w2.x = pk2(o2[0], o2[1]); w2.y = pk2(o2[2], o2[3]);
          *(u32x2*)qr = w1; *(u32x2*)(qr + 32) = w2; }
        { bf16_t* c = (pr ? (bf16_t*)(p.ws + W_CKVP) : (bf16_t*)(p.ws + W_CKVS)) + (size_t)lr * 512 + lane * 8; float f[8]; unpack8(ckv_raw, f);
          float ss = 0.f;
#pragma unroll
          for (int e = 0; e < 8; ++e) ss += f[e] * f[e];
          const float rn = rsqrtf(wave_sum(ss) * (1.f / 512.f) + EPS);
#pragma unroll
          for (int e = 0; e < 8; ++e) f[e] *= rn * p.in[I_KVN][lane * 8 + e];
          float* o = p.out + (pr ? O_CKVP : O_CKVS) + (size_t)lr * 512 + lane * 8;
          __builtin_nontemporal_store((f32x4){f[0], f[1], f[2], f[3]}, (f32x4*)o); __builtin_nontemporal_store((f32x4){f[4], f[5], f[6], f[7]}, (f32x4*)(o + 4));
          *(u32x4*)c = pack8(f); }
        { bf16_t* k = (pr ? (bf16_t*)(p.ws + W_KRP) : (bf16_t*)(p.ws + W_KRS)) + (size_t)lr * 64; const int i = lane & 31;
          const float x1 = bf2f(kr1_raw), x2 = bf2f(kr2_raw); float ss = x1 * x1 + x2 * x2;
#pragma unroll
          for (int o = 1; o < 32; o <<= 1) ss += __shfl_xor(ss, o);
          const float rr = rsqrtf(ss * (1.f / 64.f) + EPS); const f32x2_t t2 = rope[i]; const float cs = t2.x, sn = t2.y;
          const float y1 = x1 * rr * p.in[I_KRN][i], y2 = x2 * rr * p.in[I_KRN][32 + i]; const float o1 = y1 * cs - y2 * sn, o2 = y2 * cs + y1 * sn;
          float* o = p.out + (pr ? O_KRP : O_KRS) + (size_t)lr * 64;
          if (lane < 32) { o[i] = o1; o[32 + i] = o2; k[i] = f2bf(o1); k[32 + i] = f2bf(o2); } }
    }
}
__device__ __forceinline__ void e2_phase(const Params& p, bf16_t* KN, int nrows, int wid, int lane) {
    const int gw = blockIdx.x * 8 + wid, NGW = gridDim.x * 8;
    float gn[16];
#pragma unroll
    for (int e = 0; e < 16; ++e) gn[e] = p.in[I_KNN][(lane & 7) * 16 + e];
    for (int row0 = gw; row0 < nrows; row0 += 4 * NGW) {
        u32x4 a[4][2];
#pragma unroll
        for (int t = 0; t < 4; ++t) { const int row = row0 + t * NGW; if (row < nrows) { const bf16_t* k = KN + (size_t)row * 1024 + lane * 16; a[t][0] = *(const u32x4*)k; a[t][1] = *(const u32x4*)(k + 8); } }
#pragma unroll
        for (int t = 0; t < 4; ++t) { const int row = row0 + t * NGW; if (row < nrows) { bf16_t* k = KN + (size_t)row * 1024 + lane * 16; float f[16]; unpack8(a[t][0], f); unpack8(a[t][1], f + 8);
            float ss = 0.f;
#pragma unroll
            for (int e = 0; e < 16; ++e) ss += f[e] * f[e];
            ss += __shfl_xor(ss, 1); ss += __shfl_xor(ss, 2); ss += __shfl_xor(ss, 4);
            const float rn = rsqrtf(ss * (1.f / 128.f) + EPS);
#pragma unroll
            for (int e = 0; e < 16; ++e) f[e] *= rn * gn[e];
            *(u32x4*)k = pack8(f); *(u32x4*)(k + 8) = pack8(f + 8); } }
    }
}
__device__ __forceinline__ void build_sample_kv(const Params& p, int wid, int lane) {
    const int gw = blockIdx.x * 8 + wid, NGW = gridDim.x * 8;
    bf16_t* CA = (bf16_t*)(p.ws + W_CKVALL); bf16_t* KA = (bf16_t*)(p.ws + W_KRALL);
#pragma unroll 2
    for (int R = gw; R < MKS; R += NGW) { const int b = R / TKS, t = R - b * TKS;
        if (t < 2048) { const float* s = p.in[I_CCKV] + ((size_t)b * 2048 + t) * 512 + lane * 8; const f32x4 a = __builtin_nontemporal_load((const f32x4*)s), c = __builtin_nontemporal_load((const f32x4*)(s + 4));
            u32x4 w; w.x = pk2(a.x, a.y); w.y = pk2(a.z, a.w); w.z = pk2(c.x, c.y); w.w = pk2(c.z, c.w); *(u32x4*)(CA + (size_t)R * 512 + lane * 8) = w;
            KA[(size_t)R * 64 + lane] = f2bf(p.in[I_CKR][((size_t)b * 2048 + t) * 64 + lane]); }
        else { const int lr = b * 32 + t - 2048; *(u32x4*)(CA + (size_t)R * 512 + lane * 8) = *(const u32x4*)((const bf16_t*)(p.ws + W_CKVS) + (size_t)lr * 512 + lane * 8);
            KA[(size_t)R * 64 + lane] = ((const bf16_t*)(p.ws + W_KRS))[(size_t)lr * 64 + lane]; } }
}
#define MFMA32(a, b, c) __builtin_amdgcn_mfma_f32_32x32x16_bf16((a), (b), (c), 0, 0, 0)
#define MFMA16(a, b, c) __builtin_amdgcn_mfma_f32_16x16x32_bf16((a), (b), (c), 0, 0, 0)
constexpr int AT_KR = 17408, AT_KB = 26624, AT_BUF = 45056;
template <bool SAMPLE, bool DRY = false>
__device__ __forceinline__ void attn_unit(LAS unsigned char* lds, const bf16_t* Q, int ldq, const bf16_t* KN, int ldkn, const bf16_t* KR, const bf16_t* VT, int ldvt,
                                          int ntiles, int limit, bool active, bf16_t* UB, int tid, int lane, int tile0 = 0, float* part = nullptr, const float* part_other = nullptr, unsigned* cnt = nullptr) {
    const int r = lane & 31, hh = lane >> 5;
    bf16x8 qf[12];
#pragma unroll
    for (int s = 0; s < 12; ++s) qf[s] = active ? *(const bf16x8*)(Q + (size_t)r * ldq + 16 * s + 8 * hh) : (bf16x8){0, 0, 0, 0, 0, 0, 0, 0};
    f32x16 o[4];
#pragma unroll
    for (int d = 0; d < 4; ++d)
#pragma unroll
        for (int e = 0; e < 16; ++e) o[d][e] = 0.f;
    float m_run = -__builtin_inff(), l_run = 0.f;
    const int wv = __builtin_amdgcn_readfirstlane(tid >> 6);
    unsigned aoff[6];
#pragma unroll
    for (int i_ = 0; i_ < 6; ++i_) { const int ch_ = wv + 8 * i_; unsigned o_ = 0;
        if (ch_ < 17) { const int sg_ = ch_ * 64 + lane, row_ = sg_ / 17; int c_ = sg_ - row_ * 17; c_ = c_ > 15 ? 15 : c_; o_ = (unsigned)(row_ * ldkn + c_ * 8) * 2u; }
        else if (ch_ < 26) { const int sg_ = (ch_ - 17) * 64 + lane, row_ = sg_ / 9; int c_ = sg_ - row_ * 9; c_ = c_ > 7 ? 7 : c_; o_ = (unsigned)(row_ * 64 + c_ * 8) * 2u; }
        else if (ch_ < 44) { const int sg_ = (ch_ - 26) * 64 + lane, row_ = sg_ / 9; int c_ = sg_ - row_ * 9; c_ = c_ > 7 ? 7 : c_; o_ = (unsigned)(row_ * ldvt + c_ * 8) * 2u; }
        aoff[i_] = o_; }
#define AT_ISSUE(j, buf) do { LAS unsigned char* b_ = lds + (buf) * AT_BUF; const char* kn_ = (const char*)KN + (size_t)(j) * 128 * ldkn; const char* kr_ = (const char*)KR + (size_t)(j) * 8192; const char* vt_ = (const char*)VT + (size_t)(j) * 128; \
        _Pragma("unroll") for (int i_ = 0; i_ < 6; ++i_) { const int ch_ = wv + 8 * i_; unsigned o_ = aoff[i_]; asm volatile("" : "+v"(o_)); \
        if (ch_ < 17) __builtin_amdgcn_global_load_lds((const unsigned*)(kn_ + o_), (LAS unsigned*)(b_ + ch_ * 1024), 16, 0, 0); \
        else if (ch_ < 26) __builtin_amdgcn_global_load_lds((const unsigned*)(kr_ + o_), (LAS unsigned*)(b_ + AT_KR + (ch_ - 17) * 1024), 16, 0, 0); \
        else if (ch_ < 44) __builtin_amdgcn_global_load_lds((const unsigned*)(vt_ + o_), (LAS unsigned*)(b_ + AT_KB + (ch_ - 26) * 1024), 16, 0, 0); } } while (0)
    AT_ISSUE(tile0, 0); __syncthreads();
    for (int jj = 0; jj < ntiles; ++jj) { const int j = tile0 + jj;
        const bool more = (jj + 1 < ntiles);
        if (more) AT_ISSUE(j + 1, (jj + 1) & 1);
        if (active && j <= limit) {
            const LAS unsigned char* kb = lds + (jj & 1) * AT_BUF; const LAS unsigned char* vb = kb + AT_KB;
            f32x16 s0, s1;
#pragma unroll
            for (int e = 0; e < 16; ++e) { s0[e] = 0.f; s1[e] = 0.f; }
            __builtin_amdgcn_s_setprio(1);
#pragma unroll
            for (int s = 0; s < 12; ++s) { const LAS unsigned char* ka = s < 8 ? kb + r * 272 + s * 32 + hh * 16 : kb + AT_KR + r * 144 + (s - 8) * 32 + hh * 16; const int rs32 = s < 8 ? 32 * 272 : 32 * 144;
                const bf16x8 a0 = *(const LAS bf16x8*)ka, a1 = *(const LAS bf16x8*)(ka + rs32);
                s0 = MFMA32(a0, qf[s], s0); s1 = MFMA32(a1, qf[s], s1); if (s == 5) __builtin_amdgcn_sched_barrier(0); }
            __builtin_amdgcn_s_setprio(0);
            if (SAMPLE && j == 32) {
#pragma unroll
                for (int e = 0; e < 16; ++e) s1[e] = -__builtin_inff(); }
            float mx = s0[0];
#pragma unroll
            for (int e = 1; e < 16; ++e) mx = fmaxf(mx, s0[e]);
#pragma unroll
            for (int e = 0; e < 16; ++e) mx = fmaxf(mx, s1[e]);
            mx = fmaxf(mx, __shfl_xor(mx, 32));
            const float mn = fmaxf(m_run, mx), alpha = __builtin_amdgcn_exp2f(m_run - mn); m_run = mn;
            float ps = 0.f;
#pragma unroll
            for (int e = 0; e < 16; ++e) { s0[e] = __builtin_amdgcn_exp2f(s0[e] - mn); s1[e] = __builtin_amdgcn_exp2f(s1[e] - mn); ps += s0[e] + s1[e]; }
            l_run = l_run * alpha + ps;
            if (__builtin_amdgcn_ballot_w64(alpha != 1.f) != 0ull) {
#pragma unroll
            for (int d = 0; d < 4; ++d)
#pragma unroll
                for (int e = 0; e < 16; ++e) o[d][e] *= alpha; }
            bf16x8 pf[4];
#pragma unroll
            for (int sp = 0; sp < 4; ++sp) { const int hf = sp & 1; u32x4 w;
                if (sp < 2) { w.x = pk2(s0[8 * hf + 0], s0[8 * hf + 1]); w.y = pk2(s0[8 * hf + 2], s0[8 * hf + 3]); w.z = pk2(s0[8 * hf + 4], s0[8 * hf + 5]); w.w = pk2(s0[8 * hf + 6], s0[8 * hf + 7]); }
                else        { w.x = pk2(s1[8 * hf + 0], s1[8 * hf + 1]); w.y = pk2(s1[8 * hf + 2], s1[8 * hf + 3]); w.z = pk2(s1[8 * hf + 4], s1[8 * hf + 5]); w.w = pk2(s1[8 * hf + 6], s1[8 * hf + 7]); }
                pf[sp] = __builtin_bit_cast(bf16x8, w); }
            __builtin_amdgcn_s_setprio(1);
#pragma unroll
            for (int sp = 0; sp < 4; ++sp) { __builtin_amdgcn_sched_barrier(0);
#pragma unroll
                for (int d = 0; d < 4; ++d) { const LAS unsigned char* va = vb + (32 * d + r) * 144 + (16 * sp + 4 * (hh ^ ((r >> 4) & 1))) * 2;
                    const u32x2 lo = *(const LAS u32x2*)va, hi = *(const LAS u32x2*)(va + 16); const u32x4 w = {lo.x, lo.y, hi.x, hi.y};
                    o[d] = MFMA32(__builtin_bit_cast(bf16x8, w), pf[sp], o[d]); } }
            __builtin_amdgcn_s_setprio(0);
        }
        __syncthreads();
    }
#undef AT_ISSUE
    bool fin = active && !(DRY && l_run >= 0.f); float lt = l_run + __shfl_xor(l_run, 32);
    if (SAMPLE && active) {
#pragma unroll
        for (int d = 0; d < 4; ++d)
#pragma unroll
            for (int e = 0; e < 16; ++e) part[(d * 16 + e) * 64 + lane] = o[d][e];
        part[4096 + lane] = m_run; part[4160 + lane] = lt;
        asm volatile("s_waitcnt vmcnt(0)" ::: "memory");
        __threadfence();
        unsigned old = 0u; if (lane == 0) old = atomicAdd(cnt, 1u);
        old = (unsigned)__builtin_amdgcn_readfirstlane((int)old);
        fin = (old == 1u);
        if (fin) { __threadfence();
            const float m2 = __builtin_nontemporal_load(part_other + 4096 + lane), l2 = __builtin_nontemporal_load(part_other + 4160 + lane);
            const float mm = fmaxf(m_run, m2), a1 = __builtin_amdgcn_exp2f(m_run - mm), a2 = __builtin_amdgcn_exp2f(m2 - mm); lt = lt * a1 + l2 * a2;
#pragma unroll
            for (int d = 0; d < 4; ++d)
#pragma unroll
                for (int e = 0; e < 16; ++e) o[d][e] = o[d][e] * a1 + __builtin_nontemporal_load(part_other + (d * 16 + e) * 64 + lane) * a2; }
    }
    if (fin) {
        const float inv = 1.f / lt;
        int r2 = r, h2 = hh; asm volatile("" : "+v"(r2), "+v"(h2));
        char* ub = (char*)UB;
#pragma unroll
        for (int d = 0; d < 4; ++d)
#pragma unroll
            for (int g4 = 0; g4 < 4; ++g4) { bf16_t* up = (bf16_t*)(ub + (unsigned)(r2 * 1024 + 32 * d + 8 * g4 + 4 * h2) * 2u); const u32x2 z = *(const u32x2*)up;
                const float z0 = bflo(z.x), z1 = bfhi(z.x), z2 = bflo(z.y), z3 = bfhi(z.y);
                u32x2 w; w.x = pk2(o[d][4 * g4 + 0] * inv * siluf_(z0), o[d][4 * g4 + 1] * inv * siluf_(z1)); w.y = pk2(o[d][4 * g4 + 2] * inv * siluf_(z2), o[d][4 * g4 + 3] * inv * siluf_(z3));
                *(u32x2*)up = w; }
    }
}
template <bool DRY>
__device__ __forceinline__ void attn_prompt_phase(const Params& p, LAS unsigned char* lds, int tid, int wid, int lane) {
    const int G = gridDim.x, bx = blockIdx.x; const int vcu = (G % 8 == 0) ? (bx % 8) * (G / 8) + bx / 8 : bx;
    for (int item = vcu; item < 512; item += G) {
        const int pr = item & 255, bh = pr >> 4, pi = pr & 15, qb = item < 256 ? 31 - pi : pi, b = bh >> 3, h = bh & 7;
        const size_t tok0 = (size_t)b * 8192; const int q0 = qb * 256 + wid * 32;
        attn_unit<false, DRY>(lds, (const bf16_t*)(p.ws + W_QP) + (tok0 + q0) * 1536 + h * 192, 1536, (const bf16_t*)(p.ws + W_KN) + tok0 * 1024 + h * 128, 1024,
                         (const bf16_t*)(p.ws + W_KRP) + tok0 * 64, (const bf16_t*)(p.ws + W_VT) + (size_t)(h * 128) * MP + tok0, MP,
                         4 * qb + 4, 4 * qb + (wid >> 1), true, (bf16_t*)(p.ws + W_UBP) + (tok0 + q0) * 1024 + h * 128, tid, lane);
    }
}
__device__ __forceinline__ void attn_sample_phase(const Params& p, LAS unsigned char* lds, int tid, int wid, int lane) {
    const int G = gridDim.x, bx = blockIdx.x; const int vcu = (G % 8 == 0) ? (bx % 8) * (G / 8) + bx / 8 : bx;
    for (int item = vcu; item < 256; item += G) { const int bh = item >> 1, half = item & 1, b = bh >> 3, h = bh & 7; const size_t tok0 = (size_t)b * TKS;
        float* part = (float*)(p.ws + W_PART) + (size_t)item * 4224;
        attn_unit<true>(lds, (const bf16_t*)(p.ws + W_QS) + (size_t)(b * 32) * 1536 + h * 192, 1536, (const bf16_t*)(p.ws + W_KNS) + tok0 * 1024 + h * 128, 1024,
                        (const bf16_t*)(p.ws + W_KRALL) + tok0 * 64, (const bf16_t*)(p.ws + W_VTS) + (size_t)(h * 128) * MKS + tok0, MKS,
                        half ? 16 : 17, 33, wid == 0, (bf16_t*)(p.ws + W_UBS) + (size_t)(b * 32) * 1024 + h * 128, tid, lane,
                        half ? 17 : 0, part, (const float*)(p.ws + W_PART) + (size_t)(item ^ 1) * 4224, (unsigned*)(p.ws + W_CNT) + bh);
    }
}
constexpr int PR_KH = 0, PR_QH = 17408, PR_KT = 34816, PR_KT0 = 53248, PR_VT0 = 71680, PR_LM = 90112, PR_TB = 107520, PR_TBE = 116736, PR_AT = 125952, PR_VEC = 134144, PR_TL = 135168;
constexpr int PR_XT = 151552, PR_WC = 154624;
__device__ __forceinline__ void prep_conv(const LAS float* wl, float (&acc)[16], const u32x4 (&raw)[4][2], int col0) {
#pragma unroll
    for (int e = 0; e < 16; ++e) acc[e] = 0.f;
#pragma unroll
    for (int i = 0; i < 4; ++i) { float x[16]; unpack8(raw[i][0], x); unpack8(raw[i][1], x + 8);
        const LAS float* wc = wl + i * 384 + col0;
#pragma unroll
        for (int e = 0; e < 4; ++e) { const f32x4 w = *(const LAS f32x4*)(wc + 4 * e); acc[4 * e] += x[4 * e] * w.x; acc[4 * e + 1] += x[4 * e + 1] * w.y; acc[4 * e + 2] += x[4 * e + 2] * w.z; acc[4 * e + 3] += x[4 * e + 3] * w.w; } }
#pragma unroll
    for (int e = 0; e < 16; ++e) acc[e] = siluf_(acc[e]);
}
template <bool DRY>
__device__ __forceinline__ void prep_unit(const Params& p, LAS unsigned char* lds, int u, int tid0, int wid, int lane0, u32x4 (&raw)[3][4][2], float (&pre)[5], bool have, int unext) {
    const bool smp = u >= 2048; int b, h, n;
    if (!smp) { b = u >> 10; h = (u >> 7) & 7; n = u & 127; } else { b = (u - 2048) >> 3; h = (u - 2048) & 7; n = 0; }
    const size_t grow0 = smp ? (size_t)MP + b * 32 : (size_t)b * 8192 + n * 64;
    bf16_t* QKV = (bf16_t*)(p.ws + W_QKV); const bf16_t* HALO = (const bf16_t*)(p.ws + W_HALO);
    int tid = tid0, lane = lane0; asm volatile("" : "+v"(tid), "+v"(lane));
    int row = tid >> 3, cg = tid & 7; const bool valid = !smp || row < 32;
    { LAS float* wl_ = (LAS float*)(lds + PR_WC);
#pragma unroll
      for (int i_ = 0; i_ < 3; ++i_) { const int e_ = tid + 512 * i_, tap_ = e_ / 384, cc_ = e_ - tap_ * 384, part_ = cc_ >> 7; wl_[e_] = have ? pre[i_] : p.in[I_WCONV][(size_t)tap_ * 3072 + part_ * 1024 + h * 128 + (cc_ & 127)]; } }
#define PREP_STAGE(P0_, P1_, smp_, valid_, b_, h_, n_, grow0_) _Pragma("unroll") for (int part = P0_; part < P1_; ++part) { \
        const char* qb_ = (const char*)(QKV + (grow0_) * 3072 + part * 1024 + (h_) * 128); const char* hb_ = (const char*)(HALO + ((size_t)((b_) * 128 + (n_) - 1) * 3) * 3072 + part * 1024 + (h_) * 128); \
        const char* sb_ = (const char*)(p.in[I_SC] + ((size_t)(b_) * 3) * 3072 + part * 1024 + (h_) * 128); \
        _Pragma("unroll") for (int i = 0; i < 4; ++i) { const int tt = row - 3 + i; raw[part][i][0] = (u32x4){0u, 0u, 0u, 0u}; raw[part][i][1] = raw[part][i][0]; \
            if (valid_) { \
                if (tt >= 0) { const unsigned off_ = (unsigned)(tt * 3072 + cg * 16) * 2u; raw[part][i][0] = *(const u32x4*)(qb_ + off_); raw[part][i][1] = *(const u32x4*)(qb_ + off_ + 16); } \
                else if (!(smp_) && (n_) > 0) { const unsigned off_ = (unsigned)((tt + 3) * 3072 + cg * 16) * 2u; raw[part][i][0] = *(const u32x4*)(hb_ + off_); raw[part][i][1] = *(const u32x4*)(hb_ + off_ + 16); } \
                else if (smp_) { const unsigned off_ = (unsigned)((tt + 3) * 3072 + cg * 16) * 4u; float x[16]; \
                    _Pragma("unroll") for (int e = 0; e < 4; ++e) { const f32x4 v = *(const f32x4*)(sb_ + off_ + 16 * e); x[4 * e] = v.x; x[4 * e + 1] = v.y; x[4 * e + 2] = v.z; x[4 * e + 3] = v.w; } \
                    raw[part][i][0] = pack8(x); raw[part][i][1] = pack8(x + 8); } \
            } } }
    if (!have) { PREP_STAGE(0, 3, smp, valid, b, h, n, grow0) }
    LAS float* gv = (LAS float*)(lds + PR_VEC); LAS float* betav = gv + 64; LAS float* gcv = gv + 128;
    if (wid == 0) { float g = 0.f, bt = 0.f;
        if (!smp || lane < 32) { const float* ba = (const float*)(p.ws + W_BA) + (grow0 + lane) * 16; const float ba0 = have ? pre[3] : ba[h], ba1 = have ? pre[4] : ba[8 + h]; bt = sigmoidf_(ba0); const float xx = ba1 + p.in[I_DTB][h];
            const float sp = xx > 20.f ? xx : log1pf(__expf(xx)); g = -__expf(p.in[I_ALOG][h]) * sp; }
        betav[lane] = bt; float c = g;
#pragma unroll
        for (int o = 1; o < 64; o <<= 1) { const float t = __shfl_up(c, o); if (lane >= o) c += t; }
        gcv[lane] = c; }
    asm volatile("s_waitcnt vmcnt(0)" ::: "memory");
    __syncthreads();
    __builtin_amdgcn_sched_barrier(0);
    asm volatile("" : "+v"(row), "+v"(cg));
    if (!DRY) { float* o = nullptr;
        if (!smp && n == 127 && row >= 61) o = p.out + O_CVP + ((size_t)b * 3 + (row - 61)) * 3072;
        if (smp && row >= 29 && row < 32) o = p.out + O_CVS + ((size_t)b * 3 + (row - 29)) * 3072;
        if (o) {
#pragma unroll
            for (int part = 0; part < 3; ++part) { float x[16]; unpack8(raw[part][3][0], x); unpack8(raw[part][3][1], x + 8); float* op = o + part * 1024 + h * 128 + cg * 16;
#pragma unroll
                for (int e = 0; e < 4; ++e) *(f32x4*)(op + 4 * e) = (f32x4){x[4 * e], x[4 * e + 1], x[4 * e + 2], x[4 * e + 3]}; } } }
    const float gc = gcv[row], eg = __expf(gc), ed = __expf(gcv[63] - gc);
    const int pcol = (((row >> 3) ^ cg) << 3) | (row & 7);
    bf16_t* dq; if (!smp) dq = (bf16_t*)((char*)(QKV + grow0 * 3072 + h * 128) + (unsigned)(row * 3072 + cg * 16) * 2u); else dq = (bf16_t*)((char*)((bf16_t*)(p.ws + W_SQKV) + (size_t)(u - 2048) * 3 * 8192) + (unsigned)(row * 128 + cg * 16) * 2u);
    LAS bf16_t* KH = (LAS bf16_t*)(lds + PR_KH); LAS bf16_t* QH = (LAS bf16_t*)(lds + PR_QH); LAS bf16_t* KT = (LAS bf16_t*)(lds + PR_KT); LAS bf16_t* KT0 = (LAS bf16_t*)(lds + PR_KT0); LAS bf16_t* VT0 = (LAS bf16_t*)(lds + PR_VT0);
    {   float a[16]; prep_conv((const LAS float*)(lds + PR_WC), a, raw[0], cg * 16);
        float sq = 0.f;
#pragma unroll
        for (int e = 0; e < 16; ++e) sq += a[e] * a[e];
        sq += __shfl_xor(sq, 1); sq += __shfl_xor(sq, 2); sq += __shfl_xor(sq, 4);
        const float rq = rsqrtf(sq + EPS) * 0.08838834764831845f;
#pragma unroll
        for (int e = 0; e < 16; ++e) a[e] *= rq;
        *(LAS u32x4*)(QH + row * 136 + cg * 16) = pack8(a); *(LAS u32x4*)(QH + row * 136 + cg * 16 + 8) = pack8(a + 8);
#pragma unroll
        for (int e = 0; e < 16; ++e) a[e] *= eg;
        if (!DRY) { *(u32x4*)dq = pack8(a); *(u32x4*)(dq + 8) = pack8(a + 8); } }
    __builtin_amdgcn_sched_barrier(0);
    {   float a[16]; prep_conv((const LAS float*)(lds + PR_WC), a, raw[1], 128 + cg * 16);
        float sk = 0.f;
#pragma unroll
        for (int e = 0; e < 16; ++e) sk += a[e] * a[e];
        sk += __shfl_xor(sk, 1); sk += __shfl_xor(sk, 2); sk += __shfl_xor(sk, 4);
        const float rk = rsqrtf(sk + EPS);
#pragma unroll
        for (int e = 0; e < 16; ++e) a[e] *= rk;
        *(LAS u32x4*)(KH + row * 136 + cg * 16) = pack8(a); *(LAS u32x4*)(KH + row * 136 + cg * 16 + 8) = pack8(a + 8);
#pragma unroll
        for (int e = 0; e < 16; ++e) { KT[(cg * 16 + e) * 72 + pcol] = f2bf(a[e] * ed); KT0[(cg * 16 + e) * 72 + pcol] = f2bf(a[e]); } }
    __builtin_amdgcn_sched_barrier(0);
    {   float a[16]; prep_conv((const LAS float*)(lds + PR_WC), a, raw[2], 256 + cg * 16);
#pragma unroll
        for (int e = 0; e < 16; ++e) VT0[(cg * 16 + e) * 72 + pcol] = f2bf(a[e]); }
    __syncthreads();
    if (unext >= 0) { const int b2 = unext >> 10, h2 = (unext >> 7) & 7, n2 = unext & 127; const size_t g2 = (size_t)b2 * 8192 + n2 * 64; asm volatile("" : "+v"(row), "+v"(cg));
        PREP_STAGE(0, 3, false, true, b2, h2, n2, g2)
#pragma unroll
        for (int i_ = 0; i_ < 3; ++i_) { const int e_ = tid + 512 * i_, tap_ = e_ / 384, cc_ = e_ - tap_ * 384, part_ = cc_ >> 7; pre[i_] = p.in[I_WCONV][(size_t)tap_ * 3072 + part_ * 1024 + h2 * 128 + (cc_ & 127)]; }
        { const float* ba2 = (const float*)(p.ws + W_BA) + (g2 + (size_t)(lane & 63)) * 16; pre[3] = ba2[h2]; pre[4] = ba2[8 + h2]; } }
#undef PREP_STAGE
    asm volatile("" : "+v"(tid), "+v"(lane));
    {
        const LAS unsigned char* KHb = lds + PR_KH; const LAS unsigned char* QHb = lds + PR_QH; const int c = lane & 15, g = lane >> 4, mi = wid >> 1;
        f32x4 kk[2], qk[2];
#pragma unroll
        for (int j = 0; j < 2; ++j) { kk[j] = (f32x4){0.f, 0.f, 0.f, 0.f}; qk[j] = kk[j]; }
#pragma unroll
        for (int s = 0; s < 4; ++s) { const bf16x8 aK = *(const LAS bf16x8*)(KHb + (16 * mi + c) * 272 + (32 * s + 8 * g) * 2), aQ = *(const LAS bf16x8*)(QHb + (16 * mi + c) * 272 + (32 * s + 8 * g) * 2);
#pragma unroll
            for (int j = 0; j < 2; ++j) { const int nj = 2 * (wid & 1) + j; const bf16x8 bK = *(const LAS bf16x8*)(KHb + (16 * nj + c) * 272 + (32 * s + 8 * g) * 2);
                kk[j] = MFMA16(aK, bK, kk[j]); qk[j] = MFMA16(aQ, bK, qk[j]); } }
        LAS float* LM = (LAS float*)(lds + PR_LM); LAS bf16_t* ATs = (LAS bf16_t*)(lds + PR_AT);
#pragma unroll
        for (int j = 0; j < 2; ++j) { const int cj = 16 * (2 * (wid & 1) + j) + c; const float gj = gcv[cj];
#pragma unroll
            for (int e = 0; e < 4; ++e) { const int ri = 16 * mi + 4 * g + e; const float dec = (cj <= ri) ? __expf(gcv[ri] - gj) : 0.f;
                LM[ri * 68 + cj] = (cj < ri) ? betav[ri] * kk[j][e] * dec : 0.f; ATs[ri * 64 + cj] = f2bf(qk[j][e] * dec); } }
    }
    __syncthreads();
    asm volatile("" : "+v"(tid), "+v"(lane));
    {
        const LAS float* LM = (const LAS float*)(lds + PR_LM); LAS float* TL = (LAS float*)(lds + PR_TL); LAS float* XT = (LAS float*)(lds + PR_XT);
        LAS bf16_t* TBs = (LAS bf16_t*)(lds + PR_TB); LAS bf16_t* TBe = (LAS bf16_t*)(lds + PR_TBE);
        if (wid == 0) { const int blk = lane >> 4, col = lane & 15; float x[16];
#pragma unroll
            for (int r = 0; r < 16; ++r) { float a = (r == col) ? 1.f : 0.f;
#pragma unroll
                for (int k = 0; k < r; ++k) a -= LM[(16 * blk + r) * 68 + 16 * blk + k] * x[k];
                x[r] = a; TL[(16 * blk + r) * 64 + 16 * blk + col] = a; } }
        __syncthreads();
        for (int i = 1; i < 4; ++i) {
            for (int e = tid; e < i * 256; e += 512) { const int j = e >> 8, r = (e >> 4) & 15, c = e & 15; float a0 = 0.f, a1 = 0.f, a2 = 0.f, a3 = 0.f;
                for (int kb = j; kb < i; ++kb) { const LAS float* lp = LM + (16 * i + r) * 68 + 16 * kb; const LAS float* tp = TL + (16 * kb) * 64 + 16 * j + c;
#pragma unroll
                    for (int k4 = 0; k4 < 4; ++k4) { const f32x4 l4 = *(const LAS f32x4*)(lp + 4 * k4);
                        a0 += l4.x * tp[(4 * k4 + 0) * 64]; a1 += l4.y * tp[(4 * k4 + 1) * 64]; a2 += l4.z * tp[(4 * k4 + 2) * 64]; a3 += l4.w * tp[(4 * k4 + 3) * 64]; } }
                XT[e] = (a0 + a1) + (a2 + a3); }
            __syncthreads();
            for (int e = tid; e < i * 256; e += 512) { const int j = e >> 8, r = (e >> 4) & 15, c = e & 15; float a0 = 0.f, a1 = 0.f; const LAS float* dp = TL + (16 * i + r) * 64 + 16 * i; const LAS float* xp = XT + (j << 8) + c;
#pragma unroll
                for (int k4 = 0; k4 < 4; ++k4) { const f32x4 d4 = *(const LAS f32x4*)(dp + 4 * k4);
                    a0 += d4.x * xp[(4 * k4 + 0) * 16] + d4.z * xp[(4 * k4 + 2) * 16]; a1 += d4.y * xp[(4 * k4 + 1) * 16] + d4.w * xp[(4 * k4 + 3) * 16]; }
                TL[(16 * i + r) * 64 + 16 * j + c] = -(a0 + a1); }
            __syncthreads();
        }
#pragma unroll
        for (int i = 0; i < 8; ++i) { const int e = tid + 512 * i, ri = e >> 6, cj = e & 63; const float t = ((cj >> 4) > (ri >> 4)) ? 0.f : TL[e] * betav[cj]; TBs[ri * 72 + cj] = f2bf(t); TBe[ri * 72 + cj] = f2bf(t * __expf(gcv[cj])); }
    }
    __syncthreads();
    asm volatile("" : "+v"(tid), "+v"(lane));
    {
        const int c = lane & 15, g = lane >> 4;
        f32x4 aw[4], au[4];
#pragma unroll
        for (int mb = 0; mb < 4; ++mb) { aw[mb] = (f32x4){0.f, 0.f, 0.f, 0.f}; au[mb] = aw[mb]; }
#pragma unroll
        for (int s = 0; s < 2; ++s) { const bf16x8 bk = *(const LAS bf16x8*)(lds + PR_KT0 + (16 * wid + c) * 144 + (((4 * s + g) ^ wid) << 4)), bv = *(const LAS bf16x8*)(lds + PR_VT0 + (16 * wid + c) * 144 + (((4 * s + g) ^ wid) << 4));
#pragma unroll
            for (int mb = 0; mb < 4; ++mb) { aw[mb] = MFMA16(*(const LAS bf16x8*)(lds + PR_TBE + (16 * mb + c) * 144 + (32 * s + 8 * g) * 2), bk, aw[mb]);
                au[mb] = MFMA16(*(const LAS bf16x8*)(lds + PR_TB + (16 * mb + c) * 144 + (32 * s + 8 * g) * 2), bv, au[mb]); } }
        char* wb = smp ? (char*)((bf16_t*)(p.ws + W_SQKV) + (size_t)(u - 2048) * 3 * 8192 + 8192 + 16 * wid) : (char*)(QKV + grow0 * 3072 + 1024 + h * 128 + 16 * wid);
        const unsigned rs = smp ? 128u : 3072u, us = smp ? 8192u * 2u : 1024u * 2u;
#pragma unroll
        for (int mb = 0; mb < 4; ++mb)
#pragma unroll
            for (int e = 0; e < 4; ++e) { const unsigned off = ((unsigned)(16 * mb + 4 * g + e) * rs + (unsigned)c) * 2u; if (!DRY || aw[mb][e] == 123456.f) { *(bf16_t*)(wb + off) = f2bf(aw[mb][e]); *(bf16_t*)(wb + us + off) = f2bf(au[mb][e]); } }
    }
    asm volatile("" : "+v"(tid), "+v"(lane));
    if (!DRY) {   bf16_t* KDT = (bf16_t*)(p.ws + W_KDT) + (size_t)u * 8192; bf16_t* ATG = (bf16_t*)(p.ws + W_TB) + (size_t)u * 4096;
#pragma unroll
        for (int i = 0; i < 2; ++i) { const int pc = tid + 512 * i, r = pc >> 3, c = pc & 7; *(u32x4*)(KDT + r * 64 + c * 8) = *(const LAS u32x4*)(lds + PR_KT + r * 144 + ((c ^ ((r >> 4) & 7)) << 4)); }
        { const int r = tid >> 3, c = tid & 7; *(u32x4*)(ATG + r * 64 + c * 8) = *(const LAS u32x4*)(lds + PR_AT + r * 128 + c * 16); }
        if (tid == 0) ((float*)(p.ws + W_GL))[u] = __expf(gcv[63]);
    }
    __syncthreads();
}
constexpr int SC_QG = 0, SC_W = 17408, SC_KD = 34816, SC_AT = 53248, SC_U = 62464, SC_Z = 78848, SC_WV = 95232, SC_WVB = 6656, SC_EX = 148480;
constexpr int NSEG = 8, SEGLEN = 16;
template <int mode>
__device__ __forceinline__ void scan_chain(const Params& p, LAS unsigned char* lds, int bh, int seg, int tid, int wid, int lane) {
    constexpr bool smp = mode == 3, emit = mode >= 2; const int b = bh >> 3, h = bh & 7; const int nsteps = smp ? 1 : SEGLEN;
    asm volatile("" : "+v"(tid), "+v"(lane));
    const int c = lane & 15, g = lane >> 4;
    LAS unsigned char* ST = lds + SC_WV + wid * SC_WVB; LAS unsigned char* RT = ST + 4352; LAS float* EX = (LAS float*)(lds + SC_EX);
    float* MB = (float*)(p.ws + W_MB);
    f32x4 S[8];
#pragma unroll
    for (int mb = 0; mb < 8; ++mb) S[mb] = (f32x4){0.f, 0.f, 0.f, 0.f};
    if (smp) { const char* sd = (const char*)(p.in[I_SD] + ((size_t)bh * 128) * 128 + 16 * wid);
#pragma unroll
        for (int mb = 0; mb < 8; ++mb)
#pragma unroll
            for (int e = 0; e < 4; ++e) S[mb][e] = *(const float*)(sd + (unsigned)((16 * mb + 4 * g + e) * 128 + c) * 4u); }
    if (mode == 1) {
#pragma unroll
        for (int mb = 0; mb < 8; ++mb)
#pragma unroll
            for (int e = 0; e < 4; ++e) S[mb][e] = (16 * mb + 4 * g + e == 16 * wid + c) ? 1.f : 0.f; }
    if (mode == 2) {
        for (int j = 0; j < seg; ++j) { const float* Mj = MB + (size_t)(bh * NSEG + j) * 2 * 16384; const float* Bj = Mj + 16384;
            __syncthreads();
#pragma unroll 2
            for (int i = 0; i < 8; ++i) { const int pc = tid + 512 * i, r = pc >> 5, cc = pc & 31; const f32x4 v = *(const f32x4*)(Mj + r * 128 + cc * 4); u32x2 w; w.x = pk2(v.x, v.y); w.y = pk2(v.z, v.w); *(LAS u32x2*)(lds + r * 272 + cc * 8) = w; }
#pragma unroll
            for (int mb = 0; mb < 8; ++mb) { u32x2 w; w.x = pk2(S[mb][0], S[mb][1]); w.y = pk2(S[mb][2], S[mb][3]); *(LAS u32x2*)(ST + c * 272 + (16 * mb + 4 * g) * 2) = w; }
            __syncthreads();
            { const char* bj = (const char*)(Bj + 16 * wid);
#pragma unroll
              for (int mb = 0; mb < 8; ++mb)
#pragma unroll
                for (int e = 0; e < 4; ++e) S[mb][e] = *(const float*)(bj + (unsigned)((16 * mb + 4 * g + e) * 128 + c) * 4u); }
#pragma unroll
            for (int s = 0; s < 4; ++s) { const bf16x8 bS = *(const LAS bf16x8*)(ST + c * 272 + (32 * s + 8 * g) * 2);
#pragma unroll
                for (int mb = 0; mb < 8; ++mb) S[mb] = MFMA16(*(const LAS bf16x8*)(lds + (16 * mb + c) * 272 + (32 * s + 8 * g) * 2), bS, S[mb]); }
        }
    }
    const int u0 = smp ? 2048 + bh : bh * 128 + seg * SEGLEN;
    const bf16_t* qb0; unsigned rstride; size_t ustride;
    if (!smp) { qb0 = (const bf16_t*)(p.ws + W_QKV) + ((size_t)b * 8192 + (size_t)seg * SEGLEN * 64) * 3072 + h * 128; rstride = 3072; ustride = (size_t)64 * 3072; }
    else { qb0 = (const bf16_t*)(p.ws + W_SQKV) + (size_t)bh * 3 * 8192; rstride = 128; ustride = 0; }
    const size_t koff = smp ? 8192 : 1024, voff = smp ? 16384 : 2048;
    const bf16_t* KDT = (const bf16_t*)(p.ws + W_KDT) + (size_t)u0 * 8192; const bf16_t* ATG = (const bf16_t*)(p.ws + W_TB) + (size_t)u0 * 4096; const float* GLp = (const float*)(p.ws + W_GL) + u0;
    bf16_t* zb0 = smp ? (bf16_t*)(p.ws + W_UAS) + (size_t)(b * 32) * 1024 + h * 128 : (bf16_t*)(p.ws + W_UAP) + ((size_t)b * 8192 + (size_t)seg * SEGLEN * 64) * 1024 + h * 128;
    const int zrows = smp ? 32 : 64;
    u32x4 rq[2], rk[2], rv[2], rd[2], ra, rz[2]; float gl_next;
    const unsigned oq0 = (unsigned)((tid >> 4) * rstride + (tid & 15) * 8) * 2u, oq1 = (unsigned)(((tid + 512) >> 4) * rstride + (tid & 15) * 8) * 2u, od0 = (unsigned)tid * 16u, od1 = (unsigned)(tid + 512) * 16u;
    const unsigned oz0 = (unsigned)((tid >> 4) * 1024 + (tid & 15) * 8) * 2u, oz1 = (unsigned)(((tid + 512) >> 4) * 1024 + (tid & 15) * 8) * 2u;
#define SC_ISSUE(st) do { const char* qb_ = (const char*)(qb0 + (size_t)(st) * ustride); const char* kb_ = qb_ + koff * 2; const char* vb_ = qb_ + voff * 2; const char* db_ = (const char*)(KDT + (size_t)(st) * 8192); const char* tb_ = (const char*)(ATG + (size_t)(st) * 4096); \
        rq[0] = *(const u32x4*)(qb_ + oq0); rq[1] = *(const u32x4*)(qb_ + oq1); rk[0] = *(const u32x4*)(kb_ + oq0); rk[1] = *(const u32x4*)(kb_ + oq1); rv[0] = *(const u32x4*)(vb_ + oq0); rv[1] = *(const u32x4*)(vb_ + oq1); \
        rd[0] = *(const u32x4*)(db_ + od0); rd[1] = *(const u32x4*)(db_ + od1); ra = *(const u32x4*)(tb_ + od0); gl_next = GLp[st]; \
        if (emit) { const char* z_ = (const char*)(zb0 + (size_t)(st) * 64 * 1024); rz[0] = *(const u32x4*)(z_ + oz0); if ((tid >> 4) + 32 < zrows) rz[1] = *(const u32x4*)(z_ + oz1); } } while (0)
#define SC_WRITE() do { _Pragma("unroll") for (int i_ = 0; i_ < 2; ++i_) { const int pc_ = tid + 512 * i_, r_ = pc_ >> 4, c_ = pc_ & 15; *(LAS u32x4*)(lds + SC_QG + r_ * 272 + c_ * 16) = rq[i_]; *(LAS u32x4*)(lds + SC_W + r_ * 272 + c_ * 16) = rk[i_]; \
            *(LAS u32x4*)(lds + SC_U + r_ * 256 + c_ * 16) = rv[i_]; if (emit) *(LAS u32x4*)(lds + SC_Z + r_ * 256 + c_ * 16) = rz[i_]; const int r2_ = pc_ >> 3, c2_ = pc_ & 7; *(LAS u32x4*)(lds + SC_KD + r2_ * 144 + c2_ * 16) = rd[i_]; } \
        { const int r_ = tid >> 3, c_ = tid & 7; *(LAS u32x4*)(lds + SC_AT + r_ * 144 + c_ * 16) = ra; } } while (0)
#define SC_FLUSH(st_) do { char* z_ = (char*)(zb0 + (size_t)(st_) * 64 * 1024); *(u32x4*)(z_ + oz0) = *(const LAS u32x4*)(lds + SC_Z + (tid >> 4) * 256 + (tid & 15) * 16); \
        if ((tid >> 4) + 32 < zrows) *(u32x4*)(z_ + oz1) = *(const LAS u32x4*)(lds + SC_Z + ((tid >> 4) + 32) * 256 + (tid & 15) * 16); } while (0)
    const float gain = p.in[I_DNN][16 * wid + c];
    rz[0] = (u32x4){0u, 0u, 0u, 0u}; rz[1] = rz[0];
    SC_ISSUE(0);
    for (int st = 0; st < nsteps; ++st) {
        __syncthreads();
        if (emit && st > 0) SC_FLUSH(st - 1);
        SC_WRITE(); const float gl = gl_next; if (emit && tid < 64) EX[tid] = 0.f;
        __syncthreads();
        if (st + 1 < nsteps) SC_ISSUE(st + 1);
#pragma unroll
        for (int mb = 0; mb < 8; ++mb) { u32x2 w; w.x = pk2(S[mb][0], S[mb][1]); w.y = pk2(S[mb][2], S[mb][3]); *(LAS u32x2*)(ST + c * 272 + (16 * mb + 4 * g) * 2) = w; }
        f32x4 aK[4];
#pragma unroll
        for (int mb = 0; mb < 4; ++mb) aK[mb] = (f32x4){0.f, 0.f, 0.f, 0.f};
#pragma unroll
        for (int s = 0; s < 4; ++s) { const bf16x8 bS = *(const LAS bf16x8*)(ST + c * 272 + (32 * s + 8 * g) * 2);
#pragma unroll
            for (int mb = 0; mb < 4; ++mb) aK[mb] = MFMA16(*(const LAS bf16x8*)(lds + SC_W + (16 * mb + c) * 272 + (32 * s + 8 * g) * 2), bS, aK[mb]); }
#pragma unroll
        for (int mb = 0; mb < 4; ++mb) { float rr[4];
#pragma unroll
            for (int e = 0; e < 4; ++e) rr[e] = (mode == 1 ? 0.f : bf2f(*(const LAS bf16_t*)(lds + SC_U + (16 * mb + 4 * g + e) * 256 + (16 * wid + c) * 2))) - aK[mb][e];
            u32x2 w; w.x = pk2(rr[0], rr[1]); w.y = pk2(rr[2], rr[3]); *(LAS u32x2*)(RT + c * 144 + (16 * mb + 4 * g) * 2) = w; }
        f32x4 aQ[4];
        { const bf16x8 b0 = *(const LAS bf16x8*)(RT + c * 144 + (8 * g) * 2), b1 = *(const LAS bf16x8*)(RT + c * 144 + (32 + 8 * g) * 2);
#pragma unroll
          for (int mb = 0; mb < 8; ++mb) { S[mb] = S[mb] * gl;
              S[mb] = MFMA16(*(const LAS bf16x8*)(lds + SC_KD + (16 * mb + c) * 144 + (8 * g) * 2), b0, S[mb]);
              S[mb] = MFMA16(*(const LAS bf16x8*)(lds + SC_KD + (16 * mb + c) * 144 + (32 + 8 * g) * 2), b1, S[mb]); }
            if (emit) {
#pragma unroll
            for (int mb = 0; mb < 4; ++mb) { aQ[mb] = (f32x4){0.f, 0.f, 0.f, 0.f};
                aQ[mb] = MFMA16(*(const LAS bf16x8*)(lds + SC_AT + (16 * mb + c) * 144 + (8 * g) * 2), b0, aQ[mb]);
                aQ[mb] = MFMA16(*(const LAS bf16x8*)(lds + SC_AT + (16 * mb + c) * 144 + (32 + 8 * g) * 2), b1, aQ[mb]); } } }
        if (emit) {
#pragma unroll
            for (int s = 0; s < 4; ++s) { const bf16x8 bS = *(const LAS bf16x8*)(ST + c * 272 + (32 * s + 8 * g) * 2);
#pragma unroll
                for (int mb = 0; mb < 4; ++mb) aQ[mb] = MFMA16(*(const LAS bf16x8*)(lds + SC_QG + (16 * mb + c) * 272 + (32 * s + 8 * g) * 2), bS, aQ[mb]); } }
        if (emit) {
#pragma unroll
            for (int mb = 0; mb < 4; ++mb)
#pragma unroll
                for (int e = 0; e < 4; ++e) { float q = aQ[mb][e] * aQ[mb][e];
                    q += __int_as_float(__builtin_amdgcn_update_dpp(0, __float_as_int(q), 0x111, 0xf, 0xf, true));
                    q += __int_as_float(__builtin_amdgcn_update_dpp(0, __float_as_int(q), 0x112, 0xf, 0xf, true));
                    q += __int_as_float(__builtin_amdgcn_update_dpp(0, __float_as_int(q), 0x114, 0xf, 0xf, true));
                    q += __int_as_float(__builtin_amdgcn_update_dpp(0, __float_as_int(q), 0x118, 0xf, 0xf, true));
                    if (c == 15) __hip_atomic_fetch_add(EX + (16 * mb + 4 * g + e), q, __ATOMIC_RELAXED, __HIP_MEMORY_SCOPE_WORKGROUP); }
            __syncthreads();
#pragma unroll
            for (int mb = 0; mb < 4; ++mb)
#pragma unroll
                for (int e = 0; e < 4; ++e) { const int rw = 16 * mb + 4 * g + e; const float rn = rsqrtf(EX[rw] * (1.f / 128.f) + EPS);
                    LAS bf16_t* zp = (LAS bf16_t*)(lds + SC_Z + rw * 256 + (16 * wid + c) * 2); *zp = f2bf(aQ[mb][e] * rn * gain * siluf_(bf2f(*zp))); }
        }
    }
    __syncthreads();
    if (emit) SC_FLUSH(nsteps - 1);
#undef SC_ISSUE
#undef SC_WRITE
#undef SC_FLUSH
    if (mode != 2 || seg == NSEG - 1) {
        int c2 = c, g2 = g; asm volatile("" : "+v"(c2), "+v"(g2));
        char* so = mode == 3 ? (char*)(p.out + O_SDS + ((size_t)bh * 128) * 128 + 16 * wid) : mode == 2 ? (char*)(p.out + O_SDP + ((size_t)bh * 128) * 128 + 16 * wid)
                             : (char*)(MB + ((size_t)(bh * NSEG + seg) * 2 + (mode == 0 ? 1 : 0)) * 16384 + 16 * wid);
#pragma unroll
        for (int mb = 0; mb < 8; ++mb)
#pragma unroll
            for (int e = 0; e < 4; ++e) *(float*)(so + (unsigned)((16 * mb + 4 * g2 + e) * 128 + c2) * 4u) = S[mb][e]; }
    __syncthreads();
}

#define XB_TMO      128
#define XB_XCNT(j)  (256  + 64 * (j))
#define XB_XSUB(j)  (1280 + 64 * (j))
#define XB_XGEN(j)  (2304 + 64 * (j))
#define XB_TOP      3328
#define XB_TOPGEN   3392
#define XCD_BAR_WORDS 3456
#define XB_SPIN_CAP (1u << 18)

__device__ __forceinline__ unsigned xb_ld(unsigned* p)              { return __hip_atomic_load(p, __ATOMIC_RELAXED, __HIP_MEMORY_SCOPE_AGENT); }
__device__ __forceinline__ unsigned xb_add(unsigned* p, unsigned v) { return __hip_atomic_fetch_add(p, v, __ATOMIC_RELAXED, __HIP_MEMORY_SCOPE_AGENT); }
__device__ __forceinline__ unsigned xb_xcc_id() { return (unsigned)__builtin_amdgcn_s_getreg((3 << 11) | 20) & 0xFu; }
#define XB_SPIN(cond, bar) do { unsigned _sp = 0; while (cond) { __builtin_amdgcn_s_sleep(1); \
    if ((++_sp & 255u) == 0u) { if (xb_ld(&(bar)[XB_TMO])) break; if (_sp > XB_SPIN_CAP) { atomicAdd(&(bar)[XB_TMO], 1u); break; } } } } while (0)

struct XcdBarrier {
    unsigned* bar; unsigned x;
    volatile LAS unsigned* st;
};

__device__ __forceinline__ XcdBarrier xcd_barrier_post(unsigned* bar, volatile LAS unsigned* st) {
    XcdBarrier b; b.bar = bar; b.x = xb_xcc_id(); b.st = st;
    if (threadIdx.x == 0) (void)xb_add(&bar[XB_XCNT(b.x)], 1u);
    return b;
}
__device__ __forceinline__ void xcd_barrier_complete(unsigned* bar, unsigned x, unsigned& nloc, unsigned& nx) {
    const unsigned G = gridDim.x * gridDim.y * gridDim.z;
    unsigned sum, cnt, mine, sp = 0u;
    for (;;) {
        sum = 0u; cnt = 0u; mine = 0u;
#pragma unroll
        for (unsigned j = 0; j < 16; ++j) { const unsigned c = xb_ld(&bar[XB_XCNT(j)]); sum += c; cnt += (c > 0u) ? 1u : 0u; mine = (j == x) ? c : mine; }
        if (sum == G) break;
        __builtin_amdgcn_s_sleep(1);
        if ((++sp & 255u) == 0u) { if (xb_ld(&bar[XB_TMO])) break; if (sp > XB_SPIN_CAP) { atomicAdd(&bar[XB_TMO], 1u); break; } }
    }
    nloc = mine > 0u ? mine : 1u; nx = cnt > 0u ? cnt : 1u;
}

__device__ __forceinline__ void xcd_barrier(const XcdBarrier& b) {
    asm volatile("s_waitcnt vmcnt(0)" ::: "memory");
    __syncthreads();
    if (threadIdx.x == 0) {
        unsigned* bar = b.bar;
        __builtin_amdgcn_s_waitcnt(0);
        unsigned nloc = b.st[0], nx = b.st[1];
        if (nloc == 0u) { xcd_barrier_complete(bar, b.x, nloc, nx); b.st[0] = nloc; b.st[1] = nx; }
        const unsigned old = xb_add(&bar[XB_XSUB(b.x)], 1u);
        const unsigned gen = old / nloc;
        if (old + 1u == (gen + 1u) * nloc) {
            __builtin_amdgcn_fence(__ATOMIC_RELEASE, "agent");
            asm volatile("s_waitcnt vmcnt(0)" ::: "memory");
            const unsigned og = xb_add(&bar[XB_TOP], 1u);
            const unsigned tg = og / nx;
            if (og + 1u == (tg + 1u) * nx) xb_add(&bar[XB_TOPGEN], 1u);
            else XB_SPIN(xb_ld(&bar[XB_TOPGEN]) == tg, bar);
            __builtin_amdgcn_fence(__ATOMIC_ACQUIRE, "agent");
            xb_add(&bar[XB_XGEN(b.x)], 1u);
            asm volatile("s_waitcnt vmcnt(0)" ::: "memory");
        } else {
            XB_SPIN(xb_ld(&bar[XB_XGEN(b.x)]) == gen, bar);
            __builtin_amdgcn_fence(__ATOMIC_ACQUIRE, "agent");
            asm volatile("s_waitcnt vmcnt(0)" ::: "memory");
        }
    }
    __syncthreads();
}


#ifndef REPG
#define REPG 1
#endif
#ifndef REPS1
#define REPS1 1
#endif
#ifndef REPP
#define REPP 1
#endif
template <class Epi>
__device__ __forceinline__ void run_gemm(LAS unsigned char* lds, const pg8::Gemm& g, const Epi& E) {
    pg8::StaticOrder S; S.init(g.M, g.N, (int)gridDim.x, (int)blockIdx.x);
#pragma unroll 1
    for (int rep_ = 0; rep_ < REPG; ++rep_) pg8::gemm_phase<Epi, pg8::StaticOrder, true, true>((PG8_LAS unsigned char*)lds, g, S, E);
}
__device__ __forceinline__ pg8::Gemm mk_gemm(const bf16_t* A, const bf16_t* As, int pm_split, const bf16_t* Bt, int M, int N, int K, int lda, int ldb) {
    pg8::Gemm g; g.A = A; g.As = As ? As : A; g.A2 = A; g.A2s = g.As; g.Bt = Bt; g.M = M; g.N = N; g.K = K; g.lda = lda; g.ldb = ldb; g.pm_split = pm_split; g.nt1 = K / 64; return g;
}
template <int NB, bool F32OUT>
__device__ __forceinline__ void skinny_proj(const bf16_t* H, const bf16_t* Bt, void* O, int ldo, int ngroups, int wid, int lane) {
    const int c = lane & 15, g = lane >> 4;
    for (int t = blockIdx.x + gridDim.x * wid; t < ngroups; t += gridDim.x * 8) {
        f32x4 acc[NB];
#pragma unroll
        for (int nb = 0; nb < NB; ++nb) acc[nb] = (f32x4){0.f, 0.f, 0.f, 0.f};
        const bf16_t* ap = H + (size_t)(16 * t + c) * 1024 + 8 * g; const bf16_t* bp = Bt + (size_t)c * 1024 + 8 * g;
#pragma unroll 16
        for (int s = 0; s < 32; ++s) { const bf16x8 a = *(const bf16x8*)(ap + 32 * s);
#pragma unroll
            for (int nb = 0; nb < NB; ++nb) acc[nb] = MFMA16(a, *(const bf16x8*)(bp + (size_t)nb * 16 * 1024 + 32 * s), acc[nb]); }
#pragma unroll
        for (int nb = 0; nb < NB; ++nb)
#pragma unroll
            for (int e = 0; e < 4; ++e) { const size_t o = (size_t)(16 * t + 4 * g + e) * ldo + nb * 16 + c; if (F32OUT) ((float*)O)[o] = acc[nb][e]; else ((bf16_t*)O)[o] = f2bf(acc[nb][e]); }
    }
}
#ifndef PH_LO
#define PH_LO 0
#endif
#ifndef PH_HI
#define PH_HI 17
#endif
__global__ void __launch_bounds__(512, 2) hybrid_fwd(Params p_arg) {
    extern __shared__ __attribute__((aligned(16))) unsigned char lds_raw[];
    LAS unsigned char* lds = (LAS unsigned char*)lds_raw;
    cg::grid_group grid = cg::this_grid();
    volatile LAS unsigned* MISC = (volatile LAS unsigned*)(lds + LDS_BYTES - 64);
    if (threadIdx.x < 8) MISC[threadIdx.x] = 0u;
    __syncthreads();
    XcdBarrier xbar = xcd_barrier_post((unsigned*)p_arg.ws, MISC);
    if (p_arg.ws == nullptr) grid.sync();
#define PH(k) if (PH_LO <= (k) && (k) < PH_HI)
#if defined(__HIP_DEVICE_COMPILE__)
#define LOADP() Params p; { const __attribute__((address_space(4))) Params* kp_ = (const __attribute__((address_space(4))) Params*)__builtin_amdgcn_kernarg_segment_ptr(); asm volatile("" : "+s"(kp_)); p = *(const Params*)kp_; } unsigned char* ws = p.ws; (void)ws; int tid = threadIdx.x; asm volatile("" : "+v"(tid)); const int lane = tid & 63, wid = __builtin_amdgcn_readfirstlane(tid >> 6); (void)lane; (void)wid
#else
#define LOADP() Params p = p_arg; unsigned char* ws = p.ws; (void)ws; int tid = threadIdx.x; const int lane = tid & 63, wid = tid >> 6; (void)lane; (void)wid
#endif
#ifdef XSTAMP_MASK
    unsigned long long t_prev = __builtin_amdgcn_s_memrealtime(), t_extra = 0ull;
#define STAMP(k) do { const unsigned long long t_now = __builtin_amdgcn_s_memrealtime(); if ((XSTAMP_MASK >> (k)) & 1) t_extra += t_now - t_prev; t_prev = t_now; } while (0)
#else
#define STAMP(k) do { } while (0)
#endif
#define SYNC(k) if (PH_LO <= (k) && (k) + 1 < PH_HI) { xcd_barrier(xbar); } STAMP(k)
#ifdef XSYNC
    for (int i_ = 0; i_ < XSYNC; ++i_) xcd_barrier(xbar);
#endif
    PH(0) { LOADP(); for (int rep_ = 0; rep_ < REPP; ++rep_) p0_phase(p, lds, tid, wid, lane); } SYNC(0);
    PH(1) { LOADP(); for (int rep_ = 0; rep_ < REPP; ++rep_) p1_phase(p, wid, lane); } SYNC(1);
    PH(2) { LOADP();
        pg8::Gemm g = mk_gemm((const bf16_t*)(p.out + O_CKVP), nullptr, 1 << 20, (const bf16_t*)(ws + W_BT_DN), MP, 4096, 1024, 1024, 1024);
        EpiProj E{0, ws, p.out, 0, 0, 0}; run_gemm(lds, g, E);
        skinny_proj<1, true>((const bf16_t*)(p.out + O_CKVP), (const bf16_t*)(ws + W_BT_DN) + (size_t)4096 * 1024, (float*)(ws + W_BA), 16, MP / 16, wid, lane); } SYNC(2);
    PH(3) { LOADP();
        unsigned* dns = (unsigned*)(ws + W_CNT) + 256;
        if (blockIdx.x >= 128 && blockIdx.x < 204) {
            const int idx = blockIdx.x - 128; const bool dn = idx < 34; const int i2 = dn ? idx : idx - 34, nn = dn ? 17 : 21, pm = i2 / nn, pn = i2 - pm * nn;
            const bf16_t* Bt = (dn ? (const bf16_t*)(ws + W_BT_DN) : (const bf16_t*)(ws + W_BT_MLA)) + (size_t)pn * 256 * 1024;
            pg8::Gemm g = mk_gemm((const bf16_t*)(p.out + O_CKVS) + (size_t)pm * 256 * 1024, nullptr, 1 << 20, Bt, 256, 256, 1024, 1024, 1024);
            EpiProj E{dn ? 0 : 1, ws, p.out, 1, pm, pn};
            pg8::StaticOrder S; S.init(256, 256, 1, 0); pg8::gemm_phase<EpiProj, pg8::StaticOrder, true, true>((PG8_LAS unsigned char*)lds, g, S, E);
            asm volatile("s_waitcnt vmcnt(0)" ::: "memory"); __syncthreads();
            if (dn && tid == 0) { __threadfence(); __hip_atomic_fetch_add(dns, 1u, __ATOMIC_RELAXED, __HIP_MEMORY_SCOPE_AGENT); } }
        { u32x4 raw[3][4][2]; float pre[5] = {0.f, 0.f, 0.f, 0.f, 0.f}; bool have = false;
          for (int u = blockIdx.x; u < 2176; u += gridDim.x) {
            if (u >= 2048) { if (tid == 0) { unsigned sp = 0; while (__hip_atomic_load(dns, __ATOMIC_RELAXED, __HIP_MEMORY_SCOPE_AGENT) < 34u && ++sp < (1u << 22)) __builtin_amdgcn_s_sleep(2); __threadfence(); } __syncthreads(); }
            const int un = u + (int)gridDim.x; const int unext = un < 2048 ? un : -1;
            prep_unit<false>(p, lds, u, tid, wid, lane, raw, pre, have, unext); have = unext >= 0; } } } SYNC(3);
    PH(4) { LOADP();
        for (int rep_ = 0; rep_ < REPS1; ++rep_) for (int ci = blockIdx.x; ci < 256; ci += gridDim.x) { if (ci & 1) scan_chain<1>(p, lds, ci >> 4, (ci >> 1) & 7, tid, wid, lane); else scan_chain<0>(p, lds, ci >> 4, (ci >> 1) & 7, tid, wid, lane); }
        xcd_barrier(xbar); }
    PH(4) { LOADP();
        for (int ci = blockIdx.x; ci < 256; ci += gridDim.x) { if (ci < 128) scan_chain<2>(p, lds, ci >> 3, ci & 7, tid, wid, lane); else scan_chain<3>(p, lds, ci - 128, 0, tid, wid, lane); } } SYNC(4);
    PH(5) { LOADP();
        pg8::Gemm g = mk_gemm((const bf16_t*)(p.out + O_CKVP), nullptr, 1 << 20, (const bf16_t*)(ws + W_BT_MLA), MP, 5120, 1024, 1024, 1024);
        EpiProj E{1, ws, p.out, 0, 0, 0}; run_gemm(lds, g, E);
        skinny_proj<4, false>((const bf16_t*)(p.out + O_CKVP), (const bf16_t*)(ws + W_BT_MLA) + (size_t)5120 * 1024, (bf16_t*)(ws + W_KRP), 64, MP / 16, wid, lane); } SYNC(5);
    PH(6) { LOADP(); e1_phase(p, wid, lane); } SYNC(6);
    PH(7) { LOADP();
        { pg8::Gemm g = mk_gemm((const bf16_t*)(ws + W_CKVP), nullptr, 1 << 20, (const bf16_t*)(ws + W_BT_UKV), MP, 1024, 512, 512, 512); EpiKN E{(bf16_t*)(ws + W_KN), p.in[I_KNN], (PG8_LAS float*)(lds + 131072)}; run_gemm(lds, g, E); }
        { pg8::Gemm g = mk_gemm((const bf16_t*)(ws + W_BT_UKV) + (size_t)1024 * 512, nullptr, 1 << 20, (const bf16_t*)(ws + W_CKVP), 1024, MP, 512, 512, 512); EpiStore E{(bf16_t*)(ws + W_VT), MP, 1}; run_gemm(lds, g, E); } } SYNC(7);
    STAMP(8);
    PH(9) { LOADP();
#ifdef XATTN
        attn_prompt_phase<true>(p, lds, tid, wid, lane);
#endif
        attn_prompt_phase<false>(p, lds, tid, wid, lane); } SYNC(9);
    PH(10) { LOADP();
        pg8::Gemm g = mk_gemm((const bf16_t*)(ws + W_UAP), nullptr, 1 << 20, (const bf16_t*)(ws + W_BT_O), MP, 1024, 2048, 1024, 2048); g.A2 = (const bf16_t*)(ws + W_UBP); g.A2s = g.A2; g.nt1 = 16;
        EpiMerge E{(const bf16_t*)(p.out + O_YP), (bf16_t*)(ws + W_MRGP)}; run_gemm(lds, g, E);
        build_sample_kv(p, wid, lane); } SYNC(10);
    PH(11) { LOADP();
        { pg8::Gemm g = mk_gemm((const bf16_t*)(ws + W_MRGP), nullptr, 1 << 20, (const bf16_t*)(ws + W_BT_OUT), MP, 1024, 1024, 1024, 1024);
          EpiOut E{p.in[I_XP], p.out + O_YP, (const float*)(ws + W_MOD), 13, 0}; run_gemm(lds, g, E); }
        { pg8::Gemm g = mk_gemm((const bf16_t*)(ws + W_CKVALL), nullptr, 1 << 20, (const bf16_t*)(ws + W_BT_UKV), MKS, 1024, 512, 512, 512); EpiKN E{(bf16_t*)(ws + W_KNS), p.in[I_KNN], (PG8_LAS float*)(lds + 131072)}; run_gemm(lds, g, E); }
        { pg8::Gemm g = mk_gemm((const bf16_t*)(ws + W_BT_UKV) + (size_t)1024 * 512, nullptr, 1 << 20, (const bf16_t*)(ws + W_CKVALL), 1024, MKS, 512, 512, 512); EpiStore E{(bf16_t*)(ws + W_VTS), MKS, 1}; run_gemm(lds, g, E); } } SYNC(11);
    STAMP(12);
    PH(13) { LOADP(); attn_sample_phase(p, lds, tid, wid, lane); } SYNC(13);
    PH(14) { LOADP();
        if (blockIdx.x < 64) { const int sl = blockIdx.x >> 3, tl = blockIdx.x & 7, pm = tl >> 2, pn = tl & 3;
            const bf16_t* A = (sl < 4 ? (const bf16_t*)(ws + W_UAS) : (const bf16_t*)(ws + W_UBS)) + (size_t)pm * 256 * 1024 + (sl & 3) * 256;
            const bf16_t* Bt = (const bf16_t*)(ws + W_BT_O) + (size_t)pn * 256 * 2048 + sl * 256;
            pg8::Gemm g = mk_gemm(A, nullptr, 1 << 20, Bt, 256, 256, 256, 1024, 2048);
            EpiSlabMerge E{(const bf16_t*)(ws + W_GS), (float*)(ws + W_SA) + (size_t)sl * 512 * 1024, pm, pn, sl < 4 ? 0 : 1024};
            pg8::StaticOrder S; S.init(256, 256, 1, 0); pg8::gemm_phase<EpiSlabMerge, pg8::StaticOrder, true, true>((PG8_LAS unsigned char*)lds, g, S, E); } } SYNC(14);
    PH(15) { LOADP();
        if (blockIdx.x < 64) { const int sl = blockIdx.x >> 3, tl = blockIdx.x & 7, pm = tl >> 2, pn = tl & 3;
            bf16_t* cv = (bf16_t*)(ws + W_CVT) + (size_t)blockIdx.x * 256 * 128; const float* sa = (const float*)(ws + W_SA) + (size_t)pm * 256 * 1024 + sl * 128;
            for (int i = tid; i < 256 * 32; i += 512) { const int r = i >> 5, c4 = i & 31; f32x4 v = (f32x4){0.f, 0.f, 0.f, 0.f};
#pragma unroll
                for (int s = 0; s < 8; ++s) v += *(const f32x4*)(sa + (size_t)s * 512 * 1024 + (size_t)r * 1024 + c4 * 4);
                u32x2 w; w.x = pk2(v.x, v.y); w.y = pk2(v.z, v.w); *(u32x2*)(cv + r * 128 + c4 * 4) = w; }
            __threadfence(); __syncthreads();
            const bf16_t* Bt = (const bf16_t*)(ws + W_BT_OUT) + (size_t)pn * 256 * 1024 + sl * 128;
            pg8::Gemm g = mk_gemm(cv, nullptr, 1 << 20, Bt, 256, 256, 128, 128, 1024);
            EpiSlabOut E{(float*)(ws + W_SB) + (size_t)sl * 512 * 1024, pm, pn};
            pg8::StaticOrder S; S.init(256, 256, 1, 0); pg8::gemm_phase<EpiSlabOut, pg8::StaticOrder, true, true>((PG8_LAS unsigned char*)lds, g, S, E); } } SYNC(15);
    {   LOADP();
        const float* sb = (const float*)(ws + W_SB); const float* mod = (const float*)(ws + W_MOD);
        for (int i = blockIdx.x * 512 + tid; i < 512 * 256; i += gridDim.x * 512) { const int row = i >> 8, c4 = i & 255; f32x4 v = (f32x4){0.f, 0.f, 0.f, 0.f};
#pragma unroll
            for (int s = 0; s < 8; ++s) v += *(const f32x4*)(sb + (size_t)s * 512 * 1024 + (size_t)row * 1024 + c4 * 4);
            const f32x4 x = *(const f32x4*)(p.in[I_XS] + (size_t)row * 1024 + c4 * 4), gt = *(const f32x4*)(mod + (size_t)(2 + (row >> 5)) * 3072 + 2048 + c4 * 4);
            *(f32x4*)(p.out + O_YS + (size_t)row * 1024 + c4 * 4) = x + gt * v; } }
    STAMP(15);
#ifdef XSTAMP_MASK
    if (blockIdx.x == 0 && threadIdx.x == 0) { const unsigned long long t0 = __builtin_amdgcn_s_memrealtime(); while (__builtin_amdgcn_s_memrealtime() - t0 < t_extra) __builtin_amdgcn_s_sleep(8); }
#endif
}

extern "C" void kernel_launch(void* const* d_in, const int* in_sizes, int n_in, void* d_out, int out_size, void* d_ws, size_t ws_size, hipStream_t stream) {
    static int grid = 0;
    if (grid == 0) {
        int dev = 0, cus = 0, per_cu = 0;
        if (n_in != 26 || ws_size < 256 * MiB) { fprintf(stderr, "kernel_launch: unexpected n_in %d / ws %zu\n", n_in, ws_size); grid = -1; return; }
        hipGetDevice(&dev); hipDeviceGetAttribute(&cus, hipDeviceAttributeMultiprocessorCount, dev);
        if (hipFuncSetAttribute((const void*)hybrid_fwd, hipFuncAttributeMaxDynamicSharedMemorySize, LDS_BYTES) != hipSuccess) { fprintf(stderr, "kernel_launch: hipFuncSetAttribute failed\n"); }
        if (hipOccupancyMaxActiveBlocksPerMultiprocessor(&per_cu, (const void*)hybrid_fwd, 512, LDS_BYTES) != hipSuccess || per_cu < 1) { fprintf(stderr, "kernel_launch: occupancy query says %d\n", per_cu); per_cu = 1; }
        (void)hipGetLastError();
        grid = cus;
    }
    if (grid < 0) return;
    Params p{};
    for (int i = 0; i < 26; ++i) p.in[i] = (const float*)d_in[i];
    p.out = (float*)d_out; p.ws = (unsigned char*)d_ws;
    if (hipMemsetAsync(d_ws, 0, 65536, stream) != hipSuccess) { fprintf(stderr, "kernel_launch: memset failed\n"); return; }
    void* args[] = {&p};
    hipError_t e = hipLaunchCooperativeKernel((const void*)hybrid_fwd, dim3(grid), dim3(512), args, LDS_BYTES, stream);
    if (e != hipSuccess) fprintf(stderr, "cooperative launch failed: %s (grid %d)\n", hipGetErrorString(e), grid);
}
```

```cpp
#include <hip/hip_runtime.h>
#include <hip/hip_cooperative_groups.h>
#include <cstdio>
#include <cstdint>
namespace cg = cooperative_groups;
namespace pg8 {
#define PG8_LAS __attribute__((address_space(3)))
typedef unsigned short bf16_t;
typedef short bf16x8 __attribute__((ext_vector_type(8)));
typedef float f32x4 __attribute__((ext_vector_type(4)));
typedef unsigned u32x4 __attribute__((ext_vector_type(4)));
constexpr int BM = 256, BK = 64, HALF = 128, HTB = HALF * BK * 2  , STAGE_BYTES = 8 * HTB, NXCD = 8, WGM = 8;

__host__ __device__ __forceinline__ int lds_byte(int r, int c) { const int st = (r >> 4) * 2 + (c >> 5), rr = r & 15, cc = c & 31, ob = rr * 64 + cc * 2; return st * 1024 + (ob ^ (((ob >> 9) & 1) << 5)); }
__host__ __device__ __forceinline__ void stage_rc(int b, int& R, int& C) { const int st = b / 1024, sb = b % 1024, swz = sb ^ (((sb >> 9) & 1) << 5); R = (st >> 1) * 16 + swz / 64; C = (st & 1) * 32 + (swz % 64) / 2; }
__host__ __device__ __forceinline__ int perm32(int rho) { const int n = rho >> 4, i = rho & 15; return 8 * (i >> 2) + 4 * n + (i & 3); }

struct Unit { int pm, pn; };
struct Gemm { const bf16_t* A; const bf16_t* As; const bf16_t* A2; const bf16_t* A2s; const bf16_t* Bt; int M, N, K, lda, ldb, pm_split, nt1; };

struct StaticOrder {
    int nM, nN, nwg, G, c;
    __host__ __device__ void init(int M, int N, int G_, int c_) { nM = M / BM; nN = N / BM; nwg = nM * nN; G = G_; c = c_; }
    __host__ __device__ bool next(int i, Unit& u) const {
        const long L = (long)i * G + c; if (L >= nwg) return false;
        int wgid = (int)L; { const int q = nwg / NXCD, r = nwg % NXCD, xcd = wgid % NXCD, off = wgid / NXCD; wgid = (xcd < r ? xcd * (q + 1) : r * (q + 1) + (xcd - r) * q) + off; }
        const int nig = WGM * nN, gid = wgid / nig, fm = gid * WGM, gsz = (nM - fm) < WGM ? (nM - fm) : WGM;
        u.pm = fm + ((wgid % nig) % gsz); u.pn = (wgid % nig) / gsz; return true;
    }
    __device__ __forceinline__ void a_ready(const Unit&) const {}
    __device__ __forceinline__ void done(const Unit&) const {}
};

__device__ __forceinline__ unsigned cvt_pk_bf16(float lo, float hi) { unsigned r; asm volatile("v_cvt_pk_bf16_f32 %0, %1, %2" : "=v"(r) : "v"(lo), "v"(hi)); return r; }

template <class Epi, class Sched, bool ALIGN_EPI = false, bool SP2 = false>
__device__ __forceinline__ void gemm_phase(PG8_LAS unsigned char* lds, const Gemm g, const Sched& S, const Epi& E) {
    int tid_l = threadIdx.x; asm volatile("" : "+v"(tid_l));
    const int tid = tid_l, wid = __builtin_amdgcn_readfirstlane(tid >> 6), lane = tid & 63, wr = wid >> 2, wc = wid & 3, fr = lane & 15, fq = lane >> 4;
    const int K = g.K, nt = K / BK;
    unsigned voffA[2], voffB[2];
#pragma unroll
    for (int i = 0; i < 2; ++i) { int R, C; stage_rc(tid * 16 + i * 8192, R, C); const int Rb = Epi::PERM ? ((R & ~31) + perm32(R & 31)) : R;
        voffA[i] = (unsigned)(R * g.lda + C) * 2u; voffB[i] = (unsigned)(Rb * g.ldb + C) * 2u; }
    const size_t kstep = (size_t)(BK * 2);
    const size_t hstepA = (size_t)HALF * g.lda * 2, hstepB = (size_t)HALF * g.ldb * 2;
    const size_t tstepA = 2 * hstepA, tstepB = 2 * hstepB; const int nt1 = g.nt1;
    const unsigned ldsw = (unsigned)wid * 1024u;
    const int aoff = lds_byte(wr * 64 + fr, fq * 8), boff = lds_byte(wc * 32 + fr, fq * 8);
#define PG8_SA(b, h) (((b) * 2 + (h)) * HTB)
#define PG8_SB(b, h) ((4 + (b) * 2 + (h)) * HTB)
#define PG8_STAGE(bufoff, gbase, voff) do { _Pragma("unroll") for (int _i = 0; _i < 2; ++_i) \
        __builtin_amdgcn_global_load_lds((const unsigned*)((const char*)(gbase) + (voff)[_i]), (PG8_LAS unsigned*)(lds + (bufoff) + ldsw + _i * 8192), 16, 0, 0); } while (0)
#define PG8_LDA(dst, b, h) do { _Pragma("unroll") for (int m = 0; m < 4; ++m) _Pragma("unroll") for (int k = 0; k < 2; ++k) dst[m][k] = *(const PG8_LAS bf16x8*)(lds + PG8_SA(b, h) + aoff + m * 2048 + k * 1024); } while (0)
#define PG8_LDB(dst, b, h) do { _Pragma("unroll") for (int n = 0; n < 2; ++n) _Pragma("unroll") for (int k = 0; k < 2; ++k) dst[n][k] = *(const PG8_LAS bf16x8*)(lds + PG8_SB(b, h) + boff + n * 2048 + k * 1024); } while (0)
#define PG8_MMA(ai, bj, At, Bt) do { __builtin_amdgcn_s_setprio(1); _Pragma("unroll") for (int m = 0; m < 4; ++m) _Pragma("unroll") for (int n = 0; n < 2; ++n) _Pragma("unroll") for (int k = 0; k < 2; ++k) \
        acc[ai][bj][m][n] = __builtin_amdgcn_mfma_f32_16x16x32_bf16(Bt[n][k], At[m][k], acc[ai][bj][m][n], 0, 0, 0); __builtin_amdgcn_s_setprio(0); } while (0)
#define PG8_WAIT_V(n) asm volatile("s_waitcnt vmcnt(" #n ")" ::: "memory")
#define PG8_WAIT_L(n) asm volatile("s_waitcnt lgkmcnt(" #n ")" ::: "memory")
#define PG8_BAR __builtin_amdgcn_s_barrier()
#define PG8_SCHED __builtin_amdgcn_sched_barrier(0)
    Unit cur, nxt; int ui = 0;
    if (!S.next(0, cur)) return;
    f32x4 acc[2][2][4][2];
#pragma unroll
    for (int a = 0; a < 2; ++a)
#pragma unroll
        for (int b = 0; b < 2; ++b)
#pragma unroll
            for (int m = 0; m < 4; ++m)
#pragma unroll
                for (int n = 0; n < 2; ++n) acc[a][b][m][n] = (f32x4){0.f, 0.f, 0.f, 0.f};
    bf16x8 At[4][2], B0[2][2], B1[2][2];
    #define PG8_UA(P, Ps, pm_) ((pm_) < g.pm_split ? (const char*)(P) + (size_t)(pm_) * tstepA : (const char*)(Ps) + (size_t)((pm_) - g.pm_split) * tstepA)
#define PG8_KA(t_) ((t_) < nt1 ? cA + (size_t)(t_) * kstep : cA2 + (size_t)((t_) - nt1) * kstep)
    const char* cA = PG8_UA(g.A, g.As, cur.pm); const char* cA2 = PG8_UA(g.A2, g.A2s, cur.pm); const char* cB = (const char*)g.Bt + (size_t)cur.pn * tstepB;
    S.a_ready(cur);
    if constexpr (SP2) {
        PG8_STAGE(PG8_SB(0, 0), cB, voffB); PG8_STAGE(PG8_SB(0, 1), cB + hstepB, voffB); PG8_STAGE(PG8_SA(0, 0), cA, voffA); PG8_STAGE(PG8_SA(0, 1), cA + hstepA, voffA);
        if (wr == 1) PG8_BAR;
        PG8_WAIT_V(2); PG8_BAR;
        PG8_STAGE(PG8_SB(1, 0), cB + kstep, voffB); PG8_STAGE(PG8_SA(1, 0), cA + kstep, voffA); PG8_STAGE(PG8_SB(1, 1), cB + hstepB + kstep, voffB);
        PG8_WAIT_V(6); PG8_BAR;
    } else {
        PG8_STAGE(PG8_SB(0, 0), cB, voffB); PG8_STAGE(PG8_SA(0, 0), cA, voffA); PG8_STAGE(PG8_SB(0, 1), cB + hstepB, voffB); PG8_STAGE(PG8_SA(0, 1), cA + hstepA, voffA);
        if (wr == 1) PG8_BAR;
        PG8_WAIT_V(4); PG8_BAR;
        PG8_STAGE(PG8_SB(1, 0), cB + kstep, voffB); PG8_STAGE(PG8_SA(1, 0), cA + kstep, voffA); PG8_STAGE(PG8_SB(1, 1), cB + hstepB + kstep, voffB);
        PG8_WAIT_V(6); PG8_BAR;
    }
    for (;;) {
        const bool has_next = S.next(ui + 1, nxt);
        const char* nA = has_next ? PG8_UA(g.A, g.As, nxt.pm) : cA; const char* nA2 = has_next ? PG8_UA(g.A2, g.A2s, nxt.pm) : cA2; const char* nB = has_next ? (const char*)g.Bt + (size_t)nxt.pn * tstepB : cB;
        for (int t = 0; t < nt; t += 2) {
            const bool last = (t == nt - 2);
            if constexpr (Epi::HAS_MID) { if (t == nt1) E.mid(acc, cur, wr, wc, fr, fq); }
            const char* a1 = PG8_KA(t + 1);
            const char* a2 = last ? nA : PG8_KA(t + 2); const char* b2 = last ? nB : cB + (size_t)(t + 2) * kstep;
            const char* a3 = a2 + kstep; const char* b3 = b2 + kstep;
            if (last && has_next) S.a_ready(nxt);
            if constexpr (SP2) {
            PG8_LDB(B0, 0, 0); PG8_LDB(B1, 0, 1); PG8_SCHED; PG8_LDA(At, 0, 0); PG8_STAGE(PG8_SA(1, 1), a1 + hstepA, voffA);
            PG8_WAIT_V(8); PG8_WAIT_L(0); PG8_BAR; PG8_MMA(0, 0, At, B0); PG8_MMA(0, 1, At, B1); PG8_BAR; PG8_SCHED;
            PG8_LDA(At, 0, 1); PG8_STAGE(PG8_SB(0, 0), b2, voffB); PG8_STAGE(PG8_SB(0, 1), b2 + hstepB, voffB); PG8_STAGE(PG8_SA(0, 0), a2, voffA);
            PG8_WAIT_V(8); PG8_WAIT_L(0); PG8_BAR; PG8_MMA(1, 0, At, B0); PG8_MMA(1, 1, At, B1); PG8_BAR; PG8_SCHED;
            PG8_LDB(B0, 1, 0); PG8_LDB(B1, 1, 1); PG8_SCHED; PG8_LDA(At, 1, 0); PG8_STAGE(PG8_SA(0, 1), a2 + hstepA, voffA);
            PG8_WAIT_V(8); PG8_WAIT_L(0); PG8_BAR; PG8_MMA(0, 0, At, B0); PG8_MMA(0, 1, At, B1); PG8_BAR; PG8_SCHED;
            PG8_LDA(At, 1, 1); PG8_STAGE(PG8_SB(1, 0), b3, voffB); PG8_STAGE(PG8_SB(1, 1), b3 + hstepB, voffB); PG8_STAGE(PG8_SA(1, 0), a3, voffA);
            PG8_WAIT_V(8); PG8_WAIT_L(0); PG8_BAR; PG8_MMA(1, 0, At, B0); PG8_MMA(1, 1, At, B1); PG8_BAR; PG8_SCHED;
            } else {
            PG8_LDB(B0, 0, 0); PG8_SCHED; PG8_LDA(At, 0, 0); PG8_STAGE(PG8_SA(1, 1), a1 + hstepA, voffA);
            PG8_WAIT_L(8); PG8_BAR; PG8_WAIT_L(0); PG8_MMA(0, 0, At, B0); PG8_BAR; PG8_SCHED;
            PG8_LDB(B1, 0, 1); PG8_STAGE(PG8_SB(0, 0), b2, voffB);
            PG8_BAR; PG8_WAIT_L(0); PG8_MMA(0, 1, At, B1); PG8_BAR;
            PG8_LDA(At, 0, 1); PG8_STAGE(PG8_SA(0, 0), a2, voffA);
            PG8_BAR; PG8_WAIT_L(0); PG8_MMA(1, 0, At, B0); PG8_BAR; PG8_SCHED;
            PG8_STAGE(PG8_SB(0, 1), b2 + hstepB, voffB);
            PG8_WAIT_V(6); PG8_BAR; PG8_MMA(1, 1, At, B1); PG8_BAR;
            PG8_LDB(B0, 1, 0); PG8_SCHED; PG8_LDA(At, 1, 0); PG8_STAGE(PG8_SA(0, 1), a2 + hstepA, voffA);
            PG8_WAIT_L(8); PG8_BAR; PG8_WAIT_L(0); PG8_MMA(0, 0, At, B0); PG8_BAR; PG8_SCHED;
            PG8_LDB(B1, 1, 1); PG8_STAGE(PG8_SB(1, 0), b3, voffB);
            PG8_BAR; PG8_WAIT_L(0); PG8_MMA(0, 1, At, B1); PG8_BAR;
            PG8_LDA(At, 1, 1); PG8_STAGE(PG8_SA(1, 0), a3, voffA);
            PG8_BAR; PG8_WAIT_L(0); PG8_MMA(1, 0, At, B0); PG8_BAR; PG8_SCHED;
            PG8_STAGE(PG8_SB(1, 1), b3 + hstepB, voffB);
            PG8_WAIT_V(6); PG8_BAR; PG8_MMA(1, 1, At, B1); PG8_BAR;
            }
        }
        if constexpr (ALIGN_EPI) { if (wr == 0) PG8_BAR; }
        if constexpr (!Epi::AFTER_DRAIN) { E(acc, cur, wr, wc, fr, fq); S.done(cur); }
        if (!has_next) break;
#pragma unroll
        for (int a = 0; a < 2; ++a)
#pragma unroll
            for (int b = 0; b < 2; ++b)
#pragma unroll
                for (int m = 0; m < 4; ++m)
#pragma unroll
                    for (int n = 0; n < 2; ++n) acc[a][b][m][n] = (f32x4){0.f, 0.f, 0.f, 0.f};
        cur = nxt; cA = nA; cA2 = nA2; cB = nB; ++ui;
        if constexpr (ALIGN_EPI) { if (wr == 1) PG8_BAR; }
    }
    PG8_WAIT_V(0);
    if constexpr (!ALIGN_EPI) { if (wr == 0) PG8_BAR; }
    PG8_BAR;
    if constexpr (Epi::AFTER_DRAIN) { E.fused(acc, cur, wr, wc, fr, fq, lds, wid, lane); S.done(cur); }
#undef PG8_UA
#undef PG8_KA
#undef PG8_SA
#undef PG8_SB
#undef PG8_STAGE
#undef PG8_LDA
#undef PG8_LDB
#undef PG8_MMA
#undef PG8_WAIT_V
#undef PG8_WAIT_L
#undef PG8_BAR
#undef PG8_SCHED
}
}
#define LAS __attribute__((address_space(3)))
typedef unsigned short bf16_t;
typedef short bf16x8 __attribute__((ext_vector_type(8)));
typedef float f32x4 __attribute__((ext_vector_type(4)));
typedef float f32x16 __attribute__((ext_vector_type(16)));
typedef unsigned u32x4 __attribute__((ext_vector_type(4)));
typedef unsigned u32x2 __attribute__((ext_vector_type(2)));
typedef float f32x2_t __attribute__((ext_vector_type(2)));
typedef __bf16 bf16x2_t __attribute__((ext_vector_type(2)));

constexpr int MP = 16384, MS = 512, MT = MP + MS, TKS = 2080, MKS = 16 * TKS  ;
constexpr float EPS = 1e-6f;
constexpr size_t MiB = 1u << 20;
constexpr size_t W_BT_DN = 1 * MiB, W_BT_MLA = W_BT_DN + (size_t)4352 * 1024 * 2, W_BT_UKV = 20 * MiB, W_BT_O = 22 * MiB, W_BT_OUT = 26 * MiB;
constexpr size_t W_MOD = 28 * MiB, W_GL = 28 * MiB + 256 * 1024, W_BA = 28 * MiB + 512 * 1024;
constexpr size_t W_QS = 30 * MiB, W_CKVS = 31 * MiB + 512 * 1024, W_KRS = 32 * MiB, W_UAS = 33 * MiB, W_UBS = 34 * MiB, W_MRGS = 35 * MiB;
constexpr size_t W_QKV = 36 * MiB, W_HALO = 135 * MiB, W_KDT = 140 * MiB, W_SQKV = 174 * MiB, W_UAP = 189 * MiB, W_TB = 221 * MiB, W_MB = 238 * MiB, W_UBP = 222 * MiB;
constexpr size_t W_QP = 36 * MiB, W_CKVP = 84 * MiB, W_KRP = 100 * MiB, W_KN = 102 * MiB, W_VT = 134 * MiB;
constexpr size_t W_SA = 36 * MiB, W_SB = 52 * MiB;
constexpr size_t W_ROPE = 180 * MiB;
constexpr size_t W_GS = 254 * MiB, W_MF32 = 2 * MiB, W_CVT = 4 * MiB, W_PART = 8 * MiB, W_CNT = 32768;
constexpr size_t W_MRGP = 36 * MiB, W_CKVALL = 68 * MiB, W_KRALL = 101 * MiB, W_KNS = 106 * MiB, W_VTS = 172 * MiB;
static_assert(W_BT_MLA + (size_t)5376 * 1024 * 2 <= W_BT_UKV, "ws map");
static_assert(W_BA + (size_t)MT * 16 * 4 <= W_QS, "ws map");
static_assert(W_QKV + (size_t)MT * 3072 * 2 <= W_HALO && W_HALO + (size_t)264 * 3 * 3072 * 2 <= W_KDT && W_KDT + (size_t)2176 * 8192 * 2 <= W_SQKV && W_SQKV + (size_t)128 * 3 * 8192 * 2 <= W_UAP, "ws map");
static_assert(W_TB + (size_t)2176 * 4096 * 2 <= W_MB && W_MB + (size_t)128 * 2 * 16384 * 4 <= 256 * MiB && W_UAP + (size_t)MP * 1024 * 2 <= W_UBP && W_UBP + (size_t)MP * 1024 * 2 <= 256 * MiB, "ws map");
static_assert(W_QP + (size_t)MP * 1536 * 2 <= W_CKVP && W_CKVP + (size_t)MP * 512 * 2 <= W_KRP && W_KRP + (size_t)MP * 64 * 2 <= W_KN && W_KN + (size_t)MP * 1024 * 2 <= W_VT && W_VT + (size_t)MP * 1024 * 2 <= W_UAP, "ws map");
static_assert(W_MRGP + (size_t)MP * 1024 * 2 <= W_CKVALL && W_CKVALL + (size_t)(MKS + 64) * 512 * 2 <= W_KRALL && W_KRALL + (size_t)(MKS + 64) * 64 * 2 <= W_KNS && W_KNS + (size_t)(MKS + 64) * 1024 * 2 <= W_VTS && W_VTS + (size_t)1024 * MKS * 2 + 256 <= 256 * MiB, "ws map");
constexpr size_t O_YP = 0, O_YS = O_YP + (size_t)MP * 1024, O_CKVP = O_YS + (size_t)MS * 1024, O_KRP = O_CKVP + (size_t)MP * 512, O_SDP = O_KRP + (size_t)MP * 64,
                 O_CVP = O_SDP + 2 * 8 * 128 * 128, O_CKVS = O_CVP + 2 * 3 * 3072, O_KRS = O_CKVS + (size_t)MS * 512, O_SDS = O_KRS + (size_t)MS * 64, O_CVS = O_SDS + (size_t)16 * 8 * 128 * 128;
constexpr int LDS_BYTES = 163840;

struct Params { const float* in[26]; float* out; unsigned char* ws; };
enum { I_XP = 0, I_XS, I_CP, I_CS, I_CCKV, I_CKR, I_SD, I_SC, I_NG, I_WADA, I_BADA, I_WIN, I_WCONV, I_ALOG, I_DTB, I_DNN, I_QNN, I_QRN, I_KNN, I_KRN, I_KVN, I_WUK, I_WUV, I_WODN, I_WOMLA, I_WOUT };

__device__ __forceinline__ float bf2f(unsigned short u) { return __uint_as_float((unsigned)u << 16); }
__device__ __forceinline__ float bflo(unsigned u) { return __uint_as_float(u << 16); }
__device__ __forceinline__ float bfhi(unsigned u) { return __uint_as_float(u & 0xffff0000u); }
__device__ __forceinline__ unsigned pk2(float lo, float hi) { f32x2_t v = {lo, hi}; bf16x2_t b = __builtin_convertvector(v, bf16x2_t); return __builtin_bit_cast(unsigned, b); }
__device__ __forceinline__ unsigned short f2bf(float f) { return (unsigned short)(pk2(f, 0.f) & 0xffffu); }
__device__ __forceinline__ float wave_sum(float v) {
#pragma unroll
    for (int o = 1; o < 64; o <<= 1) v += __shfl_xor(v, o);
    return v;
}
__device__ __forceinline__ float sigmoidf_(float x) { return __builtin_amdgcn_rcpf(1.f + __expf(-x)); }
__device__ __forceinline__ float siluf_(float x) { return x * __builtin_amdgcn_rcpf(1.f + __expf(-x)); }
__device__ __forceinline__ void unpack8(u32x4 v, float* f) { f[0] = bflo(v.x); f[1] = bfhi(v.x); f[2] = bflo(v.y); f[3] = bfhi(v.y); f[4] = bflo(v.z); f[5] = bfhi(v.z); f[6] = bflo(v.w); f[7] = bfhi(v.w); }
__device__ __forceinline__ u32x4 pack8(const float* f) { u32x4 v; v.x = pk2(f[0], f[1]); v.y = pk2(f[2], f[3]); v.z = pk2(f[4], f[5]); v.w = pk2(f[6], f[7]); return v; }

using pg8::Unit;
struct EpiStore {
    static constexpr bool PERM = true, AFTER_DRAIN = false, HAS_MID = false;
    bf16_t* O; int ldc; int swz;
    __device__ __forceinline__ void operator()(const f32x4 (&acc)[2][2][4][2], const Unit& u, int wr, int wc, int fr, int fq) const {
#pragma unroll
        for (int ai = 0; ai < 2; ++ai)
#pragma unroll
            for (int m = 0; m < 4; ++m) { const int row = u.pm * 256 + ai * 128 + wr * 64 + m * 16 + fr; bf16_t* rp = O + (size_t)row * ldc + u.pn * 256 + wc * 32 + 8 * fq;
#pragma unroll
                for (int bj = 0; bj < 2; ++bj) { const bool sw = swz && (m & 1); const f32x4 v0 = sw ? acc[ai][bj][m][1] : acc[ai][bj][m][0], v1 = sw ? acc[ai][bj][m][0] : acc[ai][bj][m][1]; u32x4 w; w.x = pk2(v0[0], v0[1]); w.y = pk2(v0[2], v0[3]); w.z = pk2(v1[0], v1[1]); w.w = pk2(v1[2], v1[3]);
                    *(u32x4*)(rp + bj * 128) = w; } }
    }
};
struct EpiProj {
    static constexpr bool PERM = true, AFTER_DRAIN = false, HAS_MID = false;
    int pass; unsigned char* ws; float* out; int smp, pm_off, pn_off;
    __device__ __forceinline__ void operator()(const f32x4 (&acc)[2][2][4][2], const Unit& u, int wr, int wc, int fr, int fq) const {
        bf16_t* bp; bf16_t* bs; int ldc, ct; int kind = 0;
        const int pn = u.pn + pn_off, pm = u.pm + pm_off;
        if (pass == 0) {
            if (pn < 12) { bp = (bf16_t*)(ws + W_QKV); bs = bp + (size_t)MP * 3072; ldc = 3072; ct = pn * 256; kind = 3; }
            else if (pn < 16) { bp = (bf16_t*)(ws + W_UAP); bs = (bf16_t*)(ws + W_UAS); ldc = 1024; ct = (pn - 12) * 256; }
            else { bp = bs = nullptr; ldc = 0; ct = 0; kind = 1; }
        } else {
            if (pn < 6) { bp = (bf16_t*)(ws + W_QP); bs = (bf16_t*)(ws + W_QS); ldc = 1536; ct = pn * 256; }
            else if (pn < 8) { bp = (bf16_t*)(ws + W_CKVP); bs = (bf16_t*)(ws + W_CKVS); ldc = 512; ct = (pn - 6) * 256; }
            else if (pn < 12) { bp = (bf16_t*)(ws + W_UBP); bs = (bf16_t*)(ws + W_UBS); ldc = 1024; ct = (pn - 8) * 256; }
            else if (pn < 20) { bp = (bf16_t*)(out + O_YP); bs = (bf16_t*)(ws + W_GS); ldc = 2048; ct = (pn - 12) * 256; }
            else { bp = (bf16_t*)(ws + W_KRP); bs = (bf16_t*)(ws + W_KRS); ldc = 64; ct = 0; kind = 2; }
        }
        if (kind == 1) {
            if (wc != 0 || fq >= 2) return;
            float* ba = (float*)(ws + W_BA) + (smp ? (size_t)MP * 16 : 0);
#pragma unroll
            for (int ai = 0; ai < 2; ++ai)
#pragma unroll
                for (int m = 0; m < 4; ++m) { const int row = pm * 256 + ai * 128 + wr * 64 + m * 16 + fr; float* rp = ba + (size_t)row * 16 + 8 * fq;
                    *(f32x4*)rp = acc[ai][0][m][0]; *(f32x4*)(rp + 4) = acc[ai][0][m][1]; }
            return;
        }
        if (kind == 2 && wc >= 2) return;
        bf16_t* base = smp ? bs : bp;
#pragma unroll
        for (int ai = 0; ai < 2; ++ai)
#pragma unroll
            for (int m = 0; m < 4; ++m) { const int row = pm * 256 + ai * 128 + wr * 64 + m * 16 + fr;
                bf16_t* rp = base + (size_t)row * ldc + ct + wc * 32 + 8 * fq;
#pragma unroll
                for (int bj = 0; bj < 2; ++bj) { if (kind == 2 && bj == 1) continue;
                    const f32x4 v0 = acc[ai][bj][m][0], v1 = acc[ai][bj][m][1]; u32x4 w; w.x = pk2(v0[0], v0[1]); w.y = pk2(v0[2], v0[3]); w.z = pk2(v1[0], v1[1]); w.w = pk2(v1[2], v1[3]);
                    *(u32x4*)(rp + bj * 128) = w;
                    if (kind == 3 && !smp && m == 3 && fr >= 13) *(u32x4*)((bf16_t*)(ws + W_HALO) + ((size_t)(row >> 6) * 3 + (fr - 13)) * 3072 + ct + wc * 32 + 8 * fq + bj * 128) = w; } }
    }
};
struct EpiMerge {
    static constexpr bool PERM = true, AFTER_DRAIN = false, HAS_MID = true;
    const bf16_t* G; bf16_t* O;
    __device__ __forceinline__ void mid(f32x4 (&acc)[2][2][4][2], const Unit& u, int wr, int wc, int fr, int fq) const {
#pragma unroll
        for (int ai = 0; ai < 2; ++ai)
#pragma unroll
            for (int m = 0; m < 4; ++m) { const int row = u.pm * 256 + ai * 128 + wr * 64 + m * 16 + fr; const bf16_t* gp = G + (size_t)row * 2048 + u.pn * 256 + wc * 32 + 8 * fq;
#pragma unroll
                for (int bj = 0; bj < 2; ++bj) { float ga[8], gb[8]; unpack8(*(const u32x4*)(gp + bj * 128), ga); unpack8(*(const u32x4*)(gp + 1024 + bj * 128), gb);
#pragma unroll
                    for (int e = 0; e < 8; ++e) { const float f = (1.f + __expf(-gb[e])) * __builtin_amdgcn_rcpf(1.f + __expf(-ga[e])); if (e < 4) acc[ai][bj][m][0][e] *= f; else acc[ai][bj][m][1][e - 4] *= f; } } }
    }
    __device__ __forceinline__ void operator()(const f32x4 (&acc)[2][2][4][2], const Unit& u, int wr, int wc, int fr, int fq) const {
#pragma unroll
        for (int ai = 0; ai < 2; ++ai)
#pragma unroll
            for (int m = 0; m < 4; ++m) { const int row = u.pm * 256 + ai * 128 + wr * 64 + m * 16 + fr; const bf16_t* gp = G + (size_t)row * 2048 + 1024 + u.pn * 256 + wc * 32 + 8 * fq;
                bf16_t* rp = O + (size_t)row * 1024 + u.pn * 256 + wc * 32 + 8 * fq;
#pragma unroll
                for (int bj = 0; bj < 2; ++bj) { float gb[8], v[8]; unpack8(*(const u32x4*)(gp + bj * 128), gb);
#pragma unroll
                    for (int e = 0; e < 8; ++e) v[e] = (e < 4 ? acc[ai][bj][m][0][e] : acc[ai][bj][m][1][e - 4]) * sigmoidf_(gb[e]);
                    *(u32x4*)(rp + bj * 128) = pack8(v); } }
    }
};
struct EpiOut {
    static constexpr bool PERM = true, AFTER_DRAIN = false, HAS_MID = false;
    const float* X; float* Y; const float* mod; int rows_per_batch, mod_row0;
    __device__ __forceinline__ void operator()(const f32x4 (&acc)[2][2][4][2], const Unit& u, int wr, int wc, int fr, int fq) const {
#pragma unroll
        for (int ai = 0; ai < 2; ++ai)
#pragma unroll
            for (int m = 0; m < 4; ++m) { const int row = u.pm * 256 + ai * 128 + wr * 64 + m * 16 + fr; const int col = u.pn * 256 + wc * 32 + 8 * fq;
                const float* gt = mod + (size_t)(mod_row0 + (row >> rows_per_batch)) * 3072 + 2048 + col;
#pragma unroll
                for (int bj = 0; bj < 2; ++bj) {
                    const f32x4 x0 = *(const f32x4*)(X + (size_t)row * 1024 + col + bj * 128), x1 = *(const f32x4*)(X + (size_t)row * 1024 + col + bj * 128 + 4);
                    const f32x4 g0 = *(const f32x4*)(gt + bj * 128), g1 = *(const f32x4*)(gt + bj * 128 + 4);
                    __builtin_nontemporal_store(x0 + g0 * acc[ai][bj][m][0], (f32x4*)(Y + (size_t)row * 1024 + col + bj * 128));
                    __builtin_nontemporal_store(x1 + g1 * acc[ai][bj][m][1], (f32x4*)(Y + (size_t)row * 1024 + col + bj * 128 + 4)); } }
    }
};

struct EpiPartMerge {
    static constexpr bool PERM = true, AFTER_DRAIN = false, HAS_MID = false;
    const bf16_t* G; float* O; int pm, pn, goff;
    __device__ __forceinline__ void operator()(const f32x4 (&acc)[2][2][4][2], const Unit&, int wr, int wc, int fr, int fq) const {
#pragma unroll
        for (int ai = 0; ai < 2; ++ai)
#pragma unroll
            for (int m = 0; m < 4; ++m) { const int row = pm * 256 + ai * 128 + wr * 64 + m * 16 + fr; const int col = pn * 256 + wc * 32 + 8 * fq;
#pragma unroll
                for (int bj = 0; bj < 2; ++bj) { float gg[8]; unpack8(*(const u32x4*)(G + (size_t)row * 2048 + goff + col + bj * 128), gg); float* op = O + (size_t)row * 1024 + col + bj * 128;
#pragma unroll
                    for (int e = 0; e < 8; ++e) unsafeAtomicAdd(op + e, sigmoidf_(gg[e]) * (e < 4 ? acc[ai][bj][m][0][e] : acc[ai][bj][m][1][e - 4])); } }
    }
};
struct EpiPartOut {
    static constexpr bool PERM = true, AFTER_DRAIN = false, HAS_MID = false;
    const float* X; float* Y; const float* mod; int pm, pn, addx;
    __device__ __forceinline__ void operator()(const f32x4 (&acc)[2][2][4][2], const Unit&, int wr, int wc, int fr, int fq) const {
#pragma unroll
        for (int ai = 0; ai < 2; ++ai)
#pragma unroll
            for (int m = 0; m < 4; ++m) { const int row = pm * 256 + ai * 128 + wr * 64 + m * 16 + fr; const int col = pn * 256 + wc * 32 + 8 * fq;
                const float* gt = mod + (size_t)(2 + (row >> 5)) * 3072 + 2048 + col;
#pragma unroll
                for (int bj = 0; bj < 2; ++bj) { float* yp = Y + (size_t)row * 1024 + col + bj * 128; const float* xp = X + (size_t)row * 1024 + col + bj * 128;
#pragma unroll
                    for (int e = 0; e < 8; ++e) { float v = gt[bj * 128 + e] * (e < 4 ? acc[ai][bj][m][0][e] : acc[ai][bj][m][1][e - 4]); if (addx) v += xp[e]; unsafeAtomicAdd(yp + e, v); } } }
    }
};

struct EpiSlabMerge {
    static constexpr bool PERM = true, AFTER_DRAIN = false, HAS_MID = false;
    const bf16_t* G; float* S; int pm, pn, goff;
    __device__ __forceinline__ void operator()(const f32x4 (&acc)[2][2][4][2], const Unit&, int wr, int wc, int fr, int fq) const {
#pragma unroll
        for (int ai = 0; ai < 2; ++ai)
#pragma unroll
            for (int m = 0; m < 4; ++m) { const int row = pm * 256 + ai * 128 + wr * 64 + m * 16 + fr; const int col = pn * 256 + wc * 32 + 8 * fq;
#pragma unroll
                for (int bj = 0; bj < 2; ++bj) { float gg[8]; unpack8(*(const u32x4*)(G + (size_t)row * 2048 + goff + col + bj * 128), gg); float* op = S + (size_t)row * 1024 + col + bj * 128;
                    f32x4 v0 = acc[ai][bj][m][0], v1 = acc[ai][bj][m][1];
                    v0.x *= sigmoidf_(gg[0]); v0.y *= sigmoidf_(gg[1]); v0.z *= sigmoidf_(gg[2]); v0.w *= sigmoidf_(gg[3]); v1.x *= sigmoidf_(gg[4]); v1.y *= sigmoidf_(gg[5]); v1.z *= sigmoidf_(gg[6]); v1.w *= sigmoidf_(gg[7]);
                    *(f32x4*)op = v0; *(f32x4*)(op + 4) = v1; } }
    }
};
struct EpiSlabOut {
    static constexpr bool PERM = true, AFTER_DRAIN = false, HAS_MID = false;
    float* S; int pm, pn;
    __device__ __forceinline__ void operator()(const f32x4 (&acc)[2][2][4][2], const Unit&, int wr, int wc, int fr, int fq) const {
#pragma unroll
        for (int ai = 0; ai < 2; ++ai)
#pragma unroll
            for (int m = 0; m < 4; ++m) { const int row = pm * 256 + ai * 128 + wr * 64 + m * 16 + fr; const int col = pn * 256 + wc * 32 + 8 * fq;
#pragma unroll
                for (int bj = 0; bj < 2; ++bj) { float* op = S + (size_t)row * 1024 + col + bj * 128; *(f32x4*)op = acc[ai][bj][m][0]; *(f32x4*)(op + 4) = acc[ai][bj][m][1]; } }
    }
};

struct EpiKN {
    static constexpr bool PERM = true, AFTER_DRAIN = false, HAS_MID = false;
    bf16_t* O; const float* gain; PG8_LAS float* P;
    __device__ __forceinline__ void operator()(const f32x4 (&acc)[2][2][4][2], const Unit& u, int wr, int wc, int fr, int fq) const {
#pragma unroll
        for (int ai = 0; ai < 2; ++ai)
#pragma unroll
            for (int m = 0; m < 4; ++m)
#pragma unroll
                for (int bj = 0; bj < 2; ++bj) { const f32x4 v0 = acc[ai][bj][m][0], v1 = acc[ai][bj][m][1];
                    float s = (v0.x * v0.x + v0.y * v0.y) + (v0.z * v0.z + v0.w * v0.w) + (v1.x * v1.x + v1.y * v1.y) + (v1.z * v1.z + v1.w * v1.w);
                    s += __shfl_xor(s, 16); s += __shfl_xor(s, 32);
                    if (fq == 0) P[((ai * 128 + wr * 64 + m * 16 + fr) * 2 + bj) * 4 + wc] = s; }
        asm volatile("s_waitcnt lgkmcnt(0)" ::: "memory"); __builtin_amdgcn_s_barrier(); asm volatile("" ::: "memory");
        float gn[8];
#pragma unroll
        for (int e = 0; e < 8; ++e) gn[e] = gain[wc * 32 + 8 * fq + e];
#pragma unroll
        for (int ai = 0; ai < 2; ++ai)
#pragma unroll
            for (int m = 0; m < 4; ++m) { const int rl = ai * 128 + wr * 64 + m * 16 + fr; bf16_t* rp = O + (size_t)(u.pm * 256 + rl) * 1024 + u.pn * 256 + wc * 32 + 8 * fq;
#pragma unroll
                for (int bj = 0; bj < 2; ++bj) { const f32x4 ps = *(const PG8_LAS f32x4*)(P + (rl * 2 + bj) * 4); const float rn = rsqrtf(((ps.x + ps.y) + (ps.z + ps.w)) * (1.f / 128.f) + EPS);
                    const f32x4 v0 = acc[ai][bj][m][0], v1 = acc[ai][bj][m][1]; u32x4 w;
                    w.x = pk2(v0.x * rn * gn[0], v0.y * rn * gn[1]); w.y = pk2(v0.z * rn * gn[2], v0.w * rn * gn[3]); w.z = pk2(v1.x * rn * gn[4], v1.y * rn * gn[5]); w.w = pk2(v1.z * rn * gn[6], v1.w * rn * gn[7]);
                    *(u32x4*)(rp + bj * 128) = w; } }
        asm volatile("s_waitcnt lgkmcnt(0)" ::: "memory"); __builtin_amdgcn_s_barrier(); asm volatile("" ::: "memory");
    }
};
struct TrItem { const float* W; bf16_t* WT; int ldw, n0, k0, ldt, r0, kdst; };
__device__ __forceinline__ void tr_load(const TrItem& d, float (&tv)[32], int lane) {
#pragma unroll
    for (int i = 0; i < 32; ++i) tv[i] = __builtin_nontemporal_load(d.W + (size_t)(d.k0 + 2 * i + (lane >> 5)) * d.ldw + d.n0 + (lane & 31));
}
__device__ __forceinline__ void tr_store(const TrItem& d, const float (&tv)[32], LAS float* scr, int lane) {
#pragma unroll
    for (int i = 0; i < 32; ++i) scr[(2 * i + (lane >> 5)) * 33 + (lane & 31)] = tv[i];
    asm volatile("s_waitcnt lgkmcnt(0)" ::: "memory");
    const int c = lane & 7;
#pragma unroll
    for (int j = 0; j < 4; ++j) { const int n = (lane >> 3) + 8 * j; const LAS float* s = scr + (8 * c) * 33 + n;
        u32x4 o; o.x = pk2(s[0 * 33], s[1 * 33]); o.y = pk2(s[2 * 33], s[3 * 33]); o.z = pk2(s[4 * 33], s[5 * 33]); o.w = pk2(s[6 * 33], s[7 * 33]);
        *(u32x4*)(d.WT + (size_t)(d.r0 + n) * d.ldt + d.kdst + d.k0 + 8 * c) = o; }
    asm volatile("s_waitcnt lgkmcnt(0)" ::: "memory");
}
__device__ __forceinline__ void p0_phase(const Params& p, LAS unsigned char* lds, int tid, int wid, int lane) {
    const int G = gridDim.x, bx = blockIdx.x;
    for (int task = bx; task < 288; task += G) {
        const int cb = task % 48, rg = task / 48; LAS float* cl = (LAS float*)(lds + 65536);
        __syncthreads();
        for (int i = tid; i < 3 * 1024; i += 512) { const int r = rg * 3 + (i >> 10), k = i & 1023; cl[i] = r < 2 ? p.in[I_CP][r * 1024 + k] : p.in[I_CS][(r - 2) * 1024 + k]; }
        __syncthreads();
        const int j = cb * 64 + lane; float a0 = 0.f, a1 = 0.f, a2 = 0.f; const float* wa = p.in[I_WADA] + j;
#pragma unroll 16
        for (int k = wid * 128; k < wid * 128 + 128; ++k) { const float wv = wa[(size_t)k * 3072]; a0 += cl[k] * wv; a1 += cl[1024 + k] * wv; a2 += cl[2048 + k] * wv; }
        LAS float* red = (LAS float*)lds;
        red[(wid * 3 + 0) * 64 + lane] = a0; red[(wid * 3 + 1) * 64 + lane] = a1; red[(wid * 3 + 2) * 64 + lane] = a2;
        __syncthreads();
        if (tid < 192) { const int r = tid >> 6, l = tid & 63; float s = 0.f;
#pragma unroll
            for (int w = 0; w < 8; ++w) s += red[(w * 3 + r) * 64 + l];
            ((float*)(p.ws + W_MOD))[(rg * 3 + r) * 3072 + cb * 64 + l] = s + p.in[I_BADA][cb * 64 + l]; }
    }
    __syncthreads();
    for (int idx = bx * 512 + tid; idx < 8192 * 32; idx += G * 512) { const int i = idx & 31; const float inv = exp2f(-(float)i * (13.287712379549449f / 32.f)); float sn, cs; sincosf((float)(idx >> 5) * inv, &sn, &cs);
        ((f32x2_t*)(p.ws + W_ROPE))[idx] = (f32x2_t){cs, sn}; }
    LAS float* scr = (LAS float*)(lds + 81920 + wid * 8448);
    const int gw = bx * 8 + wid, NGW = G * 8;
    constexpr int I_DN = 129 * 16, I_MLA = 162 * 16, I_UK = 32 * 8, I_UV = 32 * 8, I_ODN = 32 * 16, I_OMLA = 32 * 16, I_WO = 32 * 16;
    constexpr int NITEMS = I_DN + I_MLA + I_UK + I_UV + I_ODN + I_OMLA + I_WO;
    auto decode = [&](int it) { TrItem d; int r = it;
        if (r < I_DN) { const int dg = r >> 4, kb = r & 15; d = TrItem{p.in[I_WIN], (bf16_t*)(p.ws + W_BT_DN), 9296, 32 * dg, 64 * kb, 1024, 32 * dg, 0}; return d; } r -= I_DN;
        if (r < I_MLA) { const int dg = r >> 4, kb = r & 15; int n0;
            if (dg < 48) n0 = 4112 + 32 * dg; else if (dg < 64) n0 = 5648 + 32 * (dg - 48); else if (dg < 96) n0 = 6224 + 32 * (dg - 64); else if (dg < 160) n0 = 7248 + 32 * (dg - 96); else n0 = 6160 + 32 * (dg - 160);
            d = TrItem{p.in[I_WIN], (bf16_t*)(p.ws + W_BT_MLA), 9296, n0, 64 * kb, 1024, 32 * dg, 0}; return d; } r -= I_MLA;
        if (r < I_UK) { const int dg = r >> 3, kb = r & 7; d = TrItem{p.in[I_WUK], (bf16_t*)(p.ws + W_BT_UKV), 1024, 32 * dg, 64 * kb, 512, 32 * dg, 0}; return d; } r -= I_UK;
        if (r < I_UV) { const int dg = r >> 3, kb = r & 7; d = TrItem{p.in[I_WUV], (bf16_t*)(p.ws + W_BT_UKV), 1024, 32 * dg, 64 * kb, 512, 1024 + 32 * dg, 0}; return d; } r -= I_UV;
        if (r < I_ODN) { const int dg = r >> 4, kb = r & 15; d = TrItem{p.in[I_WODN], (bf16_t*)(p.ws + W_BT_O), 1024, 32 * dg, 64 * kb, 2048, 32 * dg, 0}; return d; } r -= I_ODN;
        if (r < I_OMLA) { const int dg = r >> 4, kb = r & 15; d = TrItem{p.in[I_WOMLA], (bf16_t*)(p.ws + W_BT_O), 1024, 32 * dg, 64 * kb, 2048, 32 * dg, 1024}; return d; } r -= I_OMLA;
        { const int dg = r >> 4, kb = r & 15; d = TrItem{p.in[I_WOUT], (bf16_t*)(p.ws + W_BT_OUT), 1024, 32 * dg, 64 * kb, 1024, 32 * dg, 0}; return d; } };
    if (gw < NITEMS) { float ta[32], tb[32]; TrItem da = decode(gw), db = da; tr_load(da, ta, lane);
        for (int it = gw; it < NITEMS; it += 2 * NGW) {
            const bool hb = it + NGW < NITEMS; if (hb) { db = decode(it + NGW); tr_load(db, tb, lane); }
            tr_store(da, ta, scr, lane);
            if (!hb) break;
            const bool ha = it + 2 * NGW < NITEMS; if (ha) { da = decode(it + 2 * NGW); tr_load(da, ta, lane); }
            tr_store(db, tb, scr, lane);
            if (!ha) break; } }
}
__device__ __forceinline__ void p1_phase(const Params& p, int wid, int lane) {
    const int gw = blockIdx.x * 8 + wid, NGW = gridDim.x * 8; const float* mod = (const float*)(p.ws + W_MOD);
    for (int row0 = gw; row0 < MT; row0 += 2 * NGW) {
        f32x4 v[2][4]; float s[2] = {0.f, 0.f};
#pragma unroll
        for (int t = 0; t < 2; ++t) { const int row = row0 + t * NGW; if (row < MT) { const float* xr = row < MP ? p.in[I_XP] + (size_t)row * 1024 : p.in[I_XS] + (size_t)(row - MP) * 1024;
#pragma unroll
            for (int j = 0; j < 4; ++j) v[t][j] = __builtin_nontemporal_load((const f32x4*)(xr + 4 * lane + 256 * j)); } }
#pragma unroll
        for (int t = 0; t < 2; ++t) { const int row = row0 + t * NGW; if (row < MT) {
#pragma unroll
            for (int j = 0; j < 4; ++j) s[t] += (v[t][j].x * v[t][j].x + v[t][j].y * v[t][j].y) + (v[t][j].z * v[t][j].z + v[t][j].w * v[t][j].w);
            const float rs = rsqrtf(wave_sum(s[t]) * (1.f / 1024.f) + EPS);
            const int mr = row < MP ? (row >> 13) : 2 + ((row - MP) >> 5);
            bf16_t* hr = row < MP ? (bf16_t*)(p.out + O_CKVP) + (size_t)row * 1024 : (bf16_t*)(p.out + O_CKVS) + (size_t)(row - MP) * 1024;
#pragma unroll
            for (int j = 0; j < 4; ++j) { const int c = 4 * lane + 256 * j;
                const f32x4 g = *(const f32x4*)(p.in[I_NG] + c), sh = *(const f32x4*)(mod + mr * 3072 + c), sc = *(const f32x4*)(mod + mr * 3072 + 1024 + c);
                const f32x4 y = v[t][j] * rs * g * (1.f + sc) + sh; u32x2 o; o.x = pk2(y.x, y.y); o.y = pk2(y.z, y.w); *(u32x2*)(hr + c) = o; } } }
    }
}
__device__ __forceinline__ void e1_phase(const Params& p, int wid, int lane) {
    const int gw = blockIdx.x * 8 + wid, NGW = gridDim.x * 8;
    const float QSC = 0.07216878364870322f * 1.4426950408889634f;
    for (int row = gw; row < MT; row += NGW) {
        const bool pr = row < MP; const int lr = pr ? row : row - MP;
        const f32x2_t* rope = (const f32x2_t*)(p.ws + W_ROPE) + (size_t)(pr ? (row & 8191) : (2048 + (lr & 31))) * 32;
        const u32x4 ckv_raw = *(const u32x4*)((pr ? (const bf16_t*)(p.ws + W_CKVP) : (const bf16_t*)(p.ws + W_CKVS)) + (size_t)lr * 512 + lane * 8);
        const bf16_t* krp_ = (pr ? (const bf16_t*)(p.ws + W_KRP) : (const bf16_t*)(p.ws + W_KRS)) + (size_t)lr * 64; const unsigned short kr1_raw = krp_[lane & 31], kr2_raw = krp_[32 + (lane & 31)];
        { bf16_t* q = (pr ? (bf16_t*)(p.ws + W_QP) : (bf16_t*)(p.ws + W_QS)) + (size_t)lr * 1536; const int hd = lane >> 3, sub = lane & 7;
          bf16_t* qn = q + hd * 192 + sub * 16; float f[16]; unpack8(*(const u32x4*)qn, f); unpack8(*(const u32x4*)(qn + 8), f + 8);
          float ss = 0.f;
#pragma unroll
          for (int e = 0; e < 16; ++e) ss += f[e] * f[e];
          ss += __shfl_xor(ss, 1); ss += __shfl_xor(ss, 2); ss += __shfl_xor(ss, 4);
          const float rn = rsqrtf(ss * (1.f / 128.f) + EPS) * QSC;
#pragma unroll
          for (int e = 0; e < 16; ++e) f[e] *= rn * p.in[I_QNN][sub * 16 + e];
          *(u32x4*)qn = pack8(f); *(u32x4*)(qn + 8) = pack8(f + 8);
          bf16_t* qr = q + hd * 192 + 128 + sub * 4; const u32x2 a = *(const u32x2*)qr, b = *(const u32x2*)(qr + 32);
          float x1[4] = {bflo(a.x), bfhi(a.x), bflo(a.y), bfhi(a.y)}, x2[4] = {bflo(b.x), bfhi(b.x), bflo(b.y), bfhi(b.y)};
          float s2 = 0.f;
#pragma unroll
          for (int e = 0; e < 4; ++e) s2 += x1[e] * x1[e] + x2[e] * x2[e];
          s2 += __shfl_xor(s2, 1); s2 += __shfl_xor(s2, 2); s2 += __shfl_xor(s2, 4);
          const float rr = rsqrtf(s2 * (1.f / 64.f) + EPS);
          float o1[4], o2[4];
#pragma unroll
          for (int e = 0; e < 4; ++e) { const int i = sub * 4 + e; const f32x2_t t2 = rope[i]; const float cs = t2.x, sn = t2.y;
              const float y1 = x1[e] * rr * p.in[I_QRN][i], y2 = x2[e] * rr * p.in[I_QRN][32 + i]; o1[e] = (y1 * cs - y2 * sn) * QSC; o2[e] = (y2 * cs + y1 * sn) * QSC; }
          u32x2 w1, w2; w1.x = pk2(o1[0], o1[1]); w1.y = pk2(o1[2], o1[3]); w2.x = pk2(o2[0], o2[1]); w2.y = pk2(o2[2], o2[3]);
          *(u32x2*)qr = w1; *(u32x2*)(qr + 32) = w2; }
        { bf16_t* c = (pr ? (bf16_t*)(p.ws + W_CKVP) : (bf16_t*)(p.ws + W_CKVS)) + (size_t)lr * 512 + lane * 8; float f[8]; unpack8(ckv_raw, f);
          float ss = 0.f;
#pragma unroll
          for (int e = 0; e < 8; ++e) ss += f[e] * f[e];
          const float rn = rsqrtf(wave_sum(ss) * (1.f / 512.f) + EPS);
#pragma unroll
          for (int e = 0; e < 8; ++e) f[e] *= rn * p.in[I_KVN][lane * 8 + e];
          float* o = p.out + (pr ? O_CKVP : O_CKVS) + (size_t)lr * 512 + lane * 8;
          __builtin_nontemporal_store((f32x4){f[0], f[1], f[2], f[3]}, (f32x4*)o); __builtin_nontemporal_store((f32x4){f[4], f[5], f[6], f[7]}, (f32x4*)(o + 4));
          *(u32x4*)c = pack8(f); }
        { bf16_t* k = (pr ? (bf16_t*)(p.ws + W_KRP) : (bf16_t*)(p.ws + W_KRS)) + (size_t)lr * 64; const int i = lane & 31;
          const float x1 = bf2f(kr1_raw), x2 = bf2f(kr2_raw); float ss = x1 * x1 + x2 * x2;
#pragma unroll
          for (int o = 1; o < 32; o <<= 1) ss += __shfl_xor(ss, o);
          const float rr = rsqrtf(ss * (1.f / 64.f) + EPS); const f32x2_t t2 = rope[i]; const float cs = t2.x, sn = t2.y;
          const float y1 = x1 * rr * p.in[I_KRN][i], y2 = x2 * rr * p.in[I_KRN][32 + i]; const float o1 = y1 * cs - y2 * sn, o2 = y2 * cs + y1 * sn;
          float* o = p.out + (pr ? O_KRP : O_KRS) + (size_t)lr * 64;
          if (lane < 32) { o[i] = o1; o[32 + i] = o2; k[i] = f2bf(o1); k[32 + i] = f2bf(o2); } }
    }
}
__device__ __forceinline__ void e2_phase(const Params& p, bf16_t* KN, int nrows, int wid, int lane) {
    const int gw = blockIdx.x * 8 + wid, NGW = gridDim.x * 8;
    float gn[16];
#pragma unroll
    for (int e = 0; e < 16; ++e) gn[e] = p.in[I_KNN][(lane & 7) * 16 + e];
    for (int row0 = gw; row0 < nrows; row0 += 4 * NGW) {
        u32x4 a[4][2];
#pragma unroll
        for (int t = 0; t < 4; ++t) { const int row = row0 + t * NGW; if (row < nrows) { const bf16_t* k = KN + (size_t)row * 1024 + lane * 16; a[t][0] = *(const u32x4*)k; a[t][1] = *(const u32x4*)(k + 8); } }
#pragma unroll
        for (int t = 0; t < 4; ++t) { const int row = row0 + t * NGW; if (row < nrows) { bf16_t* k = KN + (size_t)row * 1024 + lane * 16; float f[16]; unpack8(a[t][0], f); unpack8(a[t][1], f + 8);
            float ss = 0.f;
#pragma unroll
            for (int e = 0; e < 16; ++e) ss += f[e] * f[e];
            ss += __shfl_xor(ss, 1); ss += __shfl_xor(ss, 2); ss += __shfl_xor(ss, 4);
            const float rn = rsqrtf(ss * (1.f / 128.f) + EPS);
#pragma unroll
            for (int e = 0; e < 16; ++e) f[e] *= rn * gn[e];
            *(u32x4*)k = pack8(f); *(u32x4*)(k + 8) = pack8(f + 8); } }
    }
}
__device__ __forceinline__ void build_sample_kv(const Params& p, int wid, int lane) {
    const int gw = blockIdx.x * 8 + wid, NGW = gridDim.x * 8;
    bf16_t* CA = (bf16_t*)(p.ws + W_CKVALL); bf16_t* KA = (bf16_t*)(p.ws + W_KRALL);
#pragma unroll 2
    for (int R = gw; R < MKS; R += NGW) { const int b = R / TKS, t = R - b * TKS;
        if (t < 2048) { const float* s = p.in[I_CCKV] + ((size_t)b * 2048 + t) * 512 + lane * 8; const f32x4 a = __builtin_nontemporal_load((const f32x4*)s), c = __builtin_nontemporal_load((const f32x4*)(s + 4));
            u32x4 w; w.x = pk2(a.x, a.y); w.y = pk2(a.z, a.w); w.z = pk2(c.x, c.y); w.w = pk2(c.z, c.w); *(u32x4*)(CA + (size_t)R * 512 + lane * 8) = w;
            KA[(size_t)R * 64 + lane] = f2bf(p.in[I_CKR][((size_t)b * 2048 + t) * 64 + lane]); }
        else { const int lr = b * 32 + t - 2048; *(u32x4*)(CA + (size_t)R * 512 + lane * 8) = *(const u32x4*)((const bf16_t*)(p.ws + W_CKVS) + (size_t)lr * 512 + lane * 8);
            KA[(size_t)R * 64 + lane] = ((const bf16_t*)(p.ws + W_KRS))[(size_t)lr * 64 + lane]; } }
}
#define MFMA32(a, b, c) __builtin_amdgcn_mfma_f32_32x32x16_bf16((a), (b), (c), 0, 0, 0)
#define MFMA16(a, b, c) __builtin_amdgcn_mfma_f32_16x16x32_bf16((a), (b), (c), 0, 0, 0)
constexpr int AT_KR = 17408, AT_KB = 26624, AT_BUF = 45056;
template <bool SAMPLE, bool DRY = false>
__device__ __forceinline__ void attn_unit(LAS unsigned char* lds, const bf16_t* Q, int ldq, const bf16_t* KN, int ldkn, const bf16_t* KR, const bf16_t* VT, int ldvt,
                                          int ntiles, int limit, bool active, bf16_t* UB, int tid, int lane, int tile0 = 0, float* part = nullptr, const float* part_other = nullptr, unsigned* cnt = nullptr) {
    const int r = lane & 31, hh = lane >> 5;
    bf16x8 qf[12];
#pragma unroll
    for (int s = 0; s < 12; ++s) qf[s] = active ? *(const bf16x8*)(Q + (size_t)r * ldq + 16 * s + 8 * hh) : (bf16x8){0, 0, 0, 0, 0, 0, 0, 0};
    f32x16 o[4];
#pragma unroll
    for (int d = 0; d < 4; ++d)
#pragma unroll
        for (int e = 0; e < 16; ++e) o[d][e] = 0.f;
    float m_run = -__builtin_inff(), l_run = 0.f;
    const int wv = __builtin_amdgcn_readfirstlane(tid >> 6);
    unsigned aoff[6];
#pragma unroll
    for (int i_ = 0; i_ < 6; ++i_) { const int ch_ = wv + 8 * i_; unsigned o_ = 0;
        if (ch_ < 17) { const int sg_ = ch_ * 64 + lane, row_ = sg_ / 17; int c_ = sg_ - row_ * 17; c_ = c_ > 15 ? 15 : c_; o_ = (unsigned)(row_ * ldkn + c_ * 8) * 2u; }
        else if (ch_ < 26) { const int sg_ = (ch_ - 17) * 64 + lane, row_ = sg_ / 9; int c_ = sg_ - row_ * 9; c_ = c_ > 7 ? 7 : c_; o_ = (unsigned)(row_ * 64 + c_ * 8) * 2u; }
        else if (ch_ < 44) { const int sg_ = (ch_ - 26) * 64 + lane, row_ = sg_ / 9; int c_ = sg_ - row_ * 9; c_ = c_ > 7 ? 7 : c_; o_ = (unsigned)(row_ * ldvt + c_ * 8) * 2u; }
        aoff[i_] = o_; }
#define AT_ISSUE(j, buf) do { LAS unsigned char* b_ = lds + (buf) * AT_BUF; const char* kn_ = (const char*)KN + (size_t)(j) * 128 * ldkn; const char* kr_ = (const char*)KR + (size_t)(j) * 8192; const char* vt_ = (const char*)VT + (size_t)(j) * 128; \
        _Pragma("unroll") for (int i_ = 0; i_ < 6; ++i_) { const int ch_ = wv + 8 * i_; unsigned o_ = aoff[i_]; asm volatile("" : "+v"(o_)); \
        if (ch_ < 17) __builtin_amdgcn_global_load_lds((const unsigned*)(kn_ + o_), (LAS unsigned*)(b_ + ch_ * 1024), 16, 0, 0); \
        else if (ch_ < 26) __builtin_amdgcn_global_load_lds((const unsigned*)(kr_ + o_), (LAS unsigned*)(b_ + AT_KR + (ch_ - 17) * 1024), 16, 0, 0); \
        else if (ch_ < 44) __builtin_amdgcn_global_load_lds((const unsigned*)(vt_ + o_), (LAS unsigned*)(b_ + AT_KB + (ch_ - 26) * 1024), 16, 0, 0); } } while (0)
    AT_ISSUE(tile0, 0); __syncthreads();
    for (int jj = 0; jj < ntiles; ++jj) { const int j = tile0 + jj;
        const bool more = (jj + 1 < ntiles);
        if (more) AT_ISSUE(j + 1, (jj + 1) & 1);
        if (active && j <= limit) {
            const LAS unsigned char* kb = lds + (jj & 1) * AT_BUF; const LAS unsigned char* vb = kb + AT_KB;
            f32x16 s0, s1;
#pragma unroll
            for (int e = 0; e < 16; ++e) { s0[e] = 0.f; s1[e] = 0.f; }
            __builtin_amdgcn_s_setprio(1);
#pragma unroll
            for (int s = 0; s < 12; ++s) { const LAS unsigned char* ka = s < 8 ? kb + r * 272 + s * 32 + hh * 16 : kb + AT_KR + r * 144 + (s - 8) * 32 + hh * 16; const int rs32 = s < 8 ? 32 * 272 : 32 * 144;
                const bf16x8 a0 = *(const LAS bf16x8*)ka, a1 = *(const LAS bf16x8*)(ka + rs32);
                s0 = MFMA32(a0, qf[s], s0); s1 = MFMA32(a1, qf[s], s1); if (s == 5) __builtin_amdgcn_sched_barrier(0); }
            __builtin_amdgcn_s_setprio(0);
            if (SAMPLE && j == 32) {
#pragma unroll
                for (int e = 0; e < 16; ++e) s1[e] = -__builtin_inff(); }
            float mx = s0[0];
#pragma unroll
            for (int e = 1; e < 16; ++e) mx = fmaxf(mx, s0[e]);
#pragma unroll
            for (int e = 0; e < 16; ++e) mx = fmaxf(mx, s1[e]);
            mx = fmaxf(mx, __shfl_xor(mx, 32));
            const float mn = fmaxf(m_run, mx), alpha = __builtin_amdgcn_exp2f(m_run - mn); m_run = mn;
            float ps = 0.f;
#pragma unroll
            for (int e = 0; e < 16; ++e) { s0[e] = __builtin_amdgcn_exp2f(s0[e] - mn); s1[e] = __builtin_amdgcn_exp2f(s1[e] - mn); ps += s0[e] + s1[e]; }
            l_run = l_run * alpha + ps;
            if (__builtin_amdgcn_ballot_w64(alpha != 1.f) != 0ull) {
#pragma unroll
            for (int d = 0; d < 4; ++d)
#pragma unroll
                for (int e = 0; e < 16; ++e) o[d][e] *= alpha; }
            bf16x8 pf[4];
#pragma unroll
            for (int sp = 0; sp < 4; ++sp) { const int hf = sp & 1; u32x4 w;
                if (sp < 2) { w.x = pk2(s0[8 * hf + 0], s0[8 * hf + 1]); w.y = pk2(s0[8 * hf + 2], s0[8 * hf + 3]); w.z = pk2(s0[8 * hf + 4], s0[8 * hf + 5]); w.w = pk2(s0[8 * hf + 6], s0[8 * hf + 7]); }
                else        { w.x = pk2(s1[8 * hf + 0], s1[8 * hf + 1]); w.y = pk2(s1[8 * hf + 2], s1[8 * hf + 3]); w.z = pk2(s1[8 * hf + 4], s1[8 * hf + 5]); w.w = pk2(s1[8 * hf + 6], s1[8 * hf + 7]); }
                pf[sp] = __builtin_bit_cast(bf16x8, w); }
            __builtin_amdgcn_s_setprio(1);
#pragma unroll
            for (int sp = 0; sp < 4; ++sp) { __builtin_amdgcn_sched_barrier(0);
#pragma unroll
                for (int d = 0; d < 4; ++d) { const LAS unsigned char* va = vb + (32 * d + r) * 144 + (16 * sp + 4 * (hh ^ ((r >> 4) & 1))) * 2;
                    const u32x2 lo = *(const LAS u32x2*)va, hi = *(const LAS u32x2*)(va + 16); const u32x4 w = {lo.x, lo.y, hi.x, hi.y};
                    o[d] = MFMA32(__builtin_bit_cast(bf16x8, w), pf[sp], o[d]); } }
            __builtin_amdgcn_s_setprio(0);
        }
        __syncthreads();
    }
#undef AT_ISSUE
    bool fin = active && !(DRY && l_run >= 0.f); float lt = l_run + __shfl_xor(l_run, 32);
    if (SAMPLE && active) {
#pragma unroll
        for (int d = 0; d < 4; ++d)
#pragma unroll
            for (int e = 0; e < 16; ++e) part[(d * 16 + e) * 64 + lane] = o[d][e];
        part[4096 + lane] = m_run; part[4160 + lane] = lt;
        asm volatile("s_waitcnt vmcnt(0)" ::: "memory");
        __threadfence();
        unsigned old = 0u; if (lane == 0) old = atomicAdd(cnt, 1u);
        old = (unsigned)__builtin_amdgcn_readfirstlane((int)old);
        fin = (old == 1u);
        if (fin) { __threadfence();
            const float m2 = __builtin_nontemporal_load(part_other + 4096 + lane), l2 = __builtin_nontemporal_load(part_other + 4160 + lane);
            const float mm = fmaxf(m_run, m2), a1 = __builtin_amdgcn_exp2f(m_run - mm), a2 = __builtin_amdgcn_exp2f(m2 - mm); lt = lt * a1 + l2 * a2;
#pragma unroll
            for (int d = 0; d < 4; ++d)
#pragma unroll
                for (int e = 0; e < 16; ++e) o[d][e] = o[d][e] * a1 + __builtin_nontemporal_load(part_other + (d * 16 + e) * 64 + lane) * a2; }
    }
    if (fin) {
        const float inv = 1.f / lt;
        int r2 = r, h2 = hh; asm volatile("" : "+v"(r2), "+v"(h2));
        char* ub = (char*)UB;
#pragma unroll
        for (int d = 0; d < 4; ++d)
#pragma unroll
            for (int g4 = 0; g4 < 4; ++g4) { bf16_t* up = (bf16_t*)(ub + (unsigned)(r2 * 1024 + 32 * d + 8 * g4 + 4 * h2) * 2u); const u32x2 z = *(const u32x2*)up;
                const float z0 = bflo(z.x), z1 = bfhi(z.x), z2 = bflo(z.y), z3 = bfhi(z.y);
                u32x2 w; w.x = pk2(o[d][4 * g4 + 0] * inv * siluf_(z0), o[d][4 * g4 + 1] * inv * siluf_(z1)); w.y = pk2(o[d][4 * g4 + 2] * inv * siluf_(z2), o[d][4 * g4 + 3] * inv * siluf_(z3));
                *(u32x2*)up = w; }
    }
}
template <bool DRY>
__device__ __forceinline__ void attn_prompt_phase(const Params& p, LAS unsigned char* lds, int tid, int wid, int lane) {
    const int G = gridDim.x, bx = blockIdx.x; const int vcu = (G % 8 == 0) ? (bx % 8) * (G / 8) + bx / 8 : bx;
    for (int item = vcu; item < 512; item += G) {
        const int pr = item & 255, bh = pr >> 4, pi = pr & 15, qb = item < 256 ? 31 - pi : pi, b = bh >> 3, h = bh & 7;
        const size_t tok0 = (size_t)b * 8192; const int q0 = qb * 256 + wid * 32;
        attn_unit<false, DRY>(lds, (const bf16_t*)(p.ws + W_QP) + (tok0 + q0) * 1536 + h * 192, 1536, (const bf16_t*)(p.ws + W_KN) + tok0 * 1024 + h * 128, 1024,
                         (const bf16_t*)(p.ws + W_KRP) + tok0 * 64, (const bf16_t*)(p.ws + W_VT) + (size_t)(h * 128) * MP + tok0, MP,
                         4 * qb + 4, 4 * qb + (wid >> 1), true, (bf16_t*)(p.ws + W_UBP) + (tok0 + q0) * 1024 + h * 128, tid, lane);
    }
}
__device__ __forceinline__ void attn_sample_phase(const Params& p, LAS unsigned char* lds, int tid, int wid, int lane) {
    const int G = gridDim.x, bx = blockIdx.x; const int vcu = (G % 8 == 0) ? (bx % 8) * (G / 8) + bx / 8 : bx;
    for (int item = vcu; item < 256; item += G) { const int bh = item >> 1, half = item & 1, b = bh >> 3, h = bh & 7; const size_t tok0 = (size_t)b * TKS;
        float* part = (float*)(p.ws + W_PART) + (size_t)item * 4224;
        attn_unit<true>(lds, (const bf16_t*)(p.ws + W_QS) + (size_t)(b * 32) * 1536 + h * 192, 1536, (const bf16_t*)(p.ws + W_KNS) + tok0 * 1024 + h * 128, 1024,
                        (const bf16_t*)(p.ws + W_KRALL) + tok0 * 64, (const bf16_t*)(p.ws + W_VTS) + (size_t)(h * 128) * MKS + tok0, MKS,
                        half ? 16 : 17, 33, wid == 0, (bf16_t*)(p.ws + W_UBS) + (size_t)(b * 32) * 1024 + h * 128, tid, lane,
                        half ? 17 : 0, part, (const float*)(p.ws + W_PART) + (size_t)(item ^ 1) * 4224, (unsigned*)(p.ws + W_CNT) + bh);
    }
}
constexpr int PR_KH = 0, PR_QH = 17408, PR_KT = 34816, PR_KT0 = 53248, PR_VT0 = 71680, PR_LM = 90112, PR_TB = 107520, PR_TBE = 116736, PR_AT = 125952, PR_VEC = 134144, PR_TL = 135168;
constexpr int PR_XT = 151552, PR_WC = 154624;
__device__ __forceinline__ void prep_conv(const LAS float* wl, float (&acc)[16], const u32x4 (&raw)[4][2], int col0) {
#pragma unroll
    for (int e = 0; e < 16; ++e) acc[e] = 0.f;
#pragma unroll
    for (int i = 0; i < 4; ++i) { float x[16]; unpack8(raw[i][0], x); unpack8(raw[i][1], x + 8);
        const LAS float* wc = wl + i * 384 + col0;
#pragma unroll
        for (int e = 0; e < 4; ++e) { const f32x4 w = *(const LAS f32x4*)(wc + 4 * e); acc[4 * e] += x[4 * e] * w.x; acc[4 * e + 1] += x[4 * e + 1] * w.y; acc[4 * e + 2] += x[4 * e + 2] * w.z; acc[4 * e + 3] += x[4 * e + 3] * w.w; } }
#pragma unroll
    for (int e = 0; e < 16; ++e) acc[e] = siluf_(acc[e]);
}
template <bool DRY>
__device__ __forceinline__ void prep_unit(const Params& p, LAS unsigned char* lds, int u, int tid0, int wid, int lane0, u32x4 (&raw)[3][4][2], float (&pre)[5], bool have, int unext) {
    const bool smp = u >= 2048; int b, h, n;
    if (!smp) { b = u >> 10; h = (u >> 7) & 7; n = u & 127; } else { b = (u - 2048) >> 3; h = (u - 2048) & 7; n = 0; }
    const size_t grow0 = smp ? (size_t)MP + b * 32 : (size_t)b * 8192 + n * 64;
    bf16_t* QKV = (bf16_t*)(p.ws + W_QKV); const bf16_t* HALO = (const bf16_t*)(p.ws + W_HALO);
    int tid = tid0, lane = lane0; asm volatile("" : "+v"(tid), "+v"(lane));
    int row = tid >> 3, cg = tid & 7; const bool valid = !smp || row < 32;
    { LAS float* wl_ = (LAS float*)(lds + PR_WC);
#pragma unroll
      for (int i_ = 0; i_ < 3; ++i_) { const int e_ = tid + 512 * i_, tap_ = e_ / 384, cc_ = e_ - tap_ * 384, part_ = cc_ >> 7; wl_[e_] = have ? pre[i_] : p.in[I_WCONV][(size_t)tap_ * 3072 + part_ * 1024 + h * 128 + (cc_ & 127)]; } }
#define PREP_STAGE(P0_, P1_, smp_, valid_, b_, h_, n_, grow0_) _Pragma("unroll") for (int part = P0_; part < P1_; ++part) { \
        const char* qb_ = (const char*)(QKV + (grow0_) * 3072 + part * 1024 + (h_) * 128); const char* hb_ = (const char*)(HALO + ((size_t)((b_) * 128 + (n_) - 1) * 3) * 3072 + part * 1024 + (h_) * 128); \
        const char* sb_ = (const char*)(p.in[I_SC] + ((size_t)(b_) * 3) * 3072 + part * 1024 + (h_) * 128); \
        _Pragma("unroll") for (int i = 0; i < 4; ++i) { const int tt = row - 3 + i; raw[part][i][0] = (u32x4){0u, 0u, 0u, 0u}; raw[part][i][1] = raw[part][i][0]; \
            if (valid_) { \
                if (tt >= 0) { const unsigned off_ = (unsigned)(tt * 3072 + cg * 16) * 2u; raw[part][i][0] = *(const u32x4*)(qb_ + off_); raw[part][i][1] = *(const u32x4*)(qb_ + off_ + 16); } \
                else if (!(smp_) && (n_) > 0) { const unsigned off_ = (unsigned)((tt + 3) * 3072 + cg * 16) * 2u; raw[part][i][0] = *(const u32x4*)(hb_ + off_); raw[part][i][1] = *(const u32x4*)(hb_ + off_ + 16); } \
                else if (smp_) { const unsigned off_ = (unsigned)((tt + 3) * 3072 + cg * 16) * 4u; float x[16]; \
                    _Pragma("unroll") for (int e = 0; e < 4; ++e) { const f32x4 v = *(const f32x4*)(sb_ + off_ + 16 * e); x[4 * e] = v.x; x[4 * e + 1] = v.y; x[4 * e + 2] = v.z; x[4 * e + 3] = v.w; } \
                    raw[part][i][0] = pack8(x); raw[part][i][1] = pack8(x + 8); } \
            } } }
    if (!have) { PREP_STAGE(0, 3, smp, valid, b, h, n, grow0) }
    LAS float* gv = (LAS float*)(lds + PR_VEC); LAS float* betav = gv + 64; LAS float* gcv = gv + 128;
    if (wid == 0) { float g = 0.f, bt = 0.f;
        if (!smp || lane < 32) { const float* ba = (const float*)(p.ws + W_BA) + (grow0 + lane) * 16; const float ba0 = have ? pre[3] : ba[h], ba1 = have ? pre[4] : ba[8 + h]; bt = sigmoidf_(ba0); const float xx = ba1 + p.in[I_DTB][h];
            const float sp = xx > 20.f ? xx : log1pf(__expf(xx)); g = -__expf(p.in[I_ALOG][h]) * sp; }
        betav[lane] = bt; float c = g;
#pragma unroll
        for (int o = 1; o < 64; o <<= 1) { const float t = __shfl_up(c, o); if (lane >= o) c += t; }
        gcv[lane] = c; }
    asm volatile("s_waitcnt vmcnt(0)" ::: "memory");
    __syncthreads();
    __builtin_amdgcn_sched_barrier(0);
    asm volatile("" : "+v"(row), "+v"(cg));
    if (!DRY) { float* o = nullptr;
        if (!smp && n == 127 && row >= 61) o = p.out + O_CVP + ((size_t)b * 3 + (row - 61)) * 3072;
        if (smp && row >= 29 && row < 32) o = p.out + O_CVS + ((size_t)b * 3 + (row - 29)) * 3072;
        if (o) {
#pragma unroll
            for (int part = 0; part < 3; ++part) { float x[16]; unpack8(raw[part][3][0], x); unpack8(raw[part][3][1], x + 8); float* op = o + part * 1024 + h * 128 + cg * 16;
#pragma unroll
                for (int e = 0; e < 4; ++e) *(f32x4*)(op + 4 * e) = (f32x4){x[4 * e], x[4 * e + 1], x[4 * e + 2], x[4 * e + 3]}; } } }
    const float gc = gcv[row], eg = __expf(gc), ed = __expf(gcv[63] - gc);
    const int pcol = (((row >> 3) ^ cg) << 3) | (row & 7);
    bf16_t* dq; if (!smp) dq = (bf16_t*)((char*)(QKV + grow0 * 3072 + h * 128) + (unsigned)(row * 3072 + cg * 16) * 2u); else dq = (bf16_t*)((char*)((bf16_t*)(p.ws + W_SQKV) + (size_t)(u - 2048) * 3 * 8192) + (unsigned)(row * 128 + cg * 16) * 2u);
    LAS bf16_t* KH = (LAS bf16_t*)(lds + PR_KH); LAS bf16_t* QH = (LAS bf16_t*)(lds + PR_QH); LAS bf16_t* KT = (LAS bf16_t*)(lds + PR_KT); LAS bf16_t* KT0 = (LAS bf16_t*)(lds + PR_KT0); LAS bf16_t* VT0 = (LAS bf16_t*)(lds + PR_VT0);
    {   float a[16]; prep_conv((const LAS float*)(lds + PR_WC), a, raw[0], cg * 16);
        float sq = 0.f;
#pragma unroll
        for (int e = 0; e < 16; ++e) sq += a[e] * a[e];
        sq += __shfl_xor(sq, 1); sq += __shfl_xor(sq, 2); sq += __shfl_xor(sq, 4);
        const float rq = rsqrtf(sq + EPS) * 0.08838834764831845f;
#pragma unroll
        for (int e = 0; e < 16; ++e) a[e] *= rq;
        *(LAS u32x4*)(QH + row * 136 + cg * 16) = pack8(a); *(LAS u32x4*)(QH + row * 136 + cg * 16 + 8) = pack8(a + 8);
#pragma unroll
        for (int e = 0; e < 16; ++e) a[e] *= eg;
        if (!DRY) { *(u32x4*)dq = pack8(a); *(u32x4*)(dq + 8) = pack8(a + 8); } }
    __builtin_amdgcn_sched_barrier(0);
    {   float a[16]; prep_conv((const LAS float*)(lds + PR_WC), a, raw[1], 128 + cg * 16);
        float sk = 0.f;
#pragma unroll
        for (int e = 0; e < 16; ++e) sk += a[e] * a[e];
        sk += __shfl_xor(sk, 1); sk += __shfl_xor(sk, 2); sk += __shfl_xor(sk, 4);
        const float rk = rsqrtf(sk + EPS);
#pragma unroll
        for (int e = 0; e < 16; ++e) a[e] *= rk;
        *(LAS u32x4*)(KH + row * 136 + cg * 16) = pack8(a); *(LAS u32x4*)(KH + row * 136 + cg * 16 + 8) = pack8(a + 8);
#pragma unroll
        for (int e = 0; e < 16; ++e) { KT[(cg * 16 + e) * 72 + pcol] = f2bf(a[e] * ed); KT0[(cg * 16 + e) * 72 + pcol] = f2bf(a[e]); } }
    __builtin_amdgcn_sched_barrier(0);
    {   float a[16]; prep_conv((const LAS float*)(lds + PR_WC), a, raw[2], 256 + cg * 16);
#pragma unroll
        for (int e = 0; e < 16; ++e) VT0[(cg * 16 + e) * 72 + pcol] = f2bf(a[e]); }
    __syncthreads();
    if (unext >= 0) { const int b2 = unext >> 10, h2 = (unext >> 7) & 7, n2 = unext & 127; const size_t g2 = (size_t)b2 * 8192 + n2 * 64; asm volatile("" : "+v"(row), "+v"(cg));
        PREP_STAGE(0, 3, false, true, b2, h2, n2, g2)
#pragma unroll
        for (int i_ = 0; i_ < 3; ++i_) { const int e_ = tid + 512 * i_, tap_ = e_ / 384, cc_ = e_ - tap_ * 384, part_ = cc_ >> 7; pre[i_] = p.in[I_WCONV][(size_t)tap_ * 3072 + part_ * 1024 + h2 * 128 + (cc_ & 127)]; }
        { const float* ba2 = (const float*)(p.ws + W_BA) + (g2 + (size_t)(lane & 63)) * 16; pre[3] = ba2[h2]; pre[4] = ba2[8 + h2]; } }
#undef PREP_STAGE
    asm volatile("" : "+v"(tid), "+v"(lane));
    {
        const LAS unsigned char* KHb = lds + PR_KH; const LAS unsigned char* QHb = lds + PR_QH; const int c = lane & 15, g = lane >> 4, mi = wid >> 1;
        f32x4 kk[2], qk[2];
#pragma unroll
        for (int j = 0; j < 2; ++j) { kk[j] = (f32x4){0.f, 0.f, 0.f, 0.f}; qk[j] = kk[j]; }
#pragma unroll
        for (int s = 0; s < 4; ++s) { const bf16x8 aK = *(const LAS bf16x8*)(KHb + (16 * mi + c) * 272 + (32 * s + 8 * g) * 2), aQ = *(const LAS bf16x8*)(QHb + (16 * mi + c) * 272 + (32 * s + 8 * g) * 2);
#pragma unroll
            for (int j = 0; j < 2; ++j) { const int nj = 2 * (wid & 1) + j; const bf16x8 bK = *(const LAS bf16x8*)(KHb + (16 * nj + c) * 272 + (32 * s + 8 * g) * 2);
                kk[j] = MFMA16(aK, bK, kk[j]); qk[j] = MFMA16(aQ, bK, qk[j]); } }
        LAS float* LM = (LAS float*)(lds + PR_LM); LAS bf16_t* ATs = (LAS bf16_t*)(lds + PR_AT);
#pragma unroll
        for (int j = 0; j < 2; ++j) { const int cj = 16 * (2 * (wid & 1) + j) + c; const float gj = gcv[cj];
#pragma unroll
            for (int e = 0; e < 4; ++e) { const int ri = 16 * mi + 4 * g + e; const float dec = (cj <= ri) ? __expf(gcv[ri] - gj) : 0.f;
                LM[ri * 68 + cj] = (cj < ri) ? betav[ri] * kk[j][e] * dec : 0.f; ATs[ri * 64 + cj] = f2bf(qk[j][e] * dec); } }
    }
    __syncthreads();
    asm volatile("" : "+v"(tid), "+v"(lane));
    {
        const LAS float* LM = (const LAS float*)(lds + PR_LM); LAS float* TL = (LAS float*)(lds + PR_TL); LAS float* XT = (LAS float*)(lds + PR_XT);
        LAS bf16_t* TBs = (LAS bf16_t*)(lds + PR_TB); LAS bf16_t* TBe = (LAS bf16_t*)(lds + PR_TBE);
        if (wid == 0) { const int blk = lane >> 4, col = lane & 15; float x[16];
#pragma unroll
            for (int r = 0; r < 16; ++r) { float a = (r == col) ? 1.f : 0.f;
#pragma unroll
                for (int k = 0; k < r; ++k) a -= LM[(16 * blk + r) * 68 + 16 * blk + k] * x[k];
                x[r] = a; TL[(16 * blk + r) * 64 + 16 * blk + col] = a; } }
        __syncthreads();
        for (int i = 1; i < 4; ++i) {
            for (int e = tid; e < i * 256; e += 512) { const int j = e >> 8, r = (e >> 4) & 15, c = e & 15; float a0 = 0.f, a1 = 0.f, a2 = 0.f, a3 = 0.f;
                for (int kb = j; kb < i; ++kb) { const LAS float* lp = LM + (16 * i + r) * 68 + 16 * kb; const LAS float* tp = TL + (16 * kb) * 64 + 16 * j + c;
#pragma unroll
                    for (int k4 = 0; k4 < 4; ++k4) { const f32x4 l4 = *(const LAS f32x4*)(lp + 4 * k4);
                        a0 += l4.x * tp[(4 * k4 + 0) * 64]; a1 += l4.y * tp[(4 * k4 + 1) * 64]; a2 += l4.z * tp[(4 * k4 + 2) * 64]; a3 += l4.w * tp[(4 * k4 + 3) * 64]; } }
                XT[e] = (a0 + a1) + (a2 + a3); }
            __syncthreads();
            for (int e = tid; e < i * 256; e += 512) { const int j = e >> 8, r = (e >> 4) & 15, c = e & 15; float a0 = 0.f, a1 = 0.f; const LAS float* dp = TL + (16 * i + r) * 64 + 16 * i; const LAS float* xp = XT + (j << 8) + c;
#pragma unroll
                for (int k4 = 0; k4 < 4; ++k4) { const f32x4 d4 = *(const LAS f32x4*)(dp + 4 * k4);
                    a0 += d4.x * xp[(4 * k4 + 0) * 16] + d4.z * xp[(4 * k4 + 2) * 16]; a1 += d4.y * xp[(4 * k4 + 1) * 16] + d4.w * xp[(4 * k4 + 3) * 16]; }
                TL[(16 * i + r) * 64 + 16 * j + c] = -(a0 + a1); }
            __syncthreads();
        }
#pragma unroll
        for (int i = 0; i < 8; ++i) { const int e = tid + 512 * i, ri = e >> 6, cj = e & 63; const float t = ((cj >> 4) > (ri >> 4)) ? 0.f : TL[e] * betav[cj]; TBs[ri * 72 + cj] = f2bf(t); TBe[ri * 72 + cj] = f2bf(t * __expf(gcv[cj])); }
    }
    __syncthreads();
    asm volatile("" : "+v"(tid), "+v"(lane));
    {
        const int c = lane & 15, g = lane >> 4;
        f32x4 aw[4], au[4];
#pragma unroll
        for (int mb = 0; mb < 4; ++mb) { aw[mb] = (f32x4){0.f, 0.f, 0.f, 0.f}; au[mb] = aw[mb]; }
#pragma unroll
        for (int s = 0; s < 2; ++s) { const bf16x8 bk = *(const LAS bf16x8*)(lds + PR_KT0 + (16 * wid + c) * 144 + (((4 * s + g) ^ wid) << 4)), bv = *(const LAS bf16x8*)(lds + PR_VT0 + (16 * wid + c) * 144 + (((4 * s + g) ^ wid) << 4));
#pragma unroll
            for (int mb = 0; mb < 4; ++mb) { aw[mb] = MFMA16(*(const LAS bf16x8*)(lds + PR_TBE + (16 * mb + c) * 144 + (32 * s + 8 * g) * 2), bk, aw[mb]);
                au[mb] = MFMA16(*(const LAS bf16x8*)(lds + PR_TB + (16 * mb + c) * 144 + (32 * s + 8 * g) * 2), bv, au[mb]); } }
        char* wb = smp ? (char*)((bf16_t*)(p.ws + W_SQKV) + (size_t)(u - 2048) * 3 * 8192 + 8192 + 16 * wid) : (char*)(QKV + grow0 * 3072 + 1024 + h * 128 + 16 * wid);
        const unsigned rs = smp ? 128u : 3072u, us = smp ? 8192u * 2u : 1024u * 2u;
#pragma unroll
        for (int mb = 0; mb < 4; ++mb)
#pragma unroll
            for (int e = 0; e < 4; ++e) { const unsigned off = ((unsigned)(16 * mb + 4 * g + e) * rs + (unsigned)c) * 2u; if (!DRY || aw[mb][e] == 123456.f) { *(bf16_t*)(wb + off) = f2bf(aw[mb][e]); *(bf16_t*)(wb + us + off) = f2bf(au[mb][e]); } }
    }
    asm volatile("" : "+v"(tid), "+v"(lane));
    if (!DRY) {   bf16_t* KDT = (bf16_t*)(p.ws + W_KDT) + (size_t)u * 8192; bf16_t* ATG = (bf16_t*)(p.ws + W_TB) + (size_t)u * 4096;
#pragma unroll
        for (int i = 0; i < 2; ++i) { const int pc = tid + 512 * i, r = pc >> 3, c = pc & 7; *(u32x4*)(KDT + r * 64 + c * 8) = *(const LAS u32x4*)(lds + PR_KT + r * 144 + ((c ^ ((r >> 4) & 7)) << 4)); }
        { const int r = tid >> 3, c = tid & 7; *(u32x4*)(ATG + r * 64 + c * 8) = *(const LAS u32x4*)(lds + PR_AT + r * 128 + c * 16); }
        if (tid == 0) ((float*)(p.ws + W_GL))[u] = __expf(gcv[63]);
    }
    __syncthreads();
}
constexpr int SC_QG = 0, SC_W = 17408, SC_KD = 34816, SC_AT = 53248, SC_U = 62464, SC_Z = 78848, SC_WV = 95232, SC_WVB = 6656, SC_EX = 148480;
constexpr int NSEG = 8, SEGLEN = 16;
template <int mode>
__device__ __forceinline__ void scan_chain(const Params& p, LAS unsigned char* lds, int bh, int seg, int tid, int wid, int lane) {
    constexpr bool smp = mode == 3, emit = mode >= 2; const int b = bh >> 3, h = bh & 7; const int nsteps = smp ? 1 : SEGLEN;
    asm volatile("" : "+v"(tid), "+v"(lane));
    const int c = lane & 15, g = lane >> 4;
    LAS unsigned char* ST = lds + SC_WV + wid * SC_WVB; LAS unsigned char* RT = ST + 4352; LAS float* EX = (LAS float*)(lds + SC_EX);
    float* MB = (float*)(p.ws + W_MB);
    f32x4 S[8];
#pragma unroll
    for (int mb = 0; mb < 8; ++mb) S[mb] = (f32x4){0.f, 0.f, 0.f, 0.f};
    if (smp) { const char* sd = (const char*)(p.in[I_SD] + ((size_t)bh * 128) * 128 + 16 * wid);
#pragma unroll
        for (int mb = 0; mb < 8; ++mb)
#pragma unroll
            for (int e = 0; e < 4; ++e) S[mb][e] = *(const float*)(sd + (unsigned)((16 * mb + 4 * g + e) * 128 + c) * 4u); }
    if (mode == 1) {
#pragma unroll
        for (int mb = 0; mb < 8; ++mb)
#pragma unroll
            for (int e = 0; e < 4; ++e) S[mb][e] = (16 * mb + 4 * g + e == 16 * wid + c) ? 1.f : 0.f; }
    if (mode == 2) {
        for (int j = 0; j < seg; ++j) { const float* Mj = MB + (size_t)(bh * NSEG + j) * 2 * 16384; const float* Bj = Mj + 16384;
            __syncthreads();
#pragma unroll 2
            for (int i = 0; i < 8; ++i) { const int pc = tid + 512 * i, r = pc >> 5, cc = pc & 31; const f32x4 v = *(const f32x4*)(Mj + r * 128 + cc * 4); u32x2 w; w.x = pk2(v.x, v.y); w.y = pk2(v.z, v.w); *(LAS u32x2*)(lds + r * 272 + cc * 8) = w; }
#pragma unroll
            for (int mb = 0; mb < 8; ++mb) { u32x2 w; w.x = pk2(S[mb][0], S[mb][1]); w.y = pk2(S[mb][2], S[mb][3]); *(LAS u32x2*)(ST + c * 272 + (16 * mb + 4 * g) * 2) = w; }
            __syncthreads();
            { const char* bj = (const char*)(Bj + 16 * wid);
#pragma unroll
              for (int mb = 0; mb < 8; ++mb)
#pragma unroll
                for (int e = 0; e < 4; ++e) S[mb][e] = *(const float*)(bj + (unsigned)((16 * mb + 4 * g + e) * 128 + c) * 4u); }
#pragma unroll
            for (int s = 0; s < 4; ++s) { const bf16x8 bS = *(const LAS bf16x8*)(ST + c * 272 + (32 * s + 8 * g) * 2);
#pragma unroll
                for (int mb = 0; mb < 8; ++mb) S[mb] = MFMA16(*(const LAS bf16x8*)(lds + (16 * mb + c) * 272 + (32 * s + 8 * g) * 2), bS, S[mb]); }
        }
    }
    const int u0 = smp ? 2048 + bh : bh * 128 + seg * SEGLEN;
    const bf16_t* qb0; unsigned rstride; size_t ustride;
    if (!smp) { qb0 = (const bf16_t*)(p.ws + W_QKV) + ((size_t)b * 8192 + (size_t)seg * SEGLEN * 64) * 3072 + h * 128; rstride = 3072; ustride = (size_t)64 * 3072; }
    else { qb0 = (const bf16_t*)(p.ws + W_SQKV) + (size_t)bh * 3 * 8192; rstride = 128; ustride = 0; }
    const size_t koff = smp ? 8192 : 1024, voff = smp ? 16384 : 2048;
    const bf16_t* KDT = (const bf16_t*)(p.ws + W_KDT) + (size_t)u0 * 8192; const bf16_t* ATG = (const bf16_t*)(p.ws + W_TB) + (size_t)u0 * 4096; const float* GLp = (const float*)(p.ws + W_GL) + u0;
    bf16_t* zb0 = smp ? (bf16_t*)(p.ws + W_UAS) + (size_t)(b * 32) * 1024 + h * 128 : (bf16_t*)(p.ws + W_UAP) + ((size_t)b * 8192 + (size_t)seg * SEGLEN * 64) * 1024 + h * 128;
    const int zrows = smp ? 32 : 64;
    u32x4 rq[2], rk[2], rv[2], rd[2], ra, rz[2]; float gl_next;
    const unsigned oq0 = (unsigned)((tid >> 4) * rstride + (tid & 15) * 8) * 2u, oq1 = (unsigned)(((tid + 512) >> 4) * rstride + (tid & 15) * 8) * 2u, od0 = (unsigned)tid * 16u, od1 = (unsigned)(tid + 512) * 16u;
    const unsigned oz0 = (unsigned)((tid >> 4) * 1024 + (tid & 15) * 8) * 2u, oz1 = (unsigned)(((tid + 512) >> 4) * 1024 + (tid & 15) * 8) * 2u;
#define SC_ISSUE(st) do { const char* qb_ = (const char*)(qb0 + (size_t)(st) * ustride); const char* kb_ = qb_ + koff * 2; const char* vb_ = qb_ + voff * 2; const char* db_ = (const char*)(KDT + (size_t)(st) * 8192); const char* tb_ = (const char*)(ATG + (size_t)(st) * 4096); \
        rq[0] = *(const u32x4*)(qb_ + oq0); rq[1] = *(const u32x4*)(qb_ + oq1); rk[0] = *(const u32x4*)(kb_ + oq0); rk[1] = *(const u32x4*)(kb_ + oq1); rv[0] = *(const u32x4*)(vb_ + oq0); rv[1] = *(const u32x4*)(vb_ + oq1); \
        rd[0] = *(const u32x4*)(db_ + od0); rd[1] = *(const u32x4*)(db_ + od1); ra = *(const u32x4*)(tb_ + od0); gl_next = GLp[st]; \
        if (emit) { const char* z_ = (const char*)(zb0 + (size_t)(st) * 64 * 1024); rz[0] = *(const u32x4*)(z_ + oz0); if ((tid >> 4) + 32 < zrows) rz[1] = *(const u32x4*)(z_ + oz1); } } while (0)
#define SC_WRITE() do { _Pragma("unroll") for (int i_ = 0; i_ < 2; ++i_) { const int pc_ = tid + 512 * i_, r_ = pc_ >> 4, c_ = pc_ & 15; *(LAS u32x4*)(lds + SC_QG + r_ * 272 + c_ * 16) = rq[i_]; *(LAS u32x4*)(lds + SC_W + r_ * 272 + c_ * 16) = rk[i_]; \
            *(LAS u32x4*)(lds + SC_U + r_ * 256 + c_ * 16) = rv[i_]; if (emit) *(LAS u32x4*)(lds + SC_Z + r_ * 256 + c_ * 16) = rz[i_]; const int r2_ = pc_ >> 3, c2_ = pc_ & 7; *(LAS u32x4*)(lds + SC_KD + r2_ * 144 + c2_ * 16) = rd[i_]; } \
        { const int r_ = tid >> 3, c_ = tid & 7; *(LAS u32x4*)(lds + SC_AT + r_ * 144 + c_ * 16) = ra; } } while (0)
#define SC_FLUSH(st_) do { char* z_ = (char*)(zb0 + (size_t)(st_) * 64 * 1024); *(u32x4*)(z_ + oz0) = *(const LAS u32x4*)(lds + SC_Z + (tid >> 4) * 256 + (tid & 15) * 16); \
        if ((tid >> 4) + 32 < zrows) *(u32x4*)(z_ + oz1) = *(const LAS u32x4*)(lds + SC_Z + ((tid >> 4) + 32) * 256 + (tid & 15) * 16); } while (0)
    const float gain = p.in[I_DNN][16 * wid + c];
    rz[0] = (u32x4){0u, 0u, 0u, 0u}; rz[1] = rz[0];
    SC_ISSUE(0);
    for (int st = 0; st < nsteps; ++st) {
        __syncthreads();
        if (emit && st > 0) SC_FLUSH(st - 1);
        SC_WRITE(); const float gl = gl_next; if (emit && tid < 64) EX[tid] = 0.f;
        __syncthreads();
        if (st + 1 < nsteps) SC_ISSUE(st + 1);
#pragma unroll
        for (int mb = 0; mb < 8; ++mb) { u32x2 w; w.x = pk2(S[mb][0], S[mb][1]); w.y = pk2(S[mb][2], S[mb][3]); *(LAS u32x2*)(ST + c * 272 + (16 * mb + 4 * g) * 2) = w; }
        f32x4 aK[4];
#pragma unroll
        for (int mb = 0; mb < 4; ++mb) aK[mb] = (f32x4){0.f, 0.f, 0.f, 0.f};
#pragma unroll
        for (int s = 0; s < 4; ++s) { const bf16x8 bS = *(const LAS bf16x8*)(ST + c * 272 + (32 * s + 8 * g) * 2);
#pragma unroll
            for (int mb = 0; mb < 4; ++mb) aK[mb] = MFMA16(*(const LAS bf16x8*)(lds + SC_W + (16 * mb + c) * 272 + (32 * s + 8 * g) * 2), bS, aK[mb]); }
#pragma unroll
        for (int mb = 0; mb < 4; ++mb) { float rr[4];
#pragma unroll
            for (int e = 0; e < 4; ++e) rr[e] = (mode == 1 ? 0.f : bf2f(*(const LAS bf16_t*)(lds + SC_U + (16 * mb + 4 * g + e) * 256 + (16 * wid + c) * 2))) - aK[mb][e];
            u32x2 w; w.x = pk2(rr[0], rr[1]); w.y = pk2(rr[2], rr[3]); *(LAS u32x2*)(RT + c * 144 + (16 * mb + 4 * g) * 2) = w; }
        f32x4 aQ[4];
        { const bf16x8 b0 = *(const LAS bf16x8*)(RT + c * 144 + (8 * g) * 2), b1 = *(const LAS bf16x8*)(RT + c * 144 + (32 + 8 * g) * 2);
#pragma unroll
          for (int mb = 0; mb < 8; ++mb) { S[mb] = S[mb] * gl;
              S[mb] = MFMA16(*(const LAS bf16x8*)(lds + SC_KD + (16 * mb + c) * 144 + (8 * g) * 2), b0, S[mb]);
              S[mb] = MFMA16(*(const LAS bf16x8*)(lds + SC_KD + (16 * mb + c) * 144 + (32 + 8 * g) * 2), b1, S[mb]); }
            if (emit) {
#pragma unroll
            for (int mb = 0; mb < 4; ++mb) { aQ[mb] = (f32x4){0.f, 0.f, 0.f, 0.f};
                aQ[mb] = MFMA16(*(const LAS bf16x8*)(lds + SC_AT + (16 * mb + c) * 144 + (8 * g) * 2), b0, aQ[mb]);
                aQ[mb] = MFMA16(*(const LAS bf16x8*)(lds + SC_AT + (16 * mb + c) * 144 + (32 + 8 * g) * 2), b1, aQ[mb]); } } }
        if (emit) {
#pragma unroll
            for (int s = 0; s < 4; ++s) { const bf16x8 bS = *(const LAS bf16x8*)(ST + c * 272 + (32 * s + 8 * g) * 2);
#pragma unroll
                for (int mb = 0; mb < 4; ++mb) aQ[mb] = MFMA16(*(const LAS bf16x8*)(lds + SC_QG + (16 * mb + c) * 272 + (32 * s + 8 * g) * 2), bS, aQ[mb]); } }
        if (emit) {
#pragma unroll
            for (int mb = 0; mb < 4; ++mb)
#pragma unroll
                for (int e = 0; e < 4; ++e) { float q = aQ[mb][e] * aQ[mb][e];
                    q += __int_as_float(__builtin_amdgcn_update_dpp(0, __float_as_int(q), 0x111, 0xf, 0xf, true));
                    q += __int_as_float(__builtin_amdgcn_update_dpp(0, __float_as_int(q), 0x112, 0xf, 0xf, true));
                    q += __int_as_float(__builtin_amdgcn_update_dpp(0, __float_as_int(q), 0x114, 0xf, 0xf, true));
                    q += __int_as_float(__builtin_amdgcn_update_dpp(0, __float_as_int(q), 0x118, 0xf, 0xf, true));
                    if (c == 15) __hip_atomic_fetch_add(EX + (16 * mb + 4 * g + e), q, __ATOMIC_RELAXED, __HIP_MEMORY_SCOPE_WORKGROUP); }
            __syncthreads();
#pragma unroll
            for (int mb = 0; mb < 4; ++mb)
#pragma unroll
                for (int e = 0; e < 4; ++e) { const int rw = 16 * mb + 4 * g + e; const float rn = rsqrtf(EX[rw] * (1.f / 128.f) + EPS);
                    LAS bf16_t* zp = (LAS bf16_t*)(lds + SC_Z + rw * 256 + (16 * wid + c) * 2); *zp = f2bf(aQ[mb][e] * rn * gain * siluf_(bf2f(*zp))); }
        }
    }
    __syncthreads();
    if (emit) SC_FLUSH(nsteps - 1);
#undef SC_ISSUE
#undef SC_WRITE
#undef SC_FLUSH
    if (mode != 2 || seg == NSEG - 1) {
        int c2 = c, g2 = g; asm volatile("" : "+v"(c2), "+v"(g2));
        char* so = mode == 3 ? (char*)(p.out + O_SDS + ((size_t)bh * 128) * 128 + 16 * wid) : mode == 2 ? (char*)(p.out + O_SDP + ((size_t)bh * 128) * 128 + 16 * wid)
                             : (char*)(MB + ((size_t)(bh * NSEG + seg) * 2 + (mode == 0 ? 1 : 0)) * 16384 + 16 * wid);
#pragma unroll
        for (int mb = 0; mb < 8; ++mb)
#pragma unroll
            for (int e = 0; e < 4; ++e) *(float*)(so + (unsigned)((16 * mb + 4 * g2 + e) * 128 + c2) * 4u) = S[mb][e]; }
    __syncthreads();
}

#define XB_TMO      128
#define XB_XCNT(j)  (256  + 64 * (j))
#define XB_XSUB(j)  (1280 + 64 * (j))
#define XB_XGEN(j)  (2304 + 64 * (j))
#define XB_TOP      3328
#define XB_TOPGEN   3392
#define XCD_BAR_WORDS 3456
#define XB_SPIN_CAP (1u << 18)

__device__ __forceinline__ unsigned xb_ld(unsigned* p)              { return __hip_atomic_load(p, __ATOMIC_RELAXED, __HIP_MEMORY_SCOPE_AGENT); }
__device__ __forceinline__ unsigned xb_add(unsigned* p, unsigned v) { return __hip_atomic_fetch_add(p, v, __ATOMIC_RELAXED, __HIP_MEMORY_SCOPE_AGENT); }
__device__ __forceinline__ unsigned xb_xcc_id() { return (unsigned)__builtin_amdgcn_s_getreg((3 << 11) | 20) & 0xFu; }
#define XB_SPIN(cond, bar) do { unsigned _sp = 0; while (cond) { __builtin_amdgcn_s_sleep(1); \
    if ((++_sp & 255u) == 0u) { if (xb_ld(&(bar)[XB_TMO])) break; if (_sp > XB_SPIN_CAP) { atomicAdd(&(bar)[XB_TMO], 1u); break; } } } } while (0)

struct XcdBarrier {
    unsigned* bar; unsigned x;
    volatile LAS unsigned* st;
};

__device__ __forceinline__ XcdBarrier xcd_barrier_post(unsigned* bar, volatile LAS unsigned* st) {
    XcdBarrier b; b.bar = bar; b.x = xb_xcc_id(); b.st = st;
    if (threadIdx.x == 0) (void)xb_add(&bar[XB_XCNT(b.x)], 1u);
    return b;
}
__device__ __forceinline__ void xcd_barrier_complete(unsigned* bar, unsigned x, unsigned& nloc, unsigned& nx) {
    const unsigned G = gridDim.x * gridDim.y * gridDim.z;
    unsigned sum, cnt, mine, sp = 0u;
    for (;;) {
        sum = 0u; cnt = 0u; mine = 0u;
#pragma unroll
        for (unsigned j = 0; j < 16; ++j) { const unsigned c = xb_ld(&bar[XB_XCNT(j)]); sum += c; cnt += (c > 0u) ? 1u : 0u; mine = (j == x) ? c : mine; }
        if (sum == G) break;
        __builtin_amdgcn_s_sleep(1);
        if ((++sp & 255u) == 0u) { if (xb_ld(&bar[XB_TMO])) break; if (sp > XB_SPIN_CAP) { atomicAdd(&bar[XB_TMO], 1u); break; } }
    }
    nloc = mine > 0u ? mine : 1u; nx = cnt > 0u ? cnt : 1u;
}

__device__ __forceinline__ void xcd_barrier(const XcdBarrier& b) {
    asm volatile("s_waitcnt vmcnt(0)" ::: "memory");
    __syncthreads();
    if (threadIdx.x == 0) {
        unsigned* bar = b.bar;
        __builtin_amdgcn_s_waitcnt(0);
        unsigned nloc = b.st[0], nx = b.st[1];
        if (nloc == 0u) { xcd_barrier_complete(bar, b.x, nloc, nx); b.st[0] = nloc; b.st[1] = nx; }
        const unsigned old = xb_add(&bar[XB_XSUB(b.x)], 1u);
        const unsigned gen = old / nloc;
        if (old + 1u == (gen + 1u) * nloc) {
            __builtin_amdgcn_fence(__ATOMIC_RELEASE, "agent");
            asm volatile("s_waitcnt vmcnt(0)" ::: "memory");
            const unsigned og = xb_add(&bar[XB_TOP], 1u);
            const unsigned tg = og / nx;
            if (og + 1u == (tg + 1u) * nx) xb_add(&bar[XB_TOPGEN], 1u);
            else XB_SPIN(xb_ld(&bar[XB_TOPGEN]) == tg, bar);
            __builtin_amdgcn_fence(__ATOMIC_ACQUIRE, "agent");
            xb_add(&bar[XB_XGEN(b.x)], 1u);
            asm volatile("s_waitcnt vmcnt(0)" ::: "memory");
        } else {
            XB_SPIN(xb_ld(&bar[XB_XGEN(b.x)]) == gen, bar);
            __builtin_amdgcn_fence(__ATOMIC_ACQUIRE, "agent");
            asm volatile("s_waitcnt vmcnt(0)" ::: "memory");
        }
    }
    __syncthreads();
}


#ifndef REPG
#define REPG 1
#endif
#ifndef REPS1
#define REPS1 1
#endif
#ifndef REPP
#define REPP 1
#endif
template <class Epi>
__device__ __forceinline__ void run_gemm(LAS unsigned char* lds, const pg8::Gemm& g, const Epi& E) {
    pg8::StaticOrder S; S.init(g.M, g.N, (int)gridDim.x, (int)blockIdx.x);
#pragma unroll 1
    for (int rep_ = 0; rep_ < REPG; ++rep_) pg8::gemm_phase<Epi, pg8::StaticOrder, true, true>((PG8_LAS unsigned char*)lds, g, S, E);
}
__device__ __forceinline__ pg8::Gemm mk_gemm(const bf16_t* A, const bf16_t* As, int pm_split, const bf16_t* Bt, int M, int N, int K, int lda, int ldb) {
    pg8::Gemm g; g.A = A; g.As = As ? As : A; g.A2 = A; g.A2s = g.As; g.Bt = Bt; g.M = M; g.N = N; g.K = K; g.lda = lda; g.ldb = ldb; g.pm_split = pm_split; g.nt1 = K / 64; return g;
}
template <int NB, bool F32OUT>
__device__ __forceinline__ void skinny_proj(const bf16_t* H, const bf16_t* Bt, void* O, int ldo, int ngroups, int wid, int lane) {
    const int c = lane & 15, g = lane >> 4;
    for (int t = blockIdx.x + gridDim.x * wid; t < ngroups; t += gridDim.x * 8) {
        f32x4 acc[NB];
#pragma unroll
        for (int nb = 0; nb < NB; ++nb) acc[nb] = (f32x4){0.f, 0.f, 0.f, 0.f};
        const bf16_t* ap = H + (size_t)(16 * t + c) * 1024 + 8 * g; const bf16_t* bp = Bt + (size_t)c * 1024 + 8 * g;
#pragma unroll 16
        for (int s = 0; s < 32; ++s) { const bf16x8 a = *(const bf16x8*)(ap + 32 * s);
#pragma unroll
            for (int nb = 0; nb < NB; ++nb) acc[nb] = MFMA16(a, *(const bf16x8*)(bp + (size_t)nb * 16 * 1024 + 32 * s), acc[nb]); }
#pragma unroll
        for (int nb = 0; nb < NB; ++nb)
#pragma unroll
            for (int e = 0; e < 4; ++e) { const size_t o = (size_t)(16 * t + 4 * g + e) * ldo + nb * 16 + c; if (F32OUT) ((float*)O)[o] = acc[nb][e]; else ((bf16_t*)O)[o] = f2bf(acc[nb][e]); }
    }
}
#ifndef PH_LO
#define PH_LO 0
#endif
#ifndef PH_HI
#define PH_HI 17
#endif
__global__ void __launch_bounds__(512, 2) hybrid_fwd(Params p_arg) {
    extern __shared__ __attribute__((aligned(16))) unsigned char lds_raw[];
    LAS unsigned char* lds = (LAS unsigned char*)lds_raw;
    cg::grid_group grid = cg::this_grid();
    volatile LAS unsigned* MISC = (volatile LAS unsigned*)(lds + LDS_BYTES - 64);
    if (threadIdx.x < 8) MISC[threadIdx.x] = 0u;
    __syncthreads();
    XcdBarrier xbar = xcd_barrier_post((unsigned*)p_arg.ws, MISC);
    if (p_arg.ws == nullptr) grid.sync();
#define PH(k) if (PH_LO <= (k) && (k) < PH_HI)
#if defined(__HIP_DEVICE_COMPILE__)
#define LOADP() Params p; { const __attribute__((address_space(4))) Params* kp_ = (const __attribute__((address_space(4))) Params*)__builtin_amdgcn_kernarg_segment_ptr(); asm volatile("" : "+s"(kp_)); p = *(const Params*)kp_; } unsigned char* ws = p.ws; (void)ws; int tid = threadIdx.x; asm volatile("" : "+v"(tid)); const int lane = tid & 63, wid = __builtin_amdgcn_readfirstlane(tid >> 6); (void)lane; (void)wid
#else
#define LOADP() Params p = p_arg; unsigned char* ws = p.ws; (void)ws; int tid = threadIdx.x; const int lane = tid & 63, wid = tid >> 6; (void)lane; (void)wid
#endif
#ifdef XSTAMP_MASK
    unsigned long long t_prev = __builtin_amdgcn_s_memrealtime(), t_extra = 0ull;
#define STAMP(k) do { const unsigned long long t_now = __builtin_amdgcn_s_memrealtime(); if ((XSTAMP_MASK >> (k)) & 1) t_extra += t_now - t_prev; t_prev = t_now; } while (0)
#else
#define STAMP(k) do { } while (0)
#endif
#define SYNC(k) if (PH_LO <= (k) && (k) + 1 < PH_HI) { xcd_barrier(xbar); } STAMP(k)
#ifdef XSYNC
    for (int i_ = 0; i_ < XSYNC; ++i_) xcd_barrier(xbar);
#endif
    PH(0) { LOADP(); for (int rep_ = 0; rep_ < REPP; ++rep_) p0_phase(p, lds, tid, wid, lane); } SYNC(0);
    PH(1) { LOADP(); for (int rep_ = 0; rep_ < REPP; ++rep_) p1_phase(p, wid, lane); } SYNC(1);
    PH(2) { LOADP();
        pg8::Gemm g = mk_gemm((const bf16_t*)(p.out + O_CKVP), nullptr, 1 << 20, (const bf16_t*)(ws + W_BT_DN), MP, 4096, 1024, 1024, 1024);
        EpiProj E{0, ws, p.out, 0, 0, 0}; run_gemm(lds, g, E);
        skinny_proj<1, true>((const bf16_t*)(p.out + O_CKVP), (const bf16_t*)(ws + W_BT_DN) + (size_t)4096 * 1024, (float*)(ws + W_BA), 16, MP / 16, wid, lane); } SYNC(2);
    PH(3) { LOADP();
        unsigned* dns = (unsigned*)(ws + W_CNT) + 256;
        if (blockIdx.x >= 128 && blockIdx.x < 204) {
            const int idx = blockIdx.x - 128; const bool dn = idx < 34; const int i2 = dn ? idx : idx - 34, nn = dn ? 17 : 21, pm = i2 / nn, pn = i2 - pm * nn;
            const bf16_t* Bt = (dn ? (const bf16_t*)(ws + W_BT_DN) : (const bf16_t*)(ws + W_BT_MLA)) + (size_t)pn * 256 * 1024;
            pg8::Gemm g = mk_gemm((const bf16_t*)(p.out + O_CKVS) + (size_t)pm * 256 * 1024, nullptr, 1 << 20, Bt, 256, 256, 1024, 1024, 1024);
            EpiProj E{dn ? 0 : 1, ws, p.out, 1, pm, pn};
            pg8::StaticOrder S; S.init(256, 256, 1, 0); pg8::gemm_phase<EpiProj, pg8::StaticOrder, true, true>((PG8_LAS unsigned char*)lds, g, S, E);
            asm volatile("s_waitcnt vmcnt(0)" ::: "memory"); __syncthreads();
            if (dn && tid == 0) { __threadfence(); __hip_atomic_fetch_add(dns, 1u, __ATOMIC_RELAXED, __HIP_MEMORY_SCOPE_AGENT); } }
        { u32x4 raw[3][4][2]; float pre[5] = {0.f, 0.f, 0.f, 0.f, 0.f}; bool have = false;
          for (int u = blockIdx.x; u < 2176; u += gridDim.x) {
            if (u >= 2048) { if (tid == 0) { unsigned sp = 0; while (__hip_atomic_load(dns, __ATOMIC_RELAXED, __HIP_MEMORY_SCOPE_AGENT) < 34u && ++sp < (1u << 22)) __builtin_amdgcn_s_sleep(2); __threadfence(); } __syncthreads(); }
            const int un = u + (int)gridDim.x; const int unext = un < 2048 ? un : -1;
            prep_unit<false>(p, lds, u, tid, wid, lane, raw, pre, have, unext); have = unext >= 0; } } } SYNC(3);
    PH(4) { LOADP();
        for (int rep_ = 0; rep_ < REPS1; ++rep_) for (int ci = blockIdx.x; ci < 256; ci += gridDim.x) { if (ci & 1) scan_chain<1>(p, lds, ci >> 4, (ci >> 1) & 7, tid, wid, lane); else scan_chain<0>(p, lds, ci >> 4, (ci >> 1) & 7, tid, wid, lane); }
        xcd_barrier(xbar); }
    PH(4) { LOADP();
        for (int ci = blockIdx.x; ci < 256; ci += gridDim.x) { if (ci < 128) scan_chain<2>(p, lds, ci >> 3, ci & 7, tid, wid, lane); else scan_chain<3>(p, lds, ci - 128, 0, tid, wid, lane); } } SYNC(4);
    PH(5) { LOADP();
        pg8::Gemm g = mk_gemm((const bf16_t*)(p.out + O_CKVP), nullptr, 1 << 20, (const bf16_t*)(ws + W_BT_MLA), MP, 5120, 1024, 1024, 1024);
        EpiProj E{1, ws, p.out, 0, 0, 0}; run_gemm(lds, g, E);
        skinny_proj<4, false>((const bf16_t*)(p.out + O_CKVP), (const bf16_t*)(ws + W_BT_MLA) + (size_t)5120 * 1024, (bf16_t*)(ws + W_KRP), 64, MP / 16, wid, lane); } SYNC(5);
    PH(6) { LOADP(); e1_phase(p, wid, lane); } SYNC(6);
    PH(7) { LOADP();
        { pg8::Gemm g = mk_gemm((const bf16_t*)(ws + W_CKVP), nullptr, 1 << 20, (const bf16_t*)(ws + W_BT_UKV), MP, 1024, 512, 512, 512); EpiKN E{(bf16_t*)(ws + W_KN), p.in[I_KNN], (PG8_LAS float*)(lds + 131072)}; run_gemm(lds, g, E); }
        { pg8::Gemm g = mk_gemm((const bf16_t*)(ws + W_BT_UKV) + (size_t)1024 * 512, nullptr, 1 << 20, (const bf16_t*)(ws + W_CKVP), 1024, MP, 512, 512, 512); EpiStore E{(bf16_t*)(ws + W_VT), MP, 1}; run_gemm(lds, g, E); } } SYNC(7);
    STAMP(8);
    PH(9) { LOADP();
#ifdef XATTN
        attn_prompt_phase<true>(p, lds, tid, wid, lane);
#endif
        attn_prompt_phase<false>(p, lds, tid, wid, lane); } SYNC(9);
    PH(10) { LOADP();
        pg8::Gemm g = mk_gemm((const bf16_t*)(ws + W_UAP), nullptr, 1 << 20, (const bf16_t*)(ws + W_BT_O), MP, 1024, 2048, 1024, 2048); g.A2 = (const bf16_t*)(ws + W_UBP); g.A2s = g.A2; g.nt1 = 16;
        EpiMerge E{(const bf16_t*)(p.out + O_YP), (bf16_t*)(ws + W_MRGP)}; run_gemm(lds, g, E);
        build_sample_kv(p, wid, lane); } SYNC(10);
    PH(11) { LOADP();
        { pg8::Gemm g = mk_gemm((const bf16_t*)(ws + W_MRGP), nullptr, 1 << 20, (const bf16_t*)(ws + W_BT_OUT), MP, 1024, 1024, 1024, 1024);
          EpiOut E{p.in[I_XP], p.out + O_YP, (const float*)(ws + W_MOD), 13, 0}; run_gemm(lds, g, E); }
        { pg8::Gemm g = mk_gemm((const bf16_t*)(ws + W_CKVALL), nullptr, 1 << 20, (const bf16_t*)(ws + W_BT_UKV), MKS, 1024, 512, 512, 512); EpiKN E{(bf16_t*)(ws + W_KNS), p.in[I_KNN], (PG8_LAS float*)(lds + 131072)}; run_gemm(lds, g, E); }
        { pg8::Gemm g = mk_gemm((const bf16_t*)(ws + W_BT_UKV) + (size_t)1024 * 512, nullptr, 1 << 20, (const bf16_t*)(ws + W_CKVALL), 1024, MKS, 512, 512, 512); EpiStore E{(bf16_t*)(ws + W_VTS), MKS, 1}; run_gemm(lds, g, E); } } SYNC(11);
    STAMP(12);
    PH(13) { LOADP(); attn_sample_phase(p, lds, tid, wid, lane); } SYNC(13);
    PH(14) { LOADP();
        if (blockIdx.x < 64) { const int sl = blockIdx.x >> 3, tl = blockIdx.x & 7, pm = tl >> 2, pn = tl & 3;
            const bf16_t* A = (sl < 4 ? (const bf16_t*)(ws + W_UAS) : (const bf16_t*)(ws + W_UBS)) + (size_t)pm * 256 * 1024 + (sl & 3) * 256;
            const bf16_t* Bt = (const bf16_t*)(ws + W_BT_O) + (size_t)pn * 256 * 2048 + sl * 256;
            pg8::Gemm g = mk_gemm(A, nullptr, 1 << 20, Bt, 256, 256, 256, 1024, 2048);
            EpiSlabMerge E{(const bf16_t*)(ws + W_GS), (float*)(ws + W_SA) + (size_t)sl * 512 * 1024, pm, pn, sl < 4 ? 0 : 1024};
            pg8::StaticOrder S; S.init(256, 256, 1, 0); pg8::gemm_phase<EpiSlabMerge, pg8::StaticOrder, true, true>((PG8_LAS unsigned char*)lds, g, S, E); } } SYNC(14);
    PH(15) { LOADP();
        if (blockIdx.x < 64) { const int sl = blockIdx.x >> 3, tl = blockIdx.x & 7, pm = tl >> 2, pn = tl & 3;
            bf16_t* cv = (bf16_t*)(ws + W_CVT) + (size_t)blockIdx.x * 256 * 128; const float* sa = (const float*)(ws + W_SA) + (size_t)pm * 256 * 1024 + sl * 128;
            for (int i = tid; i < 256 * 32; i += 512) { const int r = i >> 5, c4 = i & 31; f32x4 v = (f32x4){0.f, 0.f, 0.f, 0.f};
#pragma unroll
                for (int s = 0; s < 8; ++s) v += *(const f32x4*)(sa + (size_t)s * 512 * 1024 + (size_t)r * 1024 + c4 * 4);
                u32x2 w; w.x = pk2(v.x, v.y); w.y = pk2(v.z, v.w); *(u32x2*)(cv + r * 128 + c4 * 4) = w; }
            __threadfence(); __syncthreads();
            const bf16_t* Bt = (const bf16_t*)(ws + W_BT_OUT) + (size_t)pn * 256 * 1024 + sl * 128;
            pg8::Gemm g = mk_gemm(cv, nullptr, 1 << 20, Bt, 256, 256, 128, 128, 1024);
            EpiSlabOut E{(float*)(ws + W_SB) + (size_t)sl * 512 * 1024, pm, pn};
            pg8::StaticOrder S; S.init(256, 256, 1, 0); pg8::gemm_phase<EpiSlabOut, pg8::StaticOrder, true, true>((PG8_LAS unsigned char*)lds, g, S, E); } } SYNC(15);
    {   LOADP();
        const float* sb = (const float*)(ws + W_SB); const float* mod = (const float*)(ws + W_MOD);
        for (int i = blockIdx.x * 512 + tid; i < 512 * 256; i += gridDim.x * 512) { const int row = i >> 8, c4 = i & 255; f32x4 v = (f32x4){0.f, 0.f, 0.f, 0.f};
#pragma unroll
            for (int s = 0; s < 8; ++s) v += *(const f32x4*)(sb + (size_t)s * 512 * 1024 + (size_t)row * 1024 + c4 * 4);
            const f32x4 x = *(const f32x4*)(p.in[I_XS] + (size_t)row * 1024 + c4 * 4), gt = *(const f32x4*)(mod + (size_t)(2 + (row >> 5)) * 3072 + 2048 + c4 * 4);
            *(f32x4*)(p.out + O_YS + (size_t)row * 1024 + c4 * 4) = x + gt * v; } }
    STAMP(15);
#ifdef XSTAMP_MASK
    if (blockIdx.x == 0 && threadIdx.x == 0) { const unsigned long long t0 = __builtin_amdgcn_s_memrealtime(); while (__builtin_amdgcn_s_memrealtime() - t0 < t_extra) __builtin_amdgcn_s_sleep(8); }
#endif
}

extern "C" void kernel_launch(void* const* d_in, const int* in_sizes, int n_in, void* d_out, int out_size, void* d_ws, size_t ws_size, hipStream_t stream) {
    static int grid = 0;
    if (grid == 0) {
        int dev = 0, cus = 0, per_cu = 0;
        if (n_in != 26 || ws_size < 256 * MiB) { fprintf(stderr, "kernel_launch: unexpected n_in %d / ws %zu\n", n_in, ws_size); grid = -1; return; }
        hipGetDevice(&dev); hipDeviceGetAttribute(&cus, hipDeviceAttributeMultiprocessorCount, dev);
        if (hipFuncSetAttribute((const void*)hybrid_fwd, hipFuncAttributeMaxDynamicSharedMemorySize, LDS_BYTES) != hipSuccess) { fprintf(stderr, "kernel_launch: hipFuncSetAttribute failed\n"); }
        if (hipOccupancyMaxActiveBlocksPerMultiprocessor(&per_cu, (const void*)hybrid_fwd, 512, LDS_BYTES) != hipSuccess || per_cu < 1) { fprintf(stderr, "kernel_launch: occupancy query says %d\n", per_cu); per_cu = 1; }
        (void)hipGetLastError();
        grid = cus;
    }
    if (grid < 0) return;
    Params p{};
    for (int i = 0; i < 26; ++i) p.in[i] = (const float*)d_in[i];
    p.out = (float*)d_out; p.ws = (unsigned char*)d_ws;
    if (hipMemsetAsync(d_ws, 0, 65536, stream) != hipSuccess) { fprintf(stderr, "kernel_launch: memset failed\n"); return; }
    void* args[] = {&p};
    hipError_t e = hipLaunchCooperativeKernel((const void*)hybrid_fwd, dim3(grid), dim3(512), args, LDS_BYTES, stream);
    if (e != hipSuccess) fprintf(stderr, "cooperative launch failed: %s (grid %d)\n", hipGetErrorString(e), grid);
}
```
